# Optimizing an MI355X kernel written in HIP

```python
import jax, jax.numpy as jnp
from jax import lax
import numpy as np

D_MODEL = 1024
BATCH = 16
SEQ = 4096
DEPTH = 2

N_MIXERS = 2
N_A = (DEPTH + 1) // 2
N_B = DEPTH // 2

CHUNK = 128
SGU_WIDTH = D_MODEL
SGU_GROUPS = 8
SGU_GROUP_DIM = SGU_WIDTH // SGU_GROUPS

RWKV_HEAD = 64
RWKV_HEADS = D_MODEL // RWKV_HEAD
DECAY_LORA = 64
AAA_LORA = 64
GATE_LORA = 160

D_FF = 4 * D_MODEL
N_MOD = 6

RMS_EPS = 1e-6
LN_EPS = 1e-5
GN_EPS = RWKV_HEAD * 1e-5
L2_EPS = 1e-12

kernel_name = "hybrid_sgu_rwkv7_adaln_trunk"


def rms_norm(x):
    xf = x.astype(jnp.float32)
    y = xf * lax.rsqrt(jnp.mean(xf * xf, axis=-1, keepdims=True) + RMS_EPS)
    return y.astype(x.dtype)


def layer_norm(x, g, b):
    xf = x.astype(jnp.float32)
    mu = jnp.mean(xf, axis=-1, keepdims=True)
    var = jnp.mean(jnp.square(xf - mu), axis=-1, keepdims=True)
    y = (xf - mu) * lax.rsqrt(var + LN_EPS)
    return y.astype(x.dtype) * g + b


def modulate(h, shift, scale):
    return h * (1 + scale[:, None, :]) + shift[:, None, :]


def token_shift(x):
    return jnp.pad(x[:, :-1], ((0, 0), (1, 0), (0, 0)))


def sgu_mixer(h, w_in, ln_g, ln_b, w_s, b_s, w_out):
    B, T, _ = h.shape
    uv = jax.nn.gelu(h @ w_in, approximate=False)
    u, v = jnp.split(uv, 2, axis=-1)
    v = layer_norm(v, ln_g, ln_b)
    vc = v.reshape(B, T // CHUNK, CHUNK, SGU_GROUPS, SGU_GROUP_DIM)
    mask = jnp.tril(jnp.ones((CHUNK, CHUNK), dtype=w_s.dtype))
    sv = jnp.einsum('gts,bcsgd->bctgd', w_s * mask, vc) + b_s.T[:, :, None]
    return (u * sv.reshape(B, T, SGU_WIDTH)) @ w_out


def wkv7_scan(r, w, k, v, a_, b_):
    B, T, H, N = r.shape
    seq = tuple(jnp.swapaxes(z.astype(jnp.float32), 0, 1) for z in (r, w, k, v, a_, b_))

    def step(S, inp):
        r_t, w_t, k_t, v_t, a_t, b_t = inp
        sa = jnp.einsum('bhij,bhj->bhi', S, a_t)
        S = S * w_t[:, :, None, :] + sa[..., None] * b_t[:, :, None, :] + v_t[..., None] * k_t[:, :, None, :]
        y = jnp.einsum('bhij,bhj->bhi', S, r_t)
        return S, y

    S0 = jnp.zeros((B, H, N, N), jnp.float32)
    _, ys = lax.scan(step, S0, seq)
    return jnp.swapaxes(ys, 0, 1).astype(r.dtype)


def rwkv7_mixer(h, mu, w_in, w0, w1, w2, a0, a1, a2, g1, g2, k_k, k_a, r_k, ln_g, ln_b, w_out):
    B, T, D = h.shape
    H, N = RWKV_HEADS, RWKV_HEAD
    xx = token_shift(h) - h
    xr, xw, xk, xv, xa, xg = [h + xx * mu[i] for i in range(6)]
    rkv = jnp.einsum('nbtd,dne->nbte', jnp.stack([xr, xk, xv]), w_in.reshape(D, 3, D))
    r, k, v = rkv[0], rkv[1], rkv[2]
    w_log = -jax.nn.softplus(-(w0 + jnp.tanh(xw @ w1) @ w2)) - 0.5
    decay = jnp.exp(-jnp.exp(w_log))
    a = jax.nn.sigmoid(a0 + (xa @ a1) @ a2)
    g = jax.nn.sigmoid(xg @ g1) @ g2
    kk = (k * k_k).reshape(B, T, H, N)
    kkf = kk.astype(jnp.float32)
    kk = (kkf / jnp.maximum(jnp.sqrt(jnp.sum(kkf * kkf, axis=-1, keepdims=True)), L2_EPS)).astype(h.dtype)
    k = k * (1 + (a - 1) * k_a)
    rh = r.reshape(B, T, H, N)
    kh = k.reshape(B, T, H, N)
    vh = v.reshape(B, T, H, N)
    ah = a.reshape(B, T, H, N)
    y = wkv7_scan(rh, decay.reshape(B, T, H, N), kh, vh, -kk, kk * ah)
    yf = y.astype(jnp.float32)
    m = jnp.mean(yf, axis=-1, keepdims=True)
    var = jnp.mean(jnp.square(yf - m), axis=-1, keepdims=True)
    y = ((yf - m) * lax.rsqrt(var + GN_EPS)).astype(h.dtype).reshape(B, T, D) * ln_g + ln_b
    bonus = jnp.sum(rh * kh * r_k, axis=-1, keepdims=True) * vh
    y = y + bonus.reshape(B, T, D)
    return (y * g) @ w_out


def setup_inputs(seed: int = 0) -> dict:
    key = jax.random.key(seed)
    ks = iter(jax.random.split(key, 48))
    D = D_MODEL

    def nrm(shape, scale):
        return jax.random.normal(next(ks), shape, jnp.float32) * scale

    def unif(shape, lo, hi):
        return jax.random.uniform(next(ks), shape, jnp.float32, lo, hi)

    return {
        "x": nrm((BATCH, SEQ, D), 1.0),
        "c": nrm((BATCH, D), 1.0),
        "ada_w": nrm((DEPTH, D, N_MOD * D), 0.3 * D ** -0.5),
        "ada_b": nrm((DEPTH, N_MOD * D), 0.02),
        "mlp_w1": nrm((DEPTH, D, D_FF), D ** -0.5),
        "mlp_w2": nrm((DEPTH, D_FF, D), D_FF ** -0.5),
        "a_w_in": nrm((N_A, D, 2 * SGU_WIDTH), D ** -0.5),
        "a_ln_g": 1.0 + nrm((N_A, SGU_WIDTH), 0.02),
        "a_ln_b": nrm((N_A, SGU_WIDTH), 0.02),
        "a_w_s": nrm((N_A, SGU_GROUPS, CHUNK, CHUNK), CHUNK ** -0.5),
        "a_b_s": 1.0 + nrm((N_A, SGU_GROUPS, CHUNK), 0.02),
        "a_w_out": nrm((N_A, SGU_WIDTH, D), SGU_WIDTH ** -0.5),
        "b_mu": unif((N_B, 6, D), 0.0, 1.0),
        "b_w_in": nrm((N_B, D, 3 * D), D ** -0.5),
        "b_w0": unif((N_B, D), -7.0, -2.0),
        "b_w1": nrm((N_B, D, DECAY_LORA), D ** -0.5),
        "b_w2": nrm((N_B, DECAY_LORA, D), 0.1 * DECAY_LORA ** -0.5),
        "b_a0": nrm((N_B, D), 0.5),
        "b_a1": nrm((N_B, D, AAA_LORA), D ** -0.5),
        "b_a2": nrm((N_B, AAA_LORA, D), 0.5 * AAA_LORA ** -0.5),
        "b_g1": nrm((N_B, D, GATE_LORA), D ** -0.5),
        "b_g2": nrm((N_B, GATE_LORA, D), GATE_LORA ** -0.5),
        "b_k_k": 0.85 + nrm((N_B, D), 0.02),
        "b_k_a": 1.0 + nrm((N_B, D), 0.02),
        "b_r_k": -0.04 + nrm((N_B, RWKV_HEADS, RWKV_HEAD), 0.02),
        "b_ln_g": 1.0 + nrm((N_B, D), 0.02),
        "b_ln_b": nrm((N_B, D), 0.02),
        "b_w_out": nrm((N_B, D, D), D ** -0.5),
        "final_g": 1.0 + nrm((D,), 0.02),
    }


def reference(x, c, ada_w, ada_b, mlp_w1, mlp_w2,
              a_w_in, a_ln_g, a_ln_b, a_w_s, a_b_s, a_w_out,
              b_mu, b_w_in, b_w0, b_w1, b_w2, b_a0, b_a1, b_a2, b_g1, b_g2,
              b_k_k, b_k_a, b_r_k, b_ln_g, b_ln_b, b_w_out, final_g):
    cond = jax.nn.silu(c)
    for i in range(DEPTH):
        mod = cond @ ada_w[i] + ada_b[i]
        shift1, scale1, gate1, shift2, scale2, gate2 = jnp.split(mod, N_MOD, axis=-1)
        h = modulate(rms_norm(x), shift1, scale1)
        j = i // N_MIXERS
        if i % N_MIXERS == 0:
            mix = sgu_mixer(h, a_w_in[j], a_ln_g[j], a_ln_b[j], a_w_s[j], a_b_s[j], a_w_out[j])
        else:
            mix = rwkv7_mixer(h, b_mu[j], b_w_in[j], b_w0[j], b_w1[j], b_w2[j],
                              b_a0[j], b_a1[j], b_a2[j], b_g1[j], b_g2[j],
                              b_k_k[j], b_k_a[j], b_r_k[j], b_ln_g[j], b_ln_b[j], b_w_out[j])
        x = x + gate1[:, None, :] * mix
        h = modulate(rms_norm(x), shift2, scale2)
        ff = jnp.square(jax.nn.relu(h @ mlp_w1[i])) @ mlp_w2[i]
        x = x + gate2[:, None, :] * ff
    return rms_norm(x) * final_g
```

```cpp
#include <hip/hip_runtime.h>
#include <hip/hip_cooperative_groups.h>
#include <cstdio>
#include <cstdint>
namespace cg = cooperative_groups;

#define LAS __attribute__((address_space(3)))
typedef unsigned short bf16_t;
typedef short bf16x8 __attribute__((ext_vector_type(8)));
typedef float f32x4 __attribute__((ext_vector_type(4)));
typedef float f32x2 __attribute__((ext_vector_type(2)));
typedef unsigned u32x4 __attribute__((ext_vector_type(4)));
typedef unsigned u32x2 __attribute__((ext_vector_type(2)));

constexpr int D = 1024, NB = 16, T = 4096, M = NB * T, FF = 4096, NMOD = 6;
constexpr int NTHREADS = 512, NWAVES = 8;

__device__ __forceinline__ int opaque_tid() { int t = threadIdx.x; asm volatile("" : "+v"(t)); return t; }
__device__ __forceinline__ unsigned cvt_pk_bf16(float lo, float hi) { unsigned r; asm volatile("v_cvt_pk_bf16_f32 %0, %1, %2" : "=v"(r) : "v"(lo), "v"(hi)); return r; }
__device__ __forceinline__ float bf_lo(unsigned u) { return __builtin_bit_cast(float, u << 16); }
__device__ __forceinline__ float bf_hi(unsigned u) { return __builtin_bit_cast(float, u & 0xffff0000u); }
__device__ __forceinline__ float sigmoidf_(float x) { return __builtin_amdgcn_rcpf(1.0f + __expf(-x)); }

namespace pg8 {
constexpr int BM = 256, BK = 64, HALF = 128, HTB = HALF * BK * 2, STAGE_BYTES = 8 * HTB, NXCD = 8, WGM = 8;
__host__ __device__ __forceinline__ int lds_byte(int r, int c) { const int st = (r >> 4) * 2 + (c >> 5), rr = r & 15, cc = c & 31, ob = rr * 64 + cc * 2; return st * 1024 + (ob ^ (((ob >> 9) & 1) << 5)); }
__host__ __device__ __forceinline__ void stage_rc(int b, int& R, int& C) { const int st = b / 1024, sb = b % 1024, swz = sb ^ (((sb >> 9) & 1) << 5); R = (st >> 1) * 16 + swz / 64; C = (st & 1) * 32 + (swz % 64) / 2; }
__host__ __device__ __forceinline__ int perm32(int rho) { const int n = rho >> 4, i = rho & 15; return 8 * (i >> 2) + 4 * n + (i & 3); }

struct Unit { int pm, pn; };
struct Gemm { const bf16_t* A; const bf16_t* Bt; int M, N, K; long asplit; };

struct StaticOrder {
    int nM, nN, nwg, G, c, rev;
    __device__ void init(int M_, int N_, int G_, int c_, int rev_ = 0) { nM = M_ / BM; nN = N_ / BM; nwg = nM * nN; G = G_; c = c_; rev = rev_; }
    __device__ bool next(int i, Unit& u) const {
        const long L = (long)i * G + c; if (L >= nwg) return false;
        int wgid = (int)L; { const int q = nwg / NXCD, r = nwg % NXCD, xcd = wgid % NXCD, off = wgid / NXCD; wgid = (xcd < r ? xcd * (q + 1) : r * (q + 1) + (xcd - r) * q) + off; }
        const int nig = WGM * nN, gid = wgid / nig, fm = gid * WGM, gsz = (nM - fm) < WGM ? (nM - fm) : WGM;
        u.pm = fm + ((wgid % nig) % gsz); u.pn = (wgid % nig) / gsz; if (rev) u.pm = nM - 1 - u.pm; return true;
    }
};

__device__ __forceinline__ f32x2 gelu_pk(f32x2 v) {
    const f32x2 av = __builtin_elementwise_abs(v), d = av * 0.2316418882f + 1.0f;
    f32x2 t; t.x = __builtin_amdgcn_rcpf(d.x); t.y = __builtin_amdgcn_rcpf(d.y);
    f32x2 q = t * 0.5307027145f + (-0.7265760135f); q = q * t + 0.7107068705f; q = q * t + (-0.142248368f); q = q * t + 0.127414796f; q = q * t;
    const f32x2 s = (v * v) * (-0.72134752044f);
    f32x2 e; e.x = __builtin_amdgcn_exp2f(s.x); e.y = __builtin_amdgcn_exp2f(s.y);
    const f32x2 m = v * (q * e), r = v - m;
    f32x2 o; o.x = v.x < 0.f ? m.x : r.x; o.y = v.y < 0.f ? m.y : r.y; return o;
}

template <int ACT  > struct EpiAct {
    static constexpr bool PERM = true;
    bf16_t* O; int ldc;
    __device__ __forceinline__ void operator()(const f32x4 (&acc)[2][2][4][2], const Unit& u, int wr, int wc, int fr, int fq) const {
        const int row0 = u.pm * BM + wr * 64 + fr; const int col0 = u.pn * BM + wc * 32 + 8 * fq;
#pragma unroll
        for (int ai = 0; ai < 2; ++ai)
#pragma unroll
            for (int m = 0; m < 4; ++m) { bf16_t* rowp = O + (size_t)(row0 + ai * HALF + m * 16) * ldc + col0;
#pragma unroll
                for (int bj = 0; bj < 2; ++bj) { f32x4 v0 = acc[ai][bj][m][0], v1 = acc[ai][bj][m][1];
                    if (ACT == 1) { f32x2 a = gelu_pk((f32x2){v0[0], v0[1]}), b = gelu_pk((f32x2){v0[2], v0[3]}), c = gelu_pk((f32x2){v1[0], v1[1]}), d = gelu_pk((f32x2){v1[2], v1[3]});
                        v0 = (f32x4){a.x, a.y, b.x, b.y}; v1 = (f32x4){c.x, c.y, d.x, d.y}; }
                    if (ACT == 2) {
#pragma unroll
                        for (int e = 0; e < 4; ++e) { float p = fmaxf(v0[e], 0.f), q = fmaxf(v1[e], 0.f); v0[e] = p * p; v1[e] = q * q; } }
                    u32x4 w; w.x = cvt_pk_bf16(v0[0], v0[1]); w.y = cvt_pk_bf16(v0[2], v0[3]); w.z = cvt_pk_bf16(v1[0], v1[1]); w.w = cvt_pk_bf16(v1[2], v1[3]);
                    *(u32x4*)(rowp + bj * HALF) = w; } }
    }
};
struct EpiRkvL {
    static constexpr bool PERM = true;
    bf16_t* R; size_t split_stride; bf16_t* L; int pn_off;
    __device__ __forceinline__ void operator()(const f32x4 (&acc)[2][2][4][2], const Unit& u0, int wr, int wc, int fr, int fq) const {
        Unit u = u0; u.pn += pn_off;
        const int row0 = u.pm * BM + wr * 64 + fr;
        bf16_t* base; int ldc, colt, mode;
        if (u.pn < 12) { base = R + (size_t)(u.pn >> 2) * split_stride; colt = (u.pn & 3) * BM; ldc = 1024; mode = 0; }
        else { base = L; colt = (u.pn - 12) * BM; ldc = 512; mode = (u.pn == 12) ? 1 : 2; }
        const int col0 = colt + wc * 32 + 8 * fq;
#pragma unroll
        for (int ai = 0; ai < 2; ++ai)
#pragma unroll
            for (int m = 0; m < 4; ++m) { bf16_t* rowp = base + (size_t)(row0 + ai * HALF + m * 16) * ldc + col0;
#pragma unroll
                for (int bj = 0; bj < 2; ++bj) { f32x4 v0 = acc[ai][bj][m][0], v1 = acc[ai][bj][m][1];
                    if (mode == 1 && bj == 0) {
#pragma unroll
                        for (int e = 0; e < 4; ++e) { v0[e] = tanhf(v0[e]); v1[e] = tanhf(v1[e]); } }
                    if (mode == 2) {
#pragma unroll
                        for (int e = 0; e < 4; ++e) { v0[e] = sigmoidf_(v0[e]); v1[e] = sigmoidf_(v1[e]); } }
                    u32x4 w; w.x = cvt_pk_bf16(v0[0], v0[1]); w.y = cvt_pk_bf16(v0[2], v0[3]); w.z = cvt_pk_bf16(v1[0], v1[1]); w.w = cvt_pk_bf16(v1[2], v1[3]);
                    *(u32x4*)(rowp + bj * HALF) = w; } }
    }
};
struct EpiL2 {
    static constexpr bool PERM = true;
    bf16_t* O0; bf16_t* O1; bf16_t* O2; const float* w0; const float* a0;
    __device__ __forceinline__ void operator()(const f32x4 (&acc)[2][2][4][2], const Unit& u, int wr, int wc, int fr, int fq) const {
        const int mode = u.pn >> 2;
        const int row0 = u.pm * BM + wr * 64 + fr; const int col0 = (u.pn & 3) * BM + wc * 32 + 8 * fq;
        bf16_t *o0 = O0, *o1 = O1, *o2 = O2; const float *bw = w0, *ba = a0;
        asm volatile("" : "+s"(o0), "+s"(o1), "+s"(o2), "+s"(bw), "+s"(ba));
        bf16_t* base = (mode == 0) ? o0 : ((mode == 1) ? o1 : o2);
        const float* bias = (mode == 0) ? bw : ba;
#pragma unroll
        for (int bj = 0; bj < 2; ++bj) {
            f32x4 b0 = {0.f, 0.f, 0.f, 0.f}, b1 = {0.f, 0.f, 0.f, 0.f};
            if (mode != 2) { b0 = *(const f32x4*)(bias + col0 + bj * HALF); b1 = *(const f32x4*)(bias + col0 + bj * HALF + 4); }
#pragma unroll
            for (int ai = 0; ai < 2; ++ai)
#pragma unroll
                for (int m = 0; m < 4; ++m) { bf16_t* rowp = base + (size_t)(row0 + ai * HALF + m * 16) * 1024 + col0;
                    f32x4 v0 = acc[ai][bj][m][0] + b0, v1 = acc[ai][bj][m][1] + b1;
                    if (mode != 2) {
                        const float sc = (mode == 0) ? -0.87503988f : 1.0f;
#pragma unroll
                        for (int e = 0; e < 4; ++e) { v0[e] = sc * __builtin_amdgcn_rcpf(1.0f + __expf(-v0[e])); v1[e] = sc * __builtin_amdgcn_rcpf(1.0f + __expf(-v1[e])); } }
                    u32x4 w; w.x = cvt_pk_bf16(v0[0], v0[1]); w.y = cvt_pk_bf16(v0[2], v0[3]); w.z = cvt_pk_bf16(v1[0], v1[1]); w.w = cvt_pk_bf16(v1[2], v1[3]);
                    *(u32x4*)(rowp + bj * HALF) = w;
                    if (m & 1) asm volatile("" ::: "memory"); }
        }
    }
};
struct EpiRes {
    static constexpr bool PERM = false;
    const float* base; float* out; const float* gate;
    int gstride;
    __device__ __forceinline__ void operator()(const f32x4 (&acc)[2][2][4][2], const Unit& u, int wr, int wc, int fr, int fq) const {
        const int col0 = u.pn * BM + wc * 32 + 4 * fq;
        const float* gp = gate + (size_t)(u.pm >> 4) * gstride + col0;
        f32x4 gv[2][2];
#pragma unroll
        for (int bj = 0; bj < 2; ++bj)
#pragma unroll
            for (int n = 0; n < 2; ++n) gv[bj][n] = *(const f32x4*)(gp + bj * HALF + n * 16);
#pragma unroll
        for (int ai = 0; ai < 2; ++ai)
#pragma unroll
            for (int m = 0; m < 4; ++m) { const size_t off = (size_t)(u.pm * BM + ai * HALF + wr * 64 + m * 16 + fr) * 1024 + col0;
#pragma unroll
                for (int bj = 0; bj < 2; ++bj)
#pragma unroll
                    for (int n = 0; n < 2; ++n) { const f32x4 bs = *(const f32x4*)(base + off + bj * HALF + n * 16);
                        *(f32x4*)(out + off + bj * HALF + n * 16) = bs + gv[bj][n] * acc[ai][bj][m][n]; } }
    }
};

template <class Epi>
__device__ __forceinline__ void gemm_phase(LAS unsigned char* lds, const Gemm g, const StaticOrder& S, const Epi& E) {
    const int tid = opaque_tid(), wid = __builtin_amdgcn_readfirstlane(tid >> 6), lane = tid & 63, wr = wid >> 2, wc = wid & 3, fr = lane & 15, fq = lane >> 4;
    int K_ = g.K; asm volatile("" : "+s"(K_));
    const int K = K_, nt = K / BK, lda = K_;
    unsigned voffA[2], voffB[2];
#pragma unroll
    for (int i = 0; i < 2; ++i) { int R, C; stage_rc(tid * 16 + i * 8192, R, C); const int Rb = Epi::PERM ? ((R & ~31) + perm32(R & 31)) : R;
        voffA[i] = (unsigned)(R * lda + C) * 2u; voffB[i] = (unsigned)(Rb * K + C) * 2u; }
    const long kstep = (long)(BK * 2);
    const long hstepA = (long)HALF * lda * 2, hstepB = (long)HALF * K * 2, tstepB = 2 * hstepB;
    const unsigned ldsw = (unsigned)wid * 1024u;
    const int aoff = lds_byte(wr * 64 + fr, fq * 8), boff = lds_byte(wc * 32 + fr, fq * 8);
#define PG8_ABASE(u) ((const char*)g.A + ((long)((u).pn >> 2) * g.asplit + (long)(u).pm * BM * (long)lda) * 2)
#define PG8_APTR(base, kt) ((base) + (long)(kt) * kstep)
#define PG8_SA(b, h) (((b) * 2 + (h)) * HTB)
#define PG8_SB(b, h) ((4 + (b) * 2 + (h)) * HTB)
#define PG8_STAGE(bufoff, gbase, voff) do { _Pragma("unroll") for (int _i = 0; _i < 2; ++_i) \
        __builtin_amdgcn_global_load_lds((const unsigned*)((const char*)(gbase) + (voff)[_i]), (LAS unsigned*)(lds + (bufoff) + ldsw + _i * 8192), 16, 0, 0); } while (0)
#define PG8_LDA(dst, b, h) do { _Pragma("unroll") for (int m = 0; m < 4; ++m) _Pragma("unroll") for (int k = 0; k < 2; ++k) dst[m][k] = *(const LAS bf16x8*)(lds + PG8_SA(b, h) + aoff + m * 2048 + k * 1024); } while (0)
#define PG8_LDB(dst, b, h) do { _Pragma("unroll") for (int n = 0; n < 2; ++n) _Pragma("unroll") for (int k = 0; k < 2; ++k) dst[n][k] = *(const LAS bf16x8*)(lds + PG8_SB(b, h) + boff + n * 2048 + k * 1024); } while (0)
#define PG8_MMA(ai, bj, At, Bt) do { __builtin_amdgcn_s_setprio(1); _Pragma("unroll") for (int m = 0; m < 4; ++m) _Pragma("unroll") for (int n = 0; n < 2; ++n) _Pragma("unroll") for (int k = 0; k < 2; ++k) \
        acc[ai][bj][m][n] = __builtin_amdgcn_mfma_f32_16x16x32_bf16(Bt[n][k], At[m][k], acc[ai][bj][m][n], 0, 0, 0); __builtin_amdgcn_s_setprio(0); } while (0)
#define PG8_WAIT_V(n) asm volatile("s_waitcnt vmcnt(" #n ")" ::: "memory")
#define PG8_WAIT_L(n) asm volatile("s_waitcnt lgkmcnt(" #n ")" ::: "memory")
#define PG8_BAR __builtin_amdgcn_s_barrier()
#define PG8_SCHED __builtin_amdgcn_sched_barrier(0)
    Unit cur, nxt; int ui = 0;
    if (!S.next(0, cur)) return;
    f32x4 acc[2][2][4][2];
#pragma unroll
    for (int a = 0; a < 2; ++a)
#pragma unroll
        for (int b = 0; b < 2; ++b)
#pragma unroll
            for (int m = 0; m < 4; ++m)
#pragma unroll
                for (int n = 0; n < 2; ++n) acc[a][b][m][n] = (f32x4){0.f, 0.f, 0.f, 0.f};
    bf16x8 At[4][2], B0[2][2], B1[2][2];
    const char* cA = PG8_ABASE(cur); const char* cB = (const char*)g.Bt + (long)cur.pn * tstepB;
    PG8_STAGE(PG8_SB(0, 0), cB, voffB); PG8_STAGE(PG8_SB(0, 1), cB + hstepB, voffB); PG8_STAGE(PG8_SA(0, 0), cA, voffA); PG8_STAGE(PG8_SA(0, 1), cA + hstepA, voffA);
    if (wr == 1) PG8_BAR;
    PG8_WAIT_V(2); PG8_BAR;
    PG8_STAGE(PG8_SB(1, 0), cB + kstep, voffB); PG8_STAGE(PG8_SA(1, 0), cA + kstep, voffA); PG8_STAGE(PG8_SB(1, 1), cB + hstepB + kstep, voffB);
    PG8_WAIT_V(6); PG8_BAR;
    for (;;) {
        const bool has_next = S.next(ui + 1, nxt);
        const char* nA = has_next ? PG8_ABASE(nxt) : cA; const char* nB = has_next ? (const char*)g.Bt + (long)nxt.pn * tstepB : cB;
        for (int t = 0; t < nt; t += 2) {
            const bool last = (t == nt - 2);
            const char* a1 = PG8_APTR(cA, t + 1);
            const char* a2 = last ? nA : PG8_APTR(cA, t + 2); const char* b2 = last ? nB : cB + (long)(t + 2) * kstep;
            const char* a3 = a2 + kstep; const char* b3 = b2 + kstep;
            PG8_LDB(B0, 0, 0); PG8_LDB(B1, 0, 1); PG8_SCHED; PG8_LDA(At, 0, 0); PG8_STAGE(PG8_SA(1, 1), a1 + hstepA, voffA);
            PG8_WAIT_V(8); PG8_WAIT_L(0); PG8_BAR; PG8_MMA(0, 0, At, B0); PG8_MMA(0, 1, At, B1); PG8_BAR; PG8_SCHED;
            PG8_LDA(At, 0, 1); PG8_STAGE(PG8_SB(0, 0), b2, voffB); PG8_STAGE(PG8_SB(0, 1), b2 + hstepB, voffB); PG8_STAGE(PG8_SA(0, 0), a2, voffA);
            PG8_WAIT_V(8); PG8_WAIT_L(0); PG8_BAR; PG8_MMA(1, 0, At, B0); PG8_MMA(1, 1, At, B1); PG8_BAR; PG8_SCHED;
            PG8_LDB(B0, 1, 0); PG8_LDB(B1, 1, 1); PG8_SCHED; PG8_LDA(At, 1, 0); PG8_STAGE(PG8_SA(0, 1), a2 + hstepA, voffA);
            PG8_WAIT_V(8); PG8_WAIT_L(0); PG8_BAR; PG8_MMA(0, 0, At, B0); PG8_MMA(0, 1, At, B1); PG8_BAR; PG8_SCHED;
            PG8_LDA(At, 1, 1); PG8_STAGE(PG8_SB(1, 0), b3, voffB); PG8_STAGE(PG8_SB(1, 1), b3 + hstepB, voffB); PG8_STAGE(PG8_SA(1, 0), a3, voffA);
            PG8_WAIT_V(8); PG8_WAIT_L(0); PG8_BAR; PG8_MMA(1, 0, At, B0); PG8_MMA(1, 1, At, B1); PG8_BAR; PG8_SCHED;
        }
        if (wr == 0) PG8_BAR;
        E(acc, cur, wr, wc, fr, fq);
        if (!has_next) break;
#pragma unroll
        for (int a = 0; a < 2; ++a)
#pragma unroll
            for (int b = 0; b < 2; ++b)
#pragma unroll
                for (int m = 0; m < 4; ++m)
#pragma unroll
                    for (int n = 0; n < 2; ++n) acc[a][b][m][n] = (f32x4){0.f, 0.f, 0.f, 0.f};
        cur = nxt; cA = nA; cB = nB; ++ui;
        if (wr == 1) PG8_BAR;
    }
    PG8_WAIT_V(0);
    PG8_BAR;
#undef PG8_ABASE
#undef PG8_APTR
#undef PG8_SA
#undef PG8_SB
#undef PG8_STAGE
#undef PG8_LDA
#undef PG8_LDB
#undef PG8_MMA
#undef PG8_WAIT_V
#undef PG8_WAIT_L
#undef PG8_BAR
#undef PG8_SCHED
}
}

constexpr size_t MiB = 1u << 20;
constexpr size_t WS_MOD = 1 * MiB;
constexpr size_t WS_WIN0 = 2 * MiB;
constexpr size_t WS_WOUT0 = 6 * MiB;
constexpr size_t WS_W1 = 8 * MiB;
constexpr size_t WS_W2 = 24 * MiB;
constexpr size_t WS_WRKV = 40 * MiB;
constexpr size_t WS_WL1 = 46 * MiB;
constexpr size_t WS_WL2 = 48 * MiB;
constexpr size_t WS_WOUT1 = 51 * MiB;
constexpr size_t WS_WS = 53 * MiB;
constexpr size_t WS_H = 60 * MiB;
constexpr size_t WS_UV = 188 * MiB;
constexpr size_t WS_Z = 444 * MiB;
constexpr size_t WS_HID = 188 * MiB;
constexpr size_t WS_X3 = 60 * MiB;
constexpr size_t WS_H2 = 444 * MiB;
constexpr size_t WS_L = 956 * MiB;
constexpr size_t WS_R = 444 * MiB, WS_K = 572 * MiB, WS_V = 700 * MiB;
constexpr size_t WS_WE = 60 * MiB, WS_A = 188 * MiB, WS_G = 316 * MiB;
constexpr size_t WS_YG = 828 * MiB;
constexpr size_t WS_END = 1020 * MiB;
constexpr int LDS_BYTES = 147456;

struct Args {
    const float* in[29];
    float* out; unsigned char* ws;
    int lo, hi;
};

__device__ __forceinline__ float wave_sum(float v) {
#pragma unroll
    for (int o = 1; o < 64; o <<= 1) v += __shfl_xor(v, o);
    return v;
}
template <int CTRL> __device__ __forceinline__ float dppf(float v) { return __builtin_bit_cast(float, __builtin_amdgcn_update_dpp(0, __builtin_bit_cast(int, v), CTRL, 0xF, 0xF, true)); }
__device__ __forceinline__ float reduce16(float v) {
    v += dppf<0xB1>(v); v += dppf<0x4E>(v); v += dppf<0x141>(v); v += dppf<0x140>(v); return v;
}

#define XB_TMO      128
#define XB_XCNT(j)  (256  + 64 * (j))
#define XB_XSUB(j)  (1280 + 64 * (j))
#define XB_XGEN(j)  (2304 + 64 * (j))
#define XB_TOP      3328
#define XB_TOPGEN   3392
#define XCD_BAR_WORDS 3456
#define XB_SPIN_CAP (1u << 18)

__device__ __forceinline__ unsigned xb_ld(unsigned* p)              { return __hip_atomic_load(p, __ATOMIC_RELAXED, __HIP_MEMORY_SCOPE_AGENT); }
__device__ __forceinline__ unsigned xb_add(unsigned* p, unsigned v) { return __hip_atomic_fetch_add(p, v, __ATOMIC_RELAXED, __HIP_MEMORY_SCOPE_AGENT); }
__device__ __forceinline__ unsigned xb_xcc_id() { return (unsigned)__builtin_amdgcn_s_getreg((3 << 11) | 20) & 0xFu; }
#define XB_SPIN(cond, bar) do { unsigned _sp = 0; while (cond) { __builtin_amdgcn_s_sleep(1); \
    if ((++_sp & 255u) == 0u) { if (xb_ld(&(bar)[XB_TMO])) break; if (_sp > XB_SPIN_CAP) { atomicAdd(&(bar)[XB_TMO], 1u); break; } } } } while (0)

struct XcdBarrier {
    unsigned* bar; unsigned x;
    volatile LAS unsigned* st;
};

__device__ __forceinline__ XcdBarrier xcd_barrier_post(unsigned* bar, volatile LAS unsigned* st) {
    XcdBarrier b; b.bar = bar; b.x = xb_xcc_id(); b.st = st;
    if (threadIdx.x == 0) (void)xb_add(&bar[XB_XCNT(b.x)], 1u);
    return b;
}
__device__ __forceinline__ void xcd_barrier_complete(unsigned* bar, unsigned x, unsigned& nloc, unsigned& nx) {
    const unsigned G = gridDim.x * gridDim.y * gridDim.z;
    unsigned sum, cnt, mine, sp = 0u;
    for (;;) {
        sum = 0u; cnt = 0u; mine = 0u;
#pragma unroll
        for (unsigned j = 0; j < 16; ++j) { const unsigned c = xb_ld(&bar[XB_XCNT(j)]); sum += c; cnt += (c > 0u) ? 1u : 0u; mine = (j == x) ? c : mine; }
        if (sum == G) break;
        __builtin_amdgcn_s_sleep(1);
        if ((++sp & 255u) == 0u) { if (xb_ld(&bar[XB_TMO])) break; if (sp > XB_SPIN_CAP) { atomicAdd(&bar[XB_TMO], 1u); break; } }
    }
    nloc = mine > 0u ? mine : 1u; nx = cnt > 0u ? cnt : 1u;
}

__device__ __forceinline__ void xcd_barrier(const XcdBarrier& b) {
    asm volatile("s_waitcnt vmcnt(0)" ::: "memory");
    __syncthreads();
    if (threadIdx.x == 0) {
        unsigned* bar = b.bar;
        __builtin_amdgcn_s_waitcnt(0);
        unsigned nloc = b.st[0], nx = b.st[1];
        if (nloc == 0u) { xcd_barrier_complete(bar, b.x, nloc, nx); b.st[0] = nloc; b.st[1] = nx; }
        const unsigned old = xb_add(&bar[XB_XSUB(b.x)], 1u);
        const unsigned gen = old / nloc;
        if (old + 1u == (gen + 1u) * nloc) {
            __builtin_amdgcn_fence(__ATOMIC_RELEASE, "agent");
            asm volatile("s_waitcnt vmcnt(0)" ::: "memory");
            const unsigned og = xb_add(&bar[XB_TOP], 1u);
            const unsigned tg = og / nx;
            if (og + 1u == (tg + 1u) * nx) xb_add(&bar[XB_TOPGEN], 1u);
            else XB_SPIN(xb_ld(&bar[XB_TOPGEN]) == tg, bar);
            __builtin_amdgcn_fence(__ATOMIC_ACQUIRE, "agent");
            xb_add(&bar[XB_XGEN(b.x)], 1u);
            asm volatile("s_waitcnt vmcnt(0)" ::: "memory");
        } else {
            XB_SPIN(xb_ld(&bar[XB_XGEN(b.x)]) == gen, bar);
            __builtin_amdgcn_fence(__ATOMIC_ACQUIRE, "agent");
            asm volatile("s_waitcnt vmcnt(0)" ::: "memory");
        }
    }
    __syncthreads();
}


__device__ __forceinline__ void gsync(cg::grid_group& grid) {
    asm volatile("s_waitcnt vmcnt(0) lgkmcnt(0)" ::: "memory");
    grid.sync();
    if (threadIdx.x < 64) { __builtin_amdgcn_fence(__ATOMIC_ACQUIRE, "agent"); asm volatile("s_waitcnt vmcnt(0)" ::: "memory"); }
    __syncthreads();
}
__device__ __forceinline__ void transpose_item(const float* W, int lds_, int Ksrc, int Nsrc, bf16_t* WT, int ldd, int row_off, int col_off,
                                               const float* mu, int mode, LAS float* scr, int kb, int nb, int lane) {
    const int k0 = 64 * kb, n0 = 32 * nb;
#pragma unroll 8
    for (int i = 0; i < 32; ++i) { const int kk = 2 * i + (lane >> 5), nn = lane & 31, k = k0 + kk, n = n0 + nn;
        float v = (k < Ksrc && n < Nsrc) ? W[(size_t)k * lds_ + n] : 0.f;
        if (mode) { const float m = mu[k & 1023]; v *= (mode == 1) ? (1.f - m) : m; }
        scr[kk * 33 + nn] = v; }
    asm volatile("s_waitcnt lgkmcnt(0)" ::: "memory");
    const int c = lane & 7;
#pragma unroll
    for (int j = 0; j < 4; ++j) { const int n = (lane >> 3) + 8 * j; const LAS float* s = scr + (8 * c) * 33 + n;
        u32x4 o; o.x = cvt_pk_bf16(s[0 * 33], s[1 * 33]); o.y = cvt_pk_bf16(s[2 * 33], s[3 * 33]); o.z = cvt_pk_bf16(s[4 * 33], s[5 * 33]); o.w = cvt_pk_bf16(s[6 * 33], s[7 * 33]);
        *(u32x4*)(WT + (size_t)(row_off + n0 + n) * ldd + col_off + k0 + 8 * c) = o; }
    asm volatile("s_waitcnt lgkmcnt(0)" ::: "memory");
}

__device__ __forceinline__ void phase_prep(const Args& a, LAS unsigned char* lds) {
    const int tid = opaque_tid(), lane = tid & 63, wave = tid >> 6;
    unsigned char* ws = a.ws;
    {
        LAS float* sc = (LAS float*)lds;
        LAS float* red = (LAS float*)(lds + 65536);
        bool have = false;
        for (int it = blockIdx.x; it < 2 * 96; it += gridDim.x) {
            if (!have) { const float* c = a.in[1];
                for (int e = tid; e < 16 * 1024; e += NTHREADS) { const int b = e >> 10, k = e & 1023; const float x = c[e]; sc[k * 16 + b] = x / (1.f + __expf(-x)); }
                have = true; }
            __syncthreads();
            const int l = it / 96, n0 = (it % 96) * 64;
            const float* w = a.in[2] + (size_t)l * 1024 * 6144 + n0 + lane;
            float acc[16];
#pragma unroll
            for (int b = 0; b < 16; ++b) acc[b] = 0.f;
            const int kbeg = wave * 128;
#pragma unroll 8
            for (int k = kbeg; k < kbeg + 128; ++k) { const float wv = w[(size_t)k * 6144];
                const LAS f32x4* s4 = (const LAS f32x4*)(sc + k * 16);
#pragma unroll
                for (int q = 0; q < 4; ++q) { const f32x4 s = s4[q]; acc[4 * q] += s[0] * wv; acc[4 * q + 1] += s[1] * wv; acc[4 * q + 2] += s[2] * wv; acc[4 * q + 3] += s[3] * wv; } }
#pragma unroll
            for (int b = 0; b < 16; ++b) red[(wave * 16 + b) * 64 + lane] = acc[b];
            __syncthreads();
            float* mod = (float*)(ws + WS_MOD);
            for (int e = tid; e < 1024; e += NTHREADS) { const int b = e >> 6, n = e & 63; float s = 0.f;
#pragma unroll
                for (int wv = 0; wv < 8; ++wv) s += red[(wv * 16 + b) * 64 + n];
                mod[((size_t)l * 16 + b) * 6144 + n0 + n] = s + a.in[3][l * 6144 + n0 + n]; }
            __syncthreads();
        }
        __syncthreads();
    }
}
__device__ __forceinline__ void phase_weights(const Args& a, LAS unsigned char* lds) {
    const int tid = opaque_tid(), lane = tid & 63, wave = tid >> 6;
    unsigned char* ws = a.ws;
    {
        LAS float* scr = (LAS float*)(lds + wave * 16384);
        const int gw = blockIdx.x * NWAVES + wave, NGW = gridDim.x * NWAVES;
        const float* mu = a.in[12];
        constexpr int TOTAL = 16 * 64 + 16 * 32 + 2 * 16 * 128 + 2 * 64 * 32 + 3 * 16 * 32 + 2 * (16 * 4 + 16 * 4 + 16 * 8) + 24 * 32 + 16 * 32;
        for (int it = gw; it < TOTAL; it += NGW) {
            int r = it;
#define JOB(W, LDSRC, KS, NS, DST, LDD, RO, CO, MU, MODE, KB, NBK) if (r >= 0) { if (r < (KB) * (NBK)) { transpose_item((W), (LDSRC), (KS), (NS), (bf16_t*)(ws + (DST)), (LDD), (RO), (CO), (MU), (MODE), scr, r / (NBK), r % (NBK), lane); r = -1; } else r -= (KB) * (NBK); }
            JOB(a.in[6], 2048, 1024, 2048, WS_WIN0, 1024, 0, 0, mu, 0, 16, 64)
            JOB(a.in[11], 1024, 1024, 1024, WS_WOUT0, 1024, 0, 0, mu, 0, 16, 32)
            JOB(a.in[4], 4096, 1024, 4096, WS_W1, 1024, 0, 0, mu, 0, 16, 128)
            JOB(a.in[4] + (size_t)1024 * 4096, 4096, 1024, 4096, WS_W1 + (size_t)4096 * 1024 * 2, 1024, 0, 0, mu, 0, 16, 128)
            JOB(a.in[5], 1024, 4096, 1024, WS_W2, 4096, 0, 0, mu, 0, 64, 32)
            JOB(a.in[5] + (size_t)4096 * 1024, 1024, 4096, 1024, WS_W2 + (size_t)1024 * 4096 * 2, 4096, 0, 0, mu, 0, 64, 32)
            JOB(a.in[13] + 0, 3072, 1024, 1024, WS_WRKV, 1024, 0, 0, mu, 0, 16, 32)
            JOB(a.in[13] + 1024, 3072, 1024, 1024, WS_WRKV, 1024, 1024, 0, mu, 0, 16, 32)
            JOB(a.in[13] + 2048, 3072, 1024, 1024, WS_WRKV, 1024, 2048, 0, mu, 0, 16, 32)
            JOB(a.in[15], 64, 1024, 64, WS_WL1, 2048, 0, 0, mu + 1 * 1024, 1, 16, 4)
            JOB(a.in[15], 64, 1024, 64, WS_WL1, 2048, 0, 1024, mu + 1 * 1024, 2, 16, 4)
            JOB(a.in[18], 64, 1024, 64, WS_WL1, 2048, 128, 0, mu + 4 * 1024, 1, 16, 4)
            JOB(a.in[18], 64, 1024, 64, WS_WL1, 2048, 128, 1024, mu + 4 * 1024, 2, 16, 4)
            JOB(a.in[20], 160, 1024, 160, WS_WL1, 2048, 256, 0, mu + 5 * 1024, 1, 16, 8)
            JOB(a.in[20], 160, 1024, 160, WS_WL1, 2048, 256, 1024, mu + 5 * 1024, 2, 16, 8)
            JOB(a.in[16], 1024, 64, 1024, WS_WL2, 512, 0, 0, mu, 0, 2, 32)
            JOB(a.in[16], 1024, 0, 1024, WS_WL2, 512, 0, 128, mu, 0, 6, 32)
            JOB(a.in[19], 1024, 0, 1024, WS_WL2, 512, 1024, 0, mu, 0, 2, 32)
            JOB(a.in[19], 1024, 64, 1024, WS_WL2, 512, 1024, 128, mu, 0, 2, 32)
            JOB(a.in[19], 1024, 0, 1024, WS_WL2, 512, 1024, 256, mu, 0, 4, 32)
            JOB(a.in[21], 1024, 0, 1024, WS_WL2, 512, 2048, 0, mu, 0, 4, 32)
            JOB(a.in[21], 1024, 160, 1024, WS_WL2, 512, 2048, 256, mu, 0, 4, 32)
            JOB(a.in[27], 1024, 1024, 1024, WS_WOUT1, 1024, 0, 0, mu, 0, 16, 32)
#undef JOB
        }
        bf16_t* wsb = (bf16_t*)(ws + WS_WS);
        for (int e = blockIdx.x * NTHREADS + tid; e < 8 * 128 * 128 / 2; e += gridDim.x * NTHREADS) {
            const int i = e * 2, s = i & 127, t = (i >> 7) & 127;
            const float v0 = (s <= t) ? a.in[9][i] : 0.f, v1 = (s + 1 <= t) ? a.in[9][i + 1] : 0.f;
            ((unsigned*)wsb)[e] = cvt_pk_bf16(v0, v1);
        }
    }
}

__device__ __forceinline__ void phase_norm_mod(const float* x, const float* mod_shift, const float* mod_scale, bf16_t* H, int) {
    const int tid = opaque_tid(), lane = tid & 63, wave = tid >> 6;
    const int gw = blockIdx.x * NWAVES + wave, NGW = gridDim.x * NWAVES;
    constexpr int NR = 4;
    for (int m0 = gw; m0 < M; m0 += NR * NGW) {
        f32x4 v[NR][4];
#pragma unroll
        for (int r = 0; r < NR; ++r) { const int m = M - 1 - (m0 + r * NGW < M ? m0 + r * NGW : m0); const f32x4* xr = (const f32x4*)(x + (size_t)m * D) + lane;
#pragma unroll
            for (int j = 0; j < 4; ++j) v[r][j] = xr[64 * j]; }
#pragma unroll
        for (int r = 0; r < NR; ++r) { const int m = M - 1 - (m0 + r * NGW); if (m >= 0) {
            const int b = m >> 12; float s = 0.f;
#pragma unroll
            for (int j = 0; j < 4; ++j) s += (v[r][j].x * v[r][j].x + v[r][j].y * v[r][j].y) + (v[r][j].z * v[r][j].z + v[r][j].w * v[r][j].w);
            const float rstd = 1.0f / sqrtf(wave_sum(s) * (1.f / D) + 1e-6f);
            const f32x4* sh = (const f32x4*)(mod_shift + (size_t)b * 6144) + lane;
            const f32x4* sc = (const f32x4*)(mod_scale + (size_t)b * 6144) + lane;
            u32x2* o = (u32x2*)(H + (size_t)m * D) + lane;
#pragma unroll
            for (int j = 0; j < 4; ++j) { const f32x4 a = sh[64 * j], c = sc[64 * j]; const f32x4 h = v[r][j] * rstd * (c + 1.0f) + a;
                u32x2 w; w.x = cvt_pk_bf16(h.x, h.y); w.y = cvt_pk_bf16(h.z, h.w); o[64 * j] = w; } } }
    }
}
__device__ __forceinline__ void phase_final_norm(float* x, const float* g) {
    const int tid = opaque_tid(), lane = tid & 63, wave = tid >> 6;
    const int gw = blockIdx.x * NWAVES + wave, NGW = gridDim.x * NWAVES;
    constexpr int NR = 4;
    f32x4 gg[4];
#pragma unroll
    for (int j = 0; j < 4; ++j) gg[j] = ((const f32x4*)g)[lane + 64 * j];
    for (int m0 = gw; m0 < M; m0 += NR * NGW) {
        f32x4 v[NR][4];
#pragma unroll
        for (int r = 0; r < NR; ++r) { const int m = (m0 + r * NGW < M ? m0 + r * NGW : m0); const f32x4* xr = (const f32x4*)(x + (size_t)m * D) + lane;
#pragma unroll
            for (int j = 0; j < 4; ++j) v[r][j] = xr[64 * j]; }
#pragma unroll
        for (int r = 0; r < NR; ++r) { const int m = m0 + r * NGW; if (m < M) {
            float s = 0.f;
#pragma unroll
            for (int j = 0; j < 4; ++j) s += (v[r][j].x * v[r][j].x + v[r][j].y * v[r][j].y) + (v[r][j].z * v[r][j].z + v[r][j].w * v[r][j].w);
            const float rstd = 1.0f / sqrtf(wave_sum(s) * (1.f / D) + 1e-6f);
            f32x4* xr = (f32x4*)(x + (size_t)m * D) + lane;
#pragma unroll
            for (int j = 0; j < 4; ++j) xr[64 * j] = v[r][j] * rstd * gg[j]; } }
    }
}
__device__ __forceinline__ void load_row(const float* x, size_t m, int lane, f32x4 (&v)[4]) {
    const f32x4* xr = (const f32x4*)(x + m * D) + lane;
#pragma unroll
    for (int j = 0; j < 4; ++j) v[j] = xr[64 * j];
}
__device__ __forceinline__ void finish_row(f32x4 (&h)[4], const f32x4 (&sh)[4], const f32x4 (&sc1)[4]) {
    float s = 0.f;
#pragma unroll
    for (int j = 0; j < 4; ++j) s += (h[j].x * h[j].x + h[j].y * h[j].y) + (h[j].z * h[j].z + h[j].w * h[j].w);
    const float rstd = 1.0f / sqrtf(wave_sum(s) * (1.f / D) + 1e-6f);
#pragma unroll
    for (int j = 0; j < 4; ++j) h[j] = h[j] * rstd * sc1[j] + sh[j];
}
__device__ __forceinline__ void phase_norm_shift(const float* x, const float* mod_shift, const float* mod_scale, const float* mu, bf16_t* X3, bf16_t* H2) {
    const int tid = opaque_tid(), lane = tid & 63, wave = tid >> 6;
    const int gw = blockIdx.x * NWAVES + wave, NGW = gridDim.x * NWAVES;
    f32x4 mr[4], mk[4], mv[4];
#pragma unroll
    for (int j = 0; j < 4; ++j) { mr[j] = ((const f32x4*)(mu + 0 * 1024))[lane + 64 * j]; mk[j] = ((const f32x4*)(mu + 2 * 1024))[lane + 64 * j]; mv[j] = ((const f32x4*)(mu + 3 * 1024))[lane + 64 * j]; }
    for (int blk = gw; blk < M / 32; blk += NGW) {
        const size_t m0 = (size_t)blk * 32; const int b = (int)(m0 >> 12);
        f32x4 sh[4], sc1[4];
#pragma unroll
        for (int j = 0; j < 4; ++j) { sh[j] = ((const f32x4*)(mod_shift + (size_t)b * 6144))[lane + 64 * j]; sc1[j] = ((const f32x4*)(mod_scale + (size_t)b * 6144))[lane + 64 * j] + 1.0f; }
        f32x4 hp[4], h[4], n1[4], n2[4];
        const bool first = (m0 & 4095) == 0;
        load_row(x, first ? m0 : m0 - 1, lane, hp); load_row(x, m0, lane, h); load_row(x, m0 + 1, lane, n1);
        finish_row(hp, sh, sc1);
        if (first) {
#pragma unroll
            for (int j = 0; j < 4; ++j) hp[j] = (f32x4){0.f, 0.f, 0.f, 0.f}; }
        for (int i = 0; i < 32; ++i) {
            const size_t m = m0 + i;
            load_row(x, (i + 2 < 32) ? m + 2 : m, lane, n2);
            finish_row(h, sh, sc1);
            u32x2* o2 = (u32x2*)(H2 + m * 2 * D) + lane;
            u32x2* or_ = (u32x2*)(X3 + m * D) + lane;
#pragma unroll
            for (int j = 0; j < 4; ++j) {
                const f32x4 d = hp[j] - h[j];
                const f32x4 xr = h[j] + d * mr[j], xk = h[j] + d * mk[j], xv = h[j] + d * mv[j];
                u32x2 w; w.x = cvt_pk_bf16(h[j].x, h[j].y); w.y = cvt_pk_bf16(h[j].z, h[j].w); o2[64 * j] = w;
                w.x = cvt_pk_bf16(hp[j].x, hp[j].y); w.y = cvt_pk_bf16(hp[j].z, hp[j].w); o2[64 * j + D / 4] = w;
                w.x = cvt_pk_bf16(xr.x, xr.y); w.y = cvt_pk_bf16(xr.z, xr.w); or_[64 * j] = w;
                w.x = cvt_pk_bf16(xk.x, xk.y); w.y = cvt_pk_bf16(xk.z, xk.w); or_[64 * j + (size_t)M * D / 4] = w;
                w.x = cvt_pk_bf16(xv.x, xv.y); w.y = cvt_pk_bf16(xv.z, xv.w); or_[64 * j + 2 * (size_t)M * D / 4] = w;
                hp[j] = h[j]; h[j] = n1[j]; n1[j] = n2[j];
            }
        }
    }
}

__device__ __forceinline__ void phase_sgu(const Args& a, LAS unsigned char* lds) {
    const int tid = opaque_tid(), lane = tid & 63, wave = tid >> 6, fr = lane & 15, fq = lane >> 4;
    const bf16_t* UV = (const bf16_t*)(a.ws + WS_UV); bf16_t* Z = (bf16_t*)(a.ws + WS_Z);
    const bf16_t* WSB = (const bf16_t*)(a.ws + WS_WS);
    const float* lng = a.in[7]; const float* lnb = a.in[8]; const float* bs = a.in[10];
    constexpr int RS = 272;
    LAS unsigned char* Wl = lds;
    LAS unsigned char* Vl = lds + 128 * RS;
    LAS f32x2* st = (LAS f32x2*)(lds + 2 * 128 * RS);
    const int wt = wave >> 2, wd = wave & 3;
    for (int tile_ = blockIdx.x; tile_ < M / 128; tile_ += gridDim.x) {
        const int tile = M / 128 - 1 - tile_;
        const size_t m0 = (size_t)tile * 128;
        for (int r = wave * 16; r < wave * 16 + 16; ++r) {
            const u32x4* p = (const u32x4*)(UV + (m0 + r) * 2048 + 1024) + lane;
            const u32x4 q0 = p[0], q1 = p[64];
            float f[16];
            f[0] = bf_lo(q0.x); f[1] = bf_hi(q0.x); f[2] = bf_lo(q0.y); f[3] = bf_hi(q0.y); f[4] = bf_lo(q0.z); f[5] = bf_hi(q0.z); f[6] = bf_lo(q0.w); f[7] = bf_hi(q0.w);
            f[8] = bf_lo(q1.x); f[9] = bf_hi(q1.x); f[10] = bf_lo(q1.y); f[11] = bf_hi(q1.y); f[12] = bf_lo(q1.z); f[13] = bf_hi(q1.z); f[14] = bf_lo(q1.w); f[15] = bf_hi(q1.w);
            float s = 0.f;
#pragma unroll
            for (int e = 0; e < 16; ++e) s += f[e];
            const float mean = wave_sum(s) * (1.f / 1024.f);
            float q = 0.f;
#pragma unroll
            for (int e = 0; e < 16; ++e) { const float d = f[e] - mean; q += d * d; }
            const float var = wave_sum(q) * (1.f / 1024.f);
            if (lane == 0) st[r] = (f32x2){mean, 1.0f / sqrtf(var + 1e-5f)};
        }
        __syncthreads();
        for (int g = 0; g < 8; ++g) {
            {
                const u32x4* src = (const u32x4*)(WSB + (size_t)g * 128 * 128);
#pragma unroll
                for (int i = 0; i < 4; ++i) { const int idx = tid + i * NTHREADS; const int t = idx >> 4, c = idx & 15;
                    *(LAS u32x4*)(Wl + t * RS + c * 16) = src[idx]; }
            }
            {
                const int sp = tid & 63, dq = tid >> 6, s0 = 2 * sp, d0 = dq * 16;
                const f32x2 st0 = st[s0], st1 = st[s0 + 1];
                const bf16_t* p0 = UV + (m0 + s0) * 2048 + 1024 + g * 128 + d0;
                const u32x4 a0 = *(const u32x4*)p0, a1 = *(const u32x4*)(p0 + 8), b0 = *(const u32x4*)(p0 + 2048), b1 = *(const u32x4*)(p0 + 2048 + 8);
                const unsigned ua[8] = {a0.x, a0.y, a0.z, a0.w, a1.x, a1.y, a1.z, a1.w}, ub[8] = {b0.x, b0.y, b0.z, b0.w, b1.x, b1.y, b1.z, b1.w};
                const float* gp = lng + g * 128 + d0; const float* bp = lnb + g * 128 + d0;
#pragma unroll
                for (int e = 0; e < 8; ++e) {
                    const float g0 = gp[2 * e], g1 = gp[2 * e + 1], c0 = bp[2 * e], c1 = bp[2 * e + 1];
                    const float x00 = (bf_lo(ua[e]) - st0.x) * st0.y * g0 + c0, x01 = (bf_hi(ua[e]) - st0.x) * st0.y * g1 + c1;
                    const float x10 = (bf_lo(ub[e]) - st1.x) * st1.y * g0 + c0, x11 = (bf_hi(ub[e]) - st1.x) * st1.y * g1 + c1;
                    *(LAS unsigned*)(Vl + (d0 + 2 * e) * RS + s0 * 2) = cvt_pk_bf16(x00, x10);
                    *(LAS unsigned*)(Vl + (d0 + 2 * e + 1) * RS + s0 * 2) = cvt_pk_bf16(x01, x11);
                }
            }
            __syncthreads();
            f32x4 acc[4][2];
#pragma unroll
            for (int mi = 0; mi < 4; ++mi)
#pragma unroll
                for (int ni = 0; ni < 2; ++ni) acc[mi][ni] = (f32x4){0.f, 0.f, 0.f, 0.f};
#pragma unroll
            for (int ks = 0; ks < 4; ++ks) {
                if (ks * 32 <= 64 * wt + 63) {
                    bf16x8 bfr[2];
#pragma unroll
                    for (int ni = 0; ni < 2; ++ni) bfr[ni] = *(const LAS bf16x8*)(Vl + (32 * wd + 16 * ni + fr) * RS + (ks * 32 + fq * 8) * 2);
#pragma unroll
                    for (int mi = 0; mi < 4; ++mi) {
                        if (ks * 32 <= 64 * wt + 16 * mi + 15) {
                            const bf16x8 afr = *(const LAS bf16x8*)(Wl + (64 * wt + 16 * mi + fr) * RS + (ks * 32 + fq * 8) * 2);
#pragma unroll
                            for (int ni = 0; ni < 2; ++ni) acc[mi][ni] = __builtin_amdgcn_mfma_f32_16x16x32_bf16(bfr[ni], afr, acc[mi][ni], 0, 0, 0);
                        }
                    }
                }
            }
#pragma unroll
            for (int mi = 0; mi < 4; ++mi) {
                const int t = 64 * wt + 16 * mi + fr; const float bias = bs[g * 128 + t];
#pragma unroll
                for (int ni = 0; ni < 2; ++ni) {
                    const int col = g * 128 + 32 * wd + 16 * ni + 4 * fq;
                    const u32x2 uu = *(const u32x2*)(UV + (m0 + t) * 2048 + col);
                    const f32x4 sv = acc[mi][ni];
                    u32x2 o; o.x = cvt_pk_bf16(bf_lo(uu.x) * (sv[0] + bias), bf_hi(uu.x) * (sv[1] + bias)); o.y = cvt_pk_bf16(bf_lo(uu.y) * (sv[2] + bias), bf_hi(uu.y) * (sv[3] + bias));
                    *(u32x2*)(Z + (m0 + t) * 1024 + col) = o;
                }
            }
            __syncthreads();
        }
    }
}

__device__ __forceinline__ float fma_(float a, float b, float c) { float d; asm("v_fma_f32 %0, %1, %2, %3" : "=v"(d) : "v"(a), "v"(b), "v"(c)); return d; }
__device__ __forceinline__ float mul_(float a, float b) { float d; asm("v_mul_f32 %0, %1, %2" : "=v"(d) : "v"(a), "v"(b)); return d; }
__device__ __forceinline__ float dot4_(const f32x4& s, const f32x4& o) { return fma_(s.w, o.w, fma_(s.z, o.z, fma_(s.y, o.y, mul_(s.x, o.x)))); }
__device__ __forceinline__ void upd4_(f32x4& s, const f32x4& w, const f32x4& b, const f32x4& k, float sa, float v) {
    s.x = fma_(v, k.x, fma_(sa, b.x, mul_(s.x, w.x))); s.y = fma_(v, k.y, fma_(sa, b.y, mul_(s.y, w.y)));
    s.z = fma_(v, k.z, fma_(sa, b.z, mul_(s.z, w.z))); s.w = fma_(v, k.w, fma_(sa, b.w, mul_(s.w, w.w)));
}
__device__ __forceinline__ f32x2 pkmul_(f32x2 a, f32x2 b) { f32x2 d; asm("v_pk_mul_f32 %0, %1, %2" : "=v"(d) : "v"(a), "v"(b)); return d; }
__device__ __forceinline__ f32x2 pkfma_(f32x2 a, f32x2 b, f32x2 c) { f32x2 d; asm("v_pk_fma_f32 %0, %1, %2, %3" : "=v"(d) : "v"(a), "v"(b), "v"(c)); return d; }
__device__ __forceinline__ f32x2 pkfma_lo_(f32x2 a, f32x2 b, f32x2 c) { f32x2 d; asm("v_pk_fma_f32 %0, %1, %2, %3 op_sel_hi:[0,1,1]" : "=v"(d) : "v"(a), "v"(b), "v"(c)); return d; }
__device__ __forceinline__ f32x2 pkfma_hi_(f32x2 a, f32x2 b, f32x2 c) { f32x2 d; asm("v_pk_fma_f32 %0, %1, %2, %3 op_sel:[1,0,0]" : "=v"(d) : "v"(a), "v"(b), "v"(c)); return d; }
__device__ __forceinline__ float add_(float a, float b) { float d; asm("v_add_f32 %0, %1, %2" : "=v"(d) : "v"(a), "v"(b)); return d; }
#define LO2(v) __builtin_shufflevector(v, v, 0, 1)
#define HI2(v) __builtin_shufflevector(v, v, 2, 3)
__device__ __forceinline__ void phase_scan(const Args& a, LAS unsigned char* lds) {
    const int tid = opaque_tid(), lane = tid & 63, wave = tid >> 6;
    constexpr int TC = 32;
    LAS float* op = (LAS float*)lds;
    LAS float* vb = (LAS float*)(lds + (TC + 1) * 1280);
    LAS float* yb = (LAS float*)(lds + (TC + 1) * 1280 + (TC + 1) * 256);
    const bf16_t* Rg = (const bf16_t*)(a.ws + WS_R); const bf16_t* Kg = (const bf16_t*)(a.ws + WS_K); const bf16_t* Vg = (const bf16_t*)(a.ws + WS_V);
    const bf16_t* Lg = (const bf16_t*)(a.ws + WS_L); const bf16_t* WL2 = (const bf16_t*)(a.ws + WS_WL2);
    constexpr int XS = 68;
    LAS float* xb = (LAS float*)(lds + (TC + 1) * 1280 + (TC + 1) * 256 + TC * 1024);
    const int fr = lane & 15, fq = lane >> 4, stile = wave >> 2, ntile = wave & 3;
    bf16_t* YG = (bf16_t*)(a.ws + WS_YG);
    const int ts = tid >> 4, jg = tid & 15;
    const int ig = lane >> 4;
    const int r0 = wave * 8 + ig * 2;
    for (int hd = blockIdx.x; hd < NB * 16; hd += gridDim.x) {
        const int b = hd >> 4, h = hd & 15;
        const int ch = h * 64 + jg * 4;
        const f32x4 kk4 = *(const f32x4*)(a.in[22] + ch), ka4 = *(const f32x4*)(a.in[23] + ch), rk4 = *(const f32x4*)(a.in[24] + ch);
        const f32x4 lg4 = *(const f32x4*)(a.in[25] + ch), lb4 = *(const f32x4*)(a.in[26] + ch);
        const size_t base = ((size_t)b * T) * D + ch;
        f32x2 S0a = {0.f, 0.f}, S0b = {0.f, 0.f}, S1a = {0.f, 0.f}, S1b = {0.f, 0.f};
        size_t off = base + (size_t)ts * D;
        u32x2 pr = *(const u32x2*)(Rg + off), pk = *(const u32x2*)(Kg + off), pv = *(const u32x2*)(Vg + off);
        const int chn = h * 64 + ntile * 16 + fr;
        bf16x8 bw[2], ba[2], bg[5];
#pragma unroll
        for (int ks = 0; ks < 2; ++ks) { bw[ks] = *(const bf16x8*)(WL2 + (size_t)chn * 512 + ks * 32 + fq * 8); ba[ks] = *(const bf16x8*)(WL2 + (size_t)(1024 + chn) * 512 + 128 + ks * 32 + fq * 8); }
#pragma unroll
        for (int ks = 0; ks < 5; ++ks) bg[ks] = *(const bf16x8*)(WL2 + (size_t)(2048 + chn) * 512 + 256 + ks * 32 + fq * 8);
        const float w0c = a.in[14][chn], a0c = a.in[17][chn];
        bf16x8 aw[2], aa[2], ag[5];
#define LORA_LOAD(cc) do { const bf16_t* lrow = Lg + ((size_t)b * T + (size_t)(cc) * TC + stile * 16 + fr) * 512 + fq * 8; \
            _Pragma("unroll") for (int ks = 0; ks < 2; ++ks) { aw[ks] = *(const bf16x8*)(lrow + ks * 32); aa[ks] = *(const bf16x8*)(lrow + 128 + ks * 32); } \
            _Pragma("unroll") for (int ks = 0; ks < 5; ++ks) ag[ks] = *(const bf16x8*)(lrow + 256 + ks * 32); } while (0)
#define LORA_RUN() do { f32x4 cw = {0.f, 0.f, 0.f, 0.f}, ca = {0.f, 0.f, 0.f, 0.f}, cg_ = {0.f, 0.f, 0.f, 0.f}; \
            _Pragma("unroll") for (int ks = 0; ks < 2; ++ks) { cw = __builtin_amdgcn_mfma_f32_16x16x32_bf16(aw[ks], bw[ks], cw, 0, 0, 0); ca = __builtin_amdgcn_mfma_f32_16x16x32_bf16(aa[ks], ba[ks], ca, 0, 0, 0); } \
            _Pragma("unroll") for (int ks = 0; ks < 5; ++ks) cg_ = __builtin_amdgcn_mfma_f32_16x16x32_bf16(ag[ks], bg[ks], cg_, 0, 0, 0); \
            _Pragma("unroll") for (int e = 0; e < 4; ++e) { const int xi = (stile * 16 + 4 * fq + e) * XS + ntile * 16 + fr; \
                xb[xi] = __builtin_amdgcn_exp2f(-0.87503988f * __builtin_amdgcn_rcpf(1.0f + __expf(-(w0c + cw[e])))); \
                xb[TC * XS + xi] = __builtin_amdgcn_rcpf(1.0f + __expf(-(a0c + ca[e]))); \
                xb[2 * TC * XS + xi] = cg_[e]; } } while (0)
        LORA_LOAD(0); LORA_RUN();
        __syncthreads();
        u32x2 ypend = {0u, 0u};
        for (int c = 0; c < T / TC; ++c) {
            const f32x4 r4 = {bf_lo(pr.x), bf_hi(pr.x), bf_lo(pr.y), bf_hi(pr.y)};
            const f32x4 k4 = {bf_lo(pk.x), bf_hi(pk.x), bf_lo(pk.y), bf_hi(pk.y)};
            const f32x4 v4 = {bf_lo(pv.x), bf_hi(pv.x), bf_lo(pv.y), bf_hi(pv.y)};
            const f32x4 w4 = *(const LAS f32x4*)(xb + ts * XS + jg * 4), a4 = *(const LAS f32x4*)(xb + TC * XS + ts * XS + jg * 4), g4 = *(const LAS f32x4*)(xb + 2 * TC * XS + ts * XS + jg * 4);
            const f32x4 kkx = k4 * kk4;
            const float ss = reduce16((kkx.x * kkx.x + kkx.y * kkx.y) + (kkx.z * kkx.z + kkx.w * kkx.w));
            const float inv = __builtin_amdgcn_rsqf(fmaxf(ss, 1e-24f));
            const f32x4 kk = kkx * inv;
            const f32x4 kf = k4 * ((a4 - 1.0f) * ka4 + 1.0f);
            const f32x4 am = -kk, bm = kk * a4;
            const f32x4 rkr = r4 * kf * rk4;
            const float ct = reduce16((rkr.x + rkr.y) + (rkr.z + rkr.w));
            {
                LAS f32x4* o = (LAS f32x4*)(op + (ts * 16 + jg) * 20);
                o[0] = w4; o[1] = am; o[2] = bm; o[3] = kf; o[4] = r4;
                *(LAS f32x4*)(vb + ts * 64 + jg * 4) = v4;
            }
            __syncthreads();
            if (c > 0) *(u32x2*)(YG + base + (size_t)((c - 1) * TC + ts) * D) = ypend;
            if (c + 1 < T / TC) { off = base + (size_t)((c + 1) * TC + ts) * D;
                pr = *(const u32x2*)(Rg + off); pk = *(const u32x2*)(Kg + off); pv = *(const u32x2*)(Vg + off);
                LORA_LOAD(c + 1); }
            {
                const LAS float* obase = op + (lane & 15) * 20;
                const LAS float* vbase = vb + r0;
                f32x4 ow = *(const LAS f32x4*)(obase), oa = *(const LAS f32x4*)(obase + 4), ob = *(const LAS f32x4*)(obase + 8), ok = *(const LAS f32x4*)(obase + 12), orr = *(const LAS f32x4*)(obase + 16);
                f32x2 vv = *(const LAS f32x2*)(vbase);
#pragma unroll 4
                for (int s = 0; s < TC; ++s) {
                    const LAS float* o = obase + (s + 1) * 320;
                    const f32x4 now = *(const LAS f32x4*)(o), noa = *(const LAS f32x4*)(o + 4), nob = *(const LAS f32x4*)(o + 8), nok = *(const LAS f32x4*)(o + 12), norr = *(const LAS f32x4*)(o + 16);
                    const f32x2 nvv = *(const LAS f32x2*)(vbase + (s + 1) * 64);
                    const f32x2 p0 = pkfma_(S0b, HI2(oa), pkmul_(S0a, LO2(oa))), p1 = pkfma_(S1b, HI2(oa), pkmul_(S1a, LO2(oa)));
                    float sa0 = add_(p0.x, p0.y), sa1 = add_(p1.x, p1.y);
                    sa0 = reduce16(sa0); asm volatile("" : "+v"(sa0)); sa1 = reduce16(sa1);
                    const f32x2 sap = {sa0, sa1};
                    S0a = pkfma_lo_(vv, LO2(ok), pkfma_lo_(sap, LO2(ob), pkmul_(S0a, LO2(ow))));
                    S0b = pkfma_lo_(vv, HI2(ok), pkfma_lo_(sap, HI2(ob), pkmul_(S0b, HI2(ow))));
                    S1a = pkfma_hi_(vv, LO2(ok), pkfma_hi_(sap, LO2(ob), pkmul_(S1a, LO2(ow))));
                    S1b = pkfma_hi_(vv, HI2(ok), pkfma_hi_(sap, HI2(ob), pkmul_(S1b, HI2(ow))));
                    const f32x2 q0 = pkfma_(S0b, HI2(orr), pkmul_(S0a, LO2(orr))), q1 = pkfma_(S1b, HI2(orr), pkmul_(S1a, LO2(orr)));
                    float y0 = add_(q0.x, q0.y), y1 = add_(q1.x, q1.y);
                    y0 += dppf<0xB1>(y0); y1 += dppf<0xB1>(y1); y0 += dppf<0x4E>(y0); y1 += dppf<0x4E>(y1);
                    if ((lane & 3) == 0) *(LAS f32x2*)(yb + (s * 4 + ((lane >> 2) & 3)) * 64 + r0) = (f32x2){y0, y1};
                    ow = now; oa = noa; ob = nob; ok = nok; orr = norr; vv = nvv;
                }
            }
            __syncthreads();
            {
                const f32x4 y4 = (*(const LAS f32x4*)(yb + (ts * 4 + 0) * 64 + jg * 4) + *(const LAS f32x4*)(yb + (ts * 4 + 1) * 64 + jg * 4)) + (*(const LAS f32x4*)(yb + (ts * 4 + 2) * 64 + jg * 4) + *(const LAS f32x4*)(yb + (ts * 4 + 3) * 64 + jg * 4));
                const float mean = reduce16((y4.x + y4.y) + (y4.z + y4.w)) * (1.f / 64.f);
                const f32x4 d = y4 - mean;
                const float var = reduce16((d.x * d.x + d.y * d.y) + (d.z * d.z + d.w * d.w)) * (1.f / 64.f);
                const float rstd = __builtin_amdgcn_rsqf(var + 64e-5f);
                const f32x4 o = ((d * rstd) * lg4 + lb4 + v4 * ct) * g4;
                u32x2 w; w.x = cvt_pk_bf16(o.x, o.y); w.y = cvt_pk_bf16(o.z, o.w);
                ypend = w;
            }
            if (c + 1 < T / TC) LORA_RUN();
            __syncthreads();
        }
        *(u32x2*)(YG + base + (size_t)((T / TC - 1) * TC + ts) * D) = ypend;
#undef LORA_LOAD
#undef LORA_RUN
    }
}


#define SEAM() do { ++ph; if (lo < ph && ph < hi) { if (ph == 1) gsync(grid); else xcd_barrier(xbar); } } while (0)
#define RUN (lo <= ph && ph < hi)
template <int l> __device__ __forceinline__ void layer(const Args& a, LAS unsigned char* lds, cg::grid_group& grid, const XcdBarrier& xbar, int& ph, const int lo, const int hi) {
    unsigned char* ws = a.ws;
    const float* MOD = (const float*)(ws + WS_MOD);
    bf16_t* H = (bf16_t*)(ws + WS_H);
    const int G = gridDim.x, c = blockIdx.x;
    const float* mod = MOD + (size_t)l * 16 * 6144;
    const float* xin = (l == 0) ? a.in[0] : a.out;
    if (RUN) { if (l == 0) phase_weights(a, lds); if (l == 1) phase_norm_shift(xin, mod + 0 * 1024, mod + 1 * 1024, a.in[12], (bf16_t*)(ws + WS_X3), (bf16_t*)(ws + WS_H2)); else phase_norm_mod(xin, mod + 0 * 1024, mod + 1 * 1024, H, 0); }
    SEAM();
    if (l == 0) {
        if (RUN) { pg8::Gemm g{H, (const bf16_t*)(ws + WS_WIN0), M, 2048, 1024, 0}; pg8::StaticOrder S; S.init(M, 2048, G, c);
          pg8::EpiAct<1> E{(bf16_t*)(ws + WS_UV), 2048}; pg8::gemm_phase(lds, g, S, E); }
        SEAM();
        if (RUN) phase_sgu(a, lds);
        SEAM();
        if (RUN) { pg8::Gemm g{(const bf16_t*)(ws + WS_Z), (const bf16_t*)(ws + WS_WOUT0), M, 1024, 1024, 0}; pg8::StaticOrder S; S.init(M, 1024, G, c);
          pg8::EpiRes E{a.in[0], a.out, mod + 2 * 1024, 6144}; pg8::gemm_phase(lds, g, S, E); }
    } else {
        if (RUN) { pg8::Gemm g{(const bf16_t*)(ws + WS_H2), (const bf16_t*)(ws + WS_WL1), M, 512, 2048, 0}; pg8::StaticOrder S; S.init(M, 512, G, c, 1);
          pg8::EpiRkvL E{(bf16_t*)(ws + WS_R), (size_t)(WS_K - WS_R) / 2, (bf16_t*)(ws + WS_L), 12}; pg8::gemm_phase(lds, g, S, E); }
        SEAM();
        if (RUN) { pg8::Gemm g{(const bf16_t*)(ws + WS_X3), (const bf16_t*)(ws + WS_WRKV), M, 3072, 1024, (long)M * D}; pg8::StaticOrder S; S.init(M, 3072, G, c, 1);
          pg8::EpiRkvL E{(bf16_t*)(ws + WS_R), (size_t)(WS_K - WS_R) / 2, (bf16_t*)(ws + WS_L), 0}; pg8::gemm_phase(lds, g, S, E); }
        SEAM();
        if (RUN) phase_scan(a, lds);
        SEAM();
        if (RUN) { pg8::Gemm g{(const bf16_t*)(ws + WS_YG), (const bf16_t*)(ws + WS_WOUT1), M, 1024, 1024, 0}; pg8::StaticOrder S; S.init(M, 1024, G, c);
          pg8::EpiRes E{a.out, a.out, mod + 2 * 1024, 6144}; pg8::gemm_phase(lds, g, S, E); }
    }
    SEAM();
    if (RUN) phase_norm_mod(a.out, mod + 3 * 1024, mod + 4 * 1024, H, 0);
    SEAM();
    if (RUN) { pg8::Gemm g{H, (const bf16_t*)(ws + WS_W1 + (size_t)l * 4096 * 1024 * 2), M, 4096, 1024, 0}; pg8::StaticOrder S; S.init(M, 4096, G, c);
      pg8::EpiAct<2> E{(bf16_t*)(ws + WS_HID), 4096}; pg8::gemm_phase(lds, g, S, E); }
    SEAM();
    if (RUN) { pg8::Gemm g{(const bf16_t*)(ws + WS_HID), (const bf16_t*)(ws + WS_W2 + (size_t)l * 1024 * 4096 * 2), M, 1024, 4096, 0}; pg8::StaticOrder S; S.init(M, 1024, G, c, 1);
      pg8::EpiRes E{a.out, a.out, mod + 5 * 1024, 6144}; pg8::gemm_phase(lds, g, S, E); }
    SEAM();
}
constexpr int NPHASES = 17;

__global__ void __launch_bounds__(NTHREADS, 2) fwd_megakernel(Args a) {
    extern __shared__ __attribute__((aligned(16))) unsigned char lds_raw[];
    LAS unsigned char* lds = (LAS unsigned char*)lds_raw;
    cg::grid_group grid = cg::this_grid();
    const int lo = a.lo, hi = a.hi;
    int ph = 0;
    volatile LAS unsigned* bst = (volatile LAS unsigned*)(lds + 131072 + 512);
    if (threadIdx.x < 2) bst[threadIdx.x] = 0u;
    __syncthreads();
    XcdBarrier xbar; xbar.bar = (unsigned*)a.ws; xbar.x = 0; xbar.st = nullptr;
    if (hi - lo > 1) xbar = xcd_barrier_post((unsigned*)a.ws, bst);
    if (RUN) phase_prep(a, lds);
    SEAM();
    layer<0>(a, lds, grid, xbar, ph, lo, hi);
    layer<1>(a, lds, grid, xbar, ph, lo, hi);
    if (RUN) phase_final_norm(a.out, a.in[28]);
}
#ifndef N_LAUNCHES
#define N_LAUNCHES 1
#endif

extern "C" void kernel_launch(void* const* d_in, const int* in_sizes, int n_in, void* d_out, int out_size, void* d_ws, size_t ws_size, hipStream_t stream) {
    static int grid = 0;
    if (grid == 0) {
        if (n_in != 29 || out_size != M * D || ws_size < WS_END) { fprintf(stderr, "kernel_launch: unexpected problem: n_in %d out %d ws %zu (need %zu)\n", n_in, out_size, ws_size, (size_t)WS_END); grid = -1; return; }
        int dev = 0, cus = 0, per_cu = 0;
        hipGetDevice(&dev);
        hipDeviceGetAttribute(&cus, hipDeviceAttributeMultiprocessorCount, dev);
        if (hipFuncSetAttribute((const void*)fwd_megakernel, hipFuncAttributeMaxDynamicSharedMemorySize, LDS_BYTES) != hipSuccess) { fprintf(stderr, "kernel_launch: hipFuncSetAttribute failed\n"); grid = -1; return; }
        if (hipOccupancyMaxActiveBlocksPerMultiprocessor(&per_cu, (const void*)fwd_megakernel, NTHREADS, LDS_BYTES) != hipSuccess || per_cu < 1) { fprintf(stderr, "kernel_launch: occupancy query says %d blocks/CU\n", per_cu); per_cu = 1; }
        (void)hipGetLastError();
        grid = cus;
    }
    if (grid < 0) return;
    Args a{};
    for (int i = 0; i < 29; ++i) a.in[i] = (const float*)d_in[i];
    a.out = (float*)d_out; a.ws = (unsigned char*)d_ws;
    if (N_LAUNCHES == 1) {
        if (hipMemsetAsync(d_ws, 0, 16384, stream) != hipSuccess) { fprintf(stderr, "kernel_launch: memset of the barrier words failed\n"); return; }
        a.lo = 0; a.hi = NPHASES;
        void* args[] = {&a};
        hipError_t e = hipLaunchCooperativeKernel((const void*)fwd_megakernel, dim3(grid), dim3(NTHREADS), args, LDS_BYTES, stream);
        if (e != hipSuccess) fprintf(stderr, "kernel_launch: cooperative launch failed: %s (grid %d)\n", hipGetErrorString(e), grid);
    } else {
        for (int p = 0; p < NPHASES; ++p) { a.lo = p; a.hi = p + 1;
            hipLaunchKernelGGL(fwd_megakernel, dim3(grid), dim3(NTHREADS), LDS_BYTES, stream, a); }
    }
}
```

```cpp
#include <hip/hip_runtime.h>
#include <hip/hip_cooperative_groups.h>
#include <cstdio>
#include <cstdint>
namespace cg = cooperative_groups;

#define LAS __attribute__((address_space(3)))
typedef unsigned short bf16_t;
typedef short bf16x8 __attribute__((ext_vector_type(8)));
typedef float f32x4 __attribute__((ext_vector_type(4)));
typedef float f32x2 __attribute__((ext_vector_type(2)));
typedef unsigned u32x4 __attribute__((ext_vector_type(4)));
typedef unsigned u32x2 __attribute__((ext_vector_type(2)));

constexpr int D = 1024, NB = 16, T = 4096, M = NB * T, FF = 4096, NMOD = 6;
constexpr int NTHREADS = 512, NWAVES = 8;

__device__ __forceinline__ int opaque_tid() { int t = threadIdx.x; asm volatile("" : "+v"(t)); return t; }
__device__ __forceinline__ unsigned cvt_pk_bf16(float lo, float hi) { unsigned r; asm volatile("v_cvt_pk_bf16_f32 %0, %1, %2" : "=v"(r) : "v"(lo), "v"(hi)); return r; }
__device__ __forceinline__ float bf_lo(unsigned u) { return __builtin_bit_cast(float, u << 16); }
__device__ __forceinline__ float bf_hi(unsigned u) { return __builtin_bit_cast(float, u & 0xffff0000u); }
__device__ __forceinline__ float sigmoidf_(float x) { return __builtin_amdgcn_rcpf(1.0f + __expf(-x)); }

namespace pg8 {
constexpr int BM = 256, BK = 64, HALF = 128, HTB = HALF * BK * 2, STAGE_BYTES = 8 * HTB, NXCD = 8, WGM = 8;
__host__ __device__ __forceinline__ int lds_byte(int r, int c) { const int st = (r >> 4) * 2 + (c >> 5), rr = r & 15, cc = c & 31, ob = rr * 64 + cc * 2; return st * 1024 + (ob ^ (((ob >> 9) & 1) << 5)); }
__host__ __device__ __forceinline__ void stage_rc(int b, int& R, int& C) { const int st = b / 1024, sb = b % 1024, swz = sb ^ (((sb >> 9) & 1) << 5); R = (st >> 1) * 16 + swz / 64; C = (st & 1) * 32 + (swz % 64) / 2; }
__host__ __device__ __forceinline__ int perm32(int rho) { const int n = rho >> 4, i = rho & 15; return 8 * (i >> 2) + 4 * n + (i & 3); }

struct Unit { int pm, pn; };
struct Gemm { const bf16_t* A; const bf16_t* Bt; int M, N, K; long asplit; int shift; };

struct StaticOrder {
    int nM, nN, nwg, G, c, rev;
    __device__ void init(int M_, int N_, int G_, int c_, int rev_ = 0) { nM = M_ / BM; nN = N_ / BM; nwg = nM * nN; G = G_; c = c_; rev = rev_; }
    __device__ bool next(int i, Unit& u) const {
        const long L = (long)i * G + c; if (L >= nwg) return false;
        int wgid = (int)L; { const int q = nwg / NXCD, r = nwg % NXCD, xcd = wgid % NXCD, off = wgid / NXCD; wgid = (xcd < r ? xcd * (q + 1) : r * (q + 1) + (xcd - r) * q) + off; }
        const int nig = WGM * nN, gid = wgid / nig, fm = gid * WGM, gsz = (nM - fm) < WGM ? (nM - fm) : WGM;
        u.pm = fm + ((wgid % nig) % gsz); u.pn = (wgid % nig) / gsz; if (rev) u.pm = nM - 1 - u.pm; return true;
    }
};

__device__ __forceinline__ f32x2 gelu_pk(f32x2 v) {
    const f32x2 av = __builtin_elementwise_abs(v), d = av * 0.2316418882f + 1.0f;
    f32x2 t; t.x = __builtin_amdgcn_rcpf(d.x); t.y = __builtin_amdgcn_rcpf(d.y);
    f32x2 q = t * 0.5307027145f + (-0.7265760135f); q = q * t + 0.7107068705f; q = q * t + (-0.142248368f); q = q * t + 0.127414796f; q = q * t;
    const f32x2 s = (v * v) * (-0.72134752044f);
    f32x2 e; e.x = __builtin_amdgcn_exp2f(s.x); e.y = __builtin_amdgcn_exp2f(s.y);
    const f32x2 m = v * (q * e), r = v - m;
    f32x2 o; o.x = v.x < 0.f ? m.x : r.x; o.y = v.y < 0.f ? m.y : r.y; return o;
}

template <int ACT  > struct EpiAct {
    static constexpr bool PERM = true;
    bf16_t* O; int ldc;
    __device__ __forceinline__ void operator()(const f32x4 (&acc)[2][2][4][2], const Unit& u, int wr, int wc, int fr, int fq) const {
        const int row0 = u.pm * BM + wr * 64 + fr; const int col0 = u.pn * BM + wc * 32 + 8 * fq;
#pragma unroll
        for (int ai = 0; ai < 2; ++ai)
#pragma unroll
            for (int m = 0; m < 4; ++m) { bf16_t* rowp = O + (size_t)(row0 + ai * HALF + m * 16) * ldc + col0;
#pragma unroll
                for (int bj = 0; bj < 2; ++bj) { f32x4 v0 = acc[ai][bj][m][0], v1 = acc[ai][bj][m][1];
                    if (ACT == 1) { f32x2 a = gelu_pk((f32x2){v0[0], v0[1]}), b = gelu_pk((f32x2){v0[2], v0[3]}), c = gelu_pk((f32x2){v1[0], v1[1]}), d = gelu_pk((f32x2){v1[2], v1[3]});
                        v0 = (f32x4){a.x, a.y, b.x, b.y}; v1 = (f32x4){c.x, c.y, d.x, d.y}; }
                    if (ACT == 2) {
#pragma unroll
                        for (int e = 0; e < 4; ++e) { float p = fmaxf(v0[e], 0.f), q = fmaxf(v1[e], 0.f); v0[e] = p * p; v1[e] = q * q; } }
                    u32x4 w; w.x = cvt_pk_bf16(v0[0], v0[1]); w.y = cvt_pk_bf16(v0[2], v0[3]); w.z = cvt_pk_bf16(v1[0], v1[1]); w.w = cvt_pk_bf16(v1[2], v1[3]);
                    *(u32x4*)(rowp + bj * HALF) = w; } }
    }
};
struct EpiRkvL {
    static constexpr bool PERM = true;
    bf16_t* R; size_t split_stride; bf16_t* L; int pn_off;
    __device__ __forceinline__ void operator()(const f32x4 (&acc)[2][2][4][2], const Unit& u0, int wr, int wc, int fr, int fq) const {
        Unit u = u0; u.pn += pn_off;
        const int row0 = u.pm * BM + wr * 64 + fr;
        bf16_t* base; int ldc, colt, mode;
        if (u.pn < 12) { base = R + (size_t)(u.pn >> 2) * split_stride; colt = (u.pn & 3) * BM; ldc = 1024; mode = 0; }
        else { base = L; colt = (u.pn - 12) * BM; ldc = 512; mode = (u.pn == 12) ? 1 : 2; }
        const int col0 = colt + wc * 32 + 8 * fq;
#pragma unroll
        for (int ai = 0; ai < 2; ++ai)
#pragma unroll
            for (int m = 0; m < 4; ++m) { bf16_t* rowp = base + (size_t)(row0 + ai * HALF + m * 16) * ldc + col0;
#pragma unroll
                for (int bj = 0; bj < 2; ++bj) { f32x4 v0 = acc[ai][bj][m][0], v1 = acc[ai][bj][m][1];
                    if (mode == 1 && bj == 0) {
#pragma unroll
                        for (int e = 0; e < 4; ++e) { v0[e] = tanhf(v0[e]); v1[e] = tanhf(v1[e]); } }
                    if (mode == 2) {
#pragma unroll
                        for (int e = 0; e < 4; ++e) { v0[e] = sigmoidf_(v0[e]); v1[e] = sigmoidf_(v1[e]); } }
                    u32x4 w; w.x = cvt_pk_bf16(v0[0], v0[1]); w.y = cvt_pk_bf16(v0[2], v0[3]); w.z = cvt_pk_bf16(v1[0], v1[1]); w.w = cvt_pk_bf16(v1[2], v1[3]);
                    *(u32x4*)(rowp + bj * HALF) = w; } }
    }
};
struct EpiL2 {
    static constexpr bool PERM = true;
    bf16_t* O0; bf16_t* O1; bf16_t* O2; const float* w0; const float* a0;
    __device__ __forceinline__ void operator()(const f32x4 (&acc)[2][2][4][2], const Unit& u, int wr, int wc, int fr, int fq) const {
        const int mode = u.pn >> 2;
        const int row0 = u.pm * BM + wr * 64 + fr; const int col0 = (u.pn & 3) * BM + wc * 32 + 8 * fq;
        bf16_t *o0 = O0, *o1 = O1, *o2 = O2; const float *bw = w0, *ba = a0;
        asm volatile("" : "+s"(o0), "+s"(o1), "+s"(o2), "+s"(bw), "+s"(ba));
        bf16_t* base = (mode == 0) ? o0 : ((mode == 1) ? o1 : o2);
        const float* bias = (mode == 0) ? bw : ba;
#pragma unroll
        for (int bj = 0; bj < 2; ++bj) {
            f32x4 b0 = {0.f, 0.f, 0.f, 0.f}, b1 = {0.f, 0.f, 0.f, 0.f};
            if (mode != 2) { b0 = *(const f32x4*)(bias + col0 + bj * HALF); b1 = *(const f32x4*)(bias + col0 + bj * HALF + 4); }
#pragma unroll
            for (int ai = 0; ai < 2; ++ai)
#pragma unroll
                for (int m = 0; m < 4; ++m) { bf16_t* rowp = base + (size_t)(row0 + ai * HALF + m * 16) * 1024 + col0;
                    f32x4 v0 = acc[ai][bj][m][0] + b0, v1 = acc[ai][bj][m][1] + b1;
                    if (mode != 2) {
                        const float sc = (mode == 0) ? -0.87503988f : 1.0f;
#pragma unroll
                        for (int e = 0; e < 4; ++e) { v0[e] = sc * __builtin_amdgcn_rcpf(1.0f + __expf(-v0[e])); v1[e] = sc * __builtin_amdgcn_rcpf(1.0f + __expf(-v1[e])); } }
                    u32x4 w; w.x = cvt_pk_bf16(v0[0], v0[1]); w.y = cvt_pk_bf16(v0[2], v0[3]); w.z = cvt_pk_bf16(v1[0], v1[1]); w.w = cvt_pk_bf16(v1[2], v1[3]);
                    *(u32x4*)(rowp + bj * HALF) = w;
                    if (m & 1) asm volatile("" ::: "memory"); }
        }
    }
};
struct EpiRes {
    static constexpr bool PERM = false;
    const float* base; float* out; const float* gate;
    int gstride;
    __device__ __forceinline__ void operator()(const f32x4 (&acc)[2][2][4][2], const Unit& u, int wr, int wc, int fr, int fq) const {
        const int col0 = u.pn * BM + wc * 32 + 4 * fq;
        const float* gp = gate + (size_t)(u.pm >> 4) * gstride + col0;
        f32x4 gv[2][2];
#pragma unroll
        for (int bj = 0; bj < 2; ++bj)
#pragma unroll
            for (int n = 0; n < 2; ++n) gv[bj][n] = *(const f32x4*)(gp + bj * HALF + n * 16);
#pragma unroll
        for (int ai = 0; ai < 2; ++ai)
#pragma unroll
            for (int m = 0; m < 4; ++m) { const size_t off = (size_t)(u.pm * BM + ai * HALF + wr * 64 + m * 16 + fr) * 1024 + col0;
#pragma unroll
                for (int bj = 0; bj < 2; ++bj)
#pragma unroll
                    for (int n = 0; n < 2; ++n) { const f32x4 bs = *(const f32x4*)(base + off + bj * HALF + n * 16);
                        *(f32x4*)(out + off + bj * HALF + n * 16) = bs + gv[bj][n] * acc[ai][bj][m][n]; } }
    }
};

template <class Epi>
__device__ __forceinline__ void gemm_phase(LAS unsigned char* lds, const Gemm g, const StaticOrder& S, const Epi& E) {
    const int tid = opaque_tid(), wid = __builtin_amdgcn_readfirstlane(tid >> 6), lane = tid & 63, wr = wid >> 2, wc = wid & 3, fr = lane & 15, fq = lane >> 4;
    int K_ = g.K; asm volatile("" : "+s"(K_));
    const int K = K_, nt = K / BK, lda = g.shift ? (K_ >> 1) : K_;
    const int ntA = g.shift ? (nt >> 1) : (1 << 30);
    const long adj = g.shift ? ((long)lda * 2 + (long)ntA * (BK * 2)) : 0;
    unsigned voffA[2], voffB[2];
#pragma unroll
    for (int i = 0; i < 2; ++i) { int R, C; stage_rc(tid * 16 + i * 8192, R, C); const int Rb = Epi::PERM ? ((R & ~31) + perm32(R & 31)) : R;
        voffA[i] = (unsigned)(R * lda + C) * 2u; voffB[i] = (unsigned)(Rb * K + C) * 2u; }
    const long kstep = (long)(BK * 2);
    const long hstepA = (long)HALF * lda * 2, hstepB = (long)HALF * K * 2, tstepB = 2 * hstepB;
    const unsigned ldsw = (unsigned)wid * 1024u;
    const int aoff = lds_byte(wr * 64 + fr, fq * 8), boff = lds_byte(wc * 32 + fr, fq * 8);
#define PG8_ABASE(u) ((const char*)g.A + ((long)((u).pn >> 2) * g.asplit + ((long)(u).pm * BM + (g.shift ? ((u).pm >> 4) + 1 : 0)) * (long)lda) * 2)
#define PG8_APTR(base, kt) ((base) + ((long)(kt) * kstep - (((kt) >= ntA) ? adj : 0)))
#define PG8_SA(b, h) (((b) * 2 + (h)) * HTB)
#define PG8_SB(b, h) ((4 + (b) * 2 + (h)) * HTB)
#define PG8_STAGE(bufoff, gbase, voff) do { _Pragma("unroll") for (int _i = 0; _i < 2; ++_i) \
        __builtin_amdgcn_global_load_lds((const unsigned*)((const char*)(gbase) + (voff)[_i]), (LAS unsigned*)(lds + (bufoff) + ldsw + _i * 8192), 16, 0, 0); } while (0)
#define PG8_LDA(dst, b, h) do { _Pragma("unroll") for (int m = 0; m < 4; ++m) _Pragma("unroll") for (int k = 0; k < 2; ++k) dst[m][k] = *(const LAS bf16x8*)(lds + PG8_SA(b, h) + aoff + m * 2048 + k * 1024); } while (0)
#define PG8_LDB(dst, b, h) do { _Pragma("unroll") for (int n = 0; n < 2; ++n) _Pragma("unroll") for (int k = 0; k < 2; ++k) dst[n][k] = *(const LAS bf16x8*)(lds + PG8_SB(b, h) + boff + n * 2048 + k * 1024); } while (0)
#define PG8_MMA(ai, bj, At, Bt) do { __builtin_amdgcn_s_setprio(1); _Pragma("unroll") for (int m = 0; m < 4; ++m) _Pragma("unroll") for (int n = 0; n < 2; ++n) _Pragma("unroll") for (int k = 0; k < 2; ++k) \
        acc[ai][bj][m][n] = __builtin_amdgcn_mfma_f32_16x16x32_bf16(Bt[n][k], At[m][k], acc[ai][bj][m][n], 0, 0, 0); __builtin_amdgcn_s_setprio(0); } while (0)
#define PG8_WAIT_V(n) asm volatile("s_waitcnt vmcnt(" #n ")" ::: "memory")
#define PG8_WAIT_L(n) asm volatile("s_waitcnt lgkmcnt(" #n ")" ::: "memory")
#define PG8_BAR __builtin_amdgcn_s_barrier()
#define PG8_SCHED __builtin_amdgcn_sched_barrier(0)
    Unit cur, nxt; int ui = 0;
    if (!S.next(0, cur)) return;
    f32x4 acc[2][2][4][2];
#pragma unroll
    for (int a = 0; a < 2; ++a)
#pragma unroll
        for (int b = 0; b < 2; ++b)
#pragma unroll
            for (int m = 0; m < 4; ++m)
#pragma unroll
                for (int n = 0; n < 2; ++n) acc[a][b][m][n] = (f32x4){0.f, 0.f, 0.f, 0.f};
    bf16x8 At[4][2], B0[2][2], B1[2][2];
    const char* cA = PG8_ABASE(cur); const char* cB = (const char*)g.Bt + (long)cur.pn * tstepB;
    PG8_STAGE(PG8_SB(0, 0), cB, voffB); PG8_STAGE(PG8_SB(0, 1), cB + hstepB, voffB); PG8_STAGE(PG8_SA(0, 0), cA, voffA); PG8_STAGE(PG8_SA(0, 1), cA + hstepA, voffA);
    if (wr == 1) PG8_BAR;
    PG8_WAIT_V(2); PG8_BAR;
    PG8_STAGE(PG8_SB(1, 0), cB + kstep, voffB); PG8_STAGE(PG8_SA(1, 0), cA + kstep, voffA); PG8_STAGE(PG8_SB(1, 1), cB + hstepB + kstep, voffB);
    PG8_WAIT_V(6); PG8_BAR;
    for (;;) {
        const bool has_next = S.next(ui + 1, nxt);
        const char* nA = has_next ? PG8_ABASE(nxt) : cA; const char* nB = has_next ? (const char*)g.Bt + (long)nxt.pn * tstepB : cB;
        for (int t = 0; t < nt; t += 2) {
            const bool last = (t == nt - 2);
            const char* a1 = PG8_APTR(cA, t + 1);
            const char* a2 = last ? nA : PG8_APTR(cA, t + 2); const char* b2 = last ? nB : cB + (long)(t + 2) * kstep;
            const char* a3 = a2 + kstep; const char* b3 = b2 + kstep;
            PG8_LDB(B0, 0, 0); PG8_LDB(B1, 0, 1); PG8_SCHED; PG8_LDA(At, 0, 0); PG8_STAGE(PG8_SA(1, 1), a1 + hstepA, voffA);
            PG8_WAIT_V(8); PG8_WAIT_L(0); PG8_BAR; PG8_MMA(0, 0, At, B0); PG8_MMA(0, 1, At, B1); PG8_BAR; PG8_SCHED;
            PG8_LDA(At, 0, 1); PG8_STAGE(PG8_SB(0, 0), b2, voffB); PG8_STAGE(PG8_SB(0, 1), b2 + hstepB, voffB); PG8_STAGE(PG8_SA(0, 0), a2, voffA);
            PG8_WAIT_V(8); PG8_WAIT_L(0); PG8_BAR; PG8_MMA(1, 0, At, B0); PG8_MMA(1, 1, At, B1); PG8_BAR; PG8_SCHED;
            PG8_LDB(B0, 1, 0); PG8_LDB(B1, 1, 1); PG8_SCHED; PG8_LDA(At, 1, 0); PG8_STAGE(PG8_SA(0, 1), a2 + hstepA, voffA);
            PG8_WAIT_V(8); PG8_WAIT_L(0); PG8_BAR; PG8_MMA(0, 0, At, B0); PG8_MMA(0, 1, At, B1); PG8_BAR; PG8_SCHED;
            PG8_LDA(At, 1, 1); PG8_STAGE(PG8_SB(1, 0), b3, voffB); PG8_STAGE(PG8_SB(1, 1), b3 + hstepB, voffB); PG8_STAGE(PG8_SA(1, 0), a3, voffA);
            PG8_WAIT_V(8); PG8_WAIT_L(0); PG8_BAR; PG8_MMA(1, 0, At, B0); PG8_MMA(1, 1, At, B1); PG8_BAR; PG8_SCHED;
        }
        if (wr == 0) PG8_BAR;
        E(acc, cur, wr, wc, fr, fq);
        if (!has_next) break;
#pragma unroll
        for (int a = 0; a < 2; ++a)
#pragma unroll
            for (int b = 0; b < 2; ++b)
#pragma unroll
                for (int m = 0; m < 4; ++m)
#pragma unroll
                    for (int n = 0; n < 2; ++n) acc[a][b][m][n] = (f32x4){0.f, 0.f, 0.f, 0.f};
        cur = nxt; cA = nA; cB = nB; ++ui;
        if (wr == 1) PG8_BAR;
    }
    PG8_WAIT_V(0);
    PG8_BAR;
#undef PG8_ABASE
#undef PG8_APTR
#undef PG8_SA
#undef PG8_SB
#undef PG8_STAGE
#undef PG8_LDA
#undef PG8_LDB
#undef PG8_MMA
#undef PG8_WAIT_V
#undef PG8_WAIT_L
#undef PG8_BAR
#undef PG8_SCHED
}
}

constexpr size_t MiB = 1u << 20;
constexpr size_t WS_MOD = 1 * MiB;
constexpr size_t WS_WIN0 = 2 * MiB;
constexpr size_t WS_WOUT0 = 6 * MiB;
constexpr size_t WS_W1 = 8 * MiB;
constexpr size_t WS_W2 = 24 * MiB;
constexpr size_t WS_WRKV = 40 * MiB;
constexpr size_t WS_WL1 = 46 * MiB;
constexpr size_t WS_WL2 = 48 * MiB;
constexpr size_t WS_WOUT1 = 51 * MiB;
constexpr size_t WS_WS = 53 * MiB;
constexpr size_t WS_H = 60 * MiB;
constexpr size_t WS_UV = 188 * MiB;
constexpr size_t WS_Z = 444 * MiB;
constexpr size_t WS_HID = 188 * MiB;
constexpr size_t WS_X3 = 54 * MiB;
constexpr size_t WS_H2 = 438 * MiB;
constexpr size_t WS_L = 952 * MiB;
constexpr size_t WS_R = 567 * MiB, WS_K = 695 * MiB, WS_V = 823 * MiB;
constexpr size_t WS_WE = 60 * MiB, WS_A = 188 * MiB, WS_G = 316 * MiB;
constexpr size_t WS_YG = 54 * MiB;
constexpr size_t WS_END = 1020 * MiB;
constexpr int LDS_BYTES = 147456;

struct Args {
    const float* in[29];
    float* out; unsigned char* ws;
    int lo, hi;
};

__device__ __forceinline__ float wave_sum(float v) {
#pragma unroll
    for (int o = 1; o < 64; o <<= 1) v += __shfl_xor(v, o);
    return v;
}
template <int CTRL> __device__ __forceinline__ float dppf(float v) { return __builtin_bit_cast(float, __builtin_amdgcn_update_dpp(0, __builtin_bit_cast(int, v), CTRL, 0xF, 0xF, true)); }
__device__ __forceinline__ float reduce16(float v) {
    v += dppf<0xB1>(v); v += dppf<0x4E>(v); v += dppf<0x141>(v); v += dppf<0x140>(v); return v;
}

#define XB_TMO      128
#define XB_XCNT(j)  (256  + 64 * (j))
#define XB_XSUB(j)  (1280 + 64 * (j))
#define XB_XGEN(j)  (2304 + 64 * (j))
#define XB_TOP      3328
#define XB_TOPGEN   3392
#define XCD_BAR_WORDS 3456
#define XB_SPIN_CAP (1u << 18)

__device__ __forceinline__ unsigned xb_ld(unsigned* p)              { return __hip_atomic_load(p, __ATOMIC_RELAXED, __HIP_MEMORY_SCOPE_AGENT); }
__device__ __forceinline__ unsigned xb_add(unsigned* p, unsigned v) { return __hip_atomic_fetch_add(p, v, __ATOMIC_RELAXED, __HIP_MEMORY_SCOPE_AGENT); }
__device__ __forceinline__ unsigned xb_xcc_id() { return (unsigned)__builtin_amdgcn_s_getreg((3 << 11) | 20) & 0xFu; }
#define XB_SPIN(cond, bar) do { unsigned _sp = 0; while (cond) { __builtin_amdgcn_s_sleep(1); \
    if ((++_sp & 255u) == 0u) { if (xb_ld(&(bar)[XB_TMO])) break; if (_sp > XB_SPIN_CAP) { atomicAdd(&(bar)[XB_TMO], 1u); break; } } } } while (0)

struct XcdBarrier {
    unsigned* bar; unsigned x;
    volatile LAS unsigned* st;
};

__device__ __forceinline__ XcdBarrier xcd_barrier_post(unsigned* bar, volatile LAS unsigned* st) {
    XcdBarrier b; b.bar = bar; b.x = xb_xcc_id(); b.st = st;
    if (threadIdx.x == 0) (void)xb_add(&bar[XB_XCNT(b.x)], 1u);
    return b;
}
__device__ __forceinline__ void xcd_barrier_complete(unsigned* bar, unsigned x, unsigned& nloc, unsigned& nx) {
    const unsigned G = gridDim.x * gridDim.y * gridDim.z;
    unsigned sum, cnt, mine, sp = 0u;
    for (;;) {
        sum = 0u; cnt = 0u; mine = 0u;
#pragma unroll
        for (unsigned j = 0; j < 16; ++j) { const unsigned c = xb_ld(&bar[XB_XCNT(j)]); sum += c; cnt += (c > 0u) ? 1u : 0u; mine = (j == x) ? c : mine; }
        if (sum == G) break;
        __builtin_amdgcn_s_sleep(1);
        if ((++sp & 255u) == 0u) { if (xb_ld(&bar[XB_TMO])) break; if (sp > XB_SPIN_CAP) { atomicAdd(&bar[XB_TMO], 1u); break; } }
    }
    nloc = mine > 0u ? mine : 1u; nx = cnt > 0u ? cnt : 1u;
}

__device__ __forceinline__ void xcd_barrier(const XcdBarrier& b) {
    asm volatile("s_waitcnt vmcnt(0)" ::: "memory");
    __syncthreads();
    if (threadIdx.x == 0) {
        unsigned* bar = b.bar;
        __builtin_amdgcn_s_waitcnt(0);
        unsigned nloc = b.st[0], nx = b.st[1];
        if (nloc == 0u) { xcd_barrier_complete(bar, b.x, nloc, nx); b.st[0] = nloc; b.st[1] = nx; }
        const unsigned old = xb_add(&bar[XB_XSUB(b.x)], 1u);
        const unsigned gen = old / nloc;
        if (old + 1u == (gen + 1u) * nloc) {
            __builtin_amdgcn_fence(__ATOMIC_RELEASE, "agent");
            asm volatile("s_waitcnt vmcnt(0)" ::: "memory");
            const unsigned og = xb_add(&bar[XB_TOP], 1u);
            const unsigned tg = og / nx;
            if (og + 1u == (tg + 1u) * nx) xb_add(&bar[XB_TOPGEN], 1u);
            else XB_SPIN(xb_ld(&bar[XB_TOPGEN]) == tg, bar);
            __builtin_amdgcn_fence(__ATOMIC_ACQUIRE, "agent");
            xb_add(&bar[XB_XGEN(b.x)], 1u);
            asm volatile("s_waitcnt vmcnt(0)" ::: "memory");
        } else {
            XB_SPIN(xb_ld(&bar[XB_XGEN(b.x)]) == gen, bar);
            __builtin_amdgcn_fence(__ATOMIC_ACQUIRE, "agent");
            asm volatile("s_waitcnt vmcnt(0)" ::: "memory");
        }
    }
    __syncthreads();
}


__device__ __forceinline__ void gsync(cg::grid_group& grid) {
    asm volatile("s_waitcnt vmcnt(0) lgkmcnt(0)" ::: "memory");
    grid.sync();
    if (threadIdx.x < 64) { __builtin_amdgcn_fence(__ATOMIC_ACQUIRE, "agent"); asm volatile("s_waitcnt vmcnt(0)" ::: "memory"); }
    __syncthreads();
}
__device__ __forceinline__ void transpose_item(const float* W, int lds_, int Ksrc, int Nsrc, bf16_t* WT, int ldd, int row_off, int col_off,
                                               const float* mu, int mode, LAS float* scr, int kb, int nb, int lane) {
    const int k0 = 64 * kb, n0 = 32 * nb;
#pragma unroll 8
    for (int i = 0; i < 32; ++i) { const int kk = 2 * i + (lane >> 5), nn = lane & 31, k = k0 + kk, n = n0 + nn;
        float v = (k < Ksrc && n < Nsrc) ? W[(size_t)k * lds_ + n] : 0.f;
        if (mode) { const float m = mu[k & 1023]; v *= (mode == 1) ? (1.f - m) : m; }
        scr[kk * 33 + nn] = v; }
    asm volatile("s_waitcnt lgkmcnt(0)" ::: "memory");
    const int c = lane & 7;
#pragma unroll
    for (int j = 0; j < 4; ++j) { const int n = (lane >> 3) + 8 * j; const LAS float* s = scr + (8 * c) * 33 + n;
        u32x4 o; o.x = cvt_pk_bf16(s[0 * 33], s[1 * 33]); o.y = cvt_pk_bf16(s[2 * 33], s[3 * 33]); o.z = cvt_pk_bf16(s[4 * 33], s[5 * 33]); o.w = cvt_pk_bf16(s[6 * 33], s[7 * 33]);
        *(u32x4*)(WT + (size_t)(row_off + n0 + n) * ldd + col_off + k0 + 8 * c) = o; }
    asm volatile("s_waitcnt lgkmcnt(0)" ::: "memory");
}

__device__ __forceinline__ void phase_prep(const Args& a, LAS unsigned char* lds) {
    const int tid = opaque_tid(), lane = tid & 63, wave = tid >> 6;
    unsigned char* ws = a.ws;
    {
        LAS float* sc = (LAS float*)lds;
        LAS float* red = (LAS float*)(lds + 65536);
        bool have = false;
        for (int it = blockIdx.x; it < 2 * 96; it += gridDim.x) {
            if (!have) { const float* c = a.in[1];
                for (int e = tid; e < 16 * 1024; e += NTHREADS) { const int b = e >> 10, k = e & 1023; const float x = c[e]; sc[k * 16 + b] = x / (1.f + __expf(-x)); }
                have = true; }
            __syncthreads();
            const int l = it / 96, n0 = (it % 96) * 64;
            const float* w = a.in[2] + (size_t)l * 1024 * 6144 + n0 + lane;
            float acc[16];
#pragma unroll
            for (int b = 0; b < 16; ++b) acc[b] = 0.f;
            const int kbeg = wave * 128;
#pragma unroll 8
            for (int k = kbeg; k < kbeg + 128; ++k) { const float wv = w[(size_t)k * 6144];
                const LAS f32x4* s4 = (const LAS f32x4*)(sc + k * 16);
#pragma unroll
                for (int q = 0; q < 4; ++q) { const f32x4 s = s4[q]; acc[4 * q] += s[0] * wv; acc[4 * q + 1] += s[1] * wv; acc[4 * q + 2] += s[2] * wv; acc[4 * q + 3] += s[3] * wv; } }
#pragma unroll
            for (int b = 0; b < 16; ++b) red[(wave * 16 + b) * 64 + lane] = acc[b];
            __syncthreads();
            float* mod = (float*)(ws + WS_MOD);
            for (int e = tid; e < 1024; e += NTHREADS) { const int b = e >> 6, n = e & 63; float s = 0.f;
#pragma unroll
                for (int wv = 0; wv < 8; ++wv) s += red[(wv * 16 + b) * 64 + n];
                mod[((size_t)l * 16 + b) * 6144 + n0 + n] = s + a.in[3][l * 6144 + n0 + n]; }
            __syncthreads();
        }
        __syncthreads();
    }
}
__device__ __forceinline__ void phase_weights(const Args& a, LAS unsigned char* lds) {
    const int tid = opaque_tid(), lane = tid & 63, wave = tid >> 6;
    unsigned char* ws = a.ws;
    {
        LAS float* scr = (LAS float*)(lds + wave * 16384);
        const int gw = blockIdx.x * NWAVES + wave, NGW = gridDim.x * NWAVES;
        const float* mu = a.in[12];
        constexpr int TOTAL = 16 * 64 + 16 * 32 + 2 * 16 * 128 + 2 * 64 * 32 + 3 * 16 * 32 + 2 * (16 * 4 + 16 * 4 + 16 * 8) + 24 * 32 + 16 * 32;
        for (int it = gw; it < TOTAL; it += NGW) {
            int r = it;
#define JOB(W, LDSRC, KS, NS, DST, LDD, RO, CO, MU, MODE, KB, NBK) if (r >= 0) { if (r < (KB) * (NBK)) { transpose_item((W), (LDSRC), (KS), (NS), (bf16_t*)(ws + (DST)), (LDD), (RO), (CO), (MU), (MODE), scr, r / (NBK), r % (NBK), lane); r = -1; } else r -= (KB) * (NBK); }
            JOB(a.in[6], 2048, 1024, 2048, WS_WIN0, 1024, 0, 0, mu, 0, 16, 64)
            JOB(a.in[11], 1024, 1024, 1024, WS_WOUT0, 1024, 0, 0, mu, 0, 16, 32)
            JOB(a.in[4], 4096, 1024, 4096, WS_W1, 1024, 0, 0, mu, 0, 16, 128)
            JOB(a.in[4] + (size_t)1024 * 4096, 4096, 1024, 4096, WS_W1 + (size_t)4096 * 1024 * 2, 1024, 0, 0, mu, 0, 16, 128)
            JOB(a.in[5], 1024, 4096, 1024, WS_W2, 4096, 0, 0, mu, 0, 64, 32)
            JOB(a.in[5] + (size_t)4096 * 1024, 1024, 4096, 1024, WS_W2 + (size_t)1024 * 4096 * 2, 4096, 0, 0, mu, 0, 64, 32)
            JOB(a.in[13] + 0, 3072, 1024, 1024, WS_WRKV, 1024, 0, 0, mu, 0, 16, 32)
            JOB(a.in[13] + 1024, 3072, 1024, 1024, WS_WRKV, 1024, 1024, 0, mu, 0, 16, 32)
            JOB(a.in[13] + 2048, 3072, 1024, 1024, WS_WRKV, 1024, 2048, 0, mu, 0, 16, 32)
            JOB(a.in[15], 64, 1024, 64, WS_WL1, 2048, 0, 0, mu + 1 * 1024, 1, 16, 4)
            JOB(a.in[15], 64, 1024, 64, WS_WL1, 2048, 0, 1024, mu + 1 * 1024, 2, 16, 4)
            JOB(a.in[18], 64, 1024, 64, WS_WL1, 2048, 128, 0, mu + 4 * 1024, 1, 16, 4)
            JOB(a.in[18], 64, 1024, 64, WS_WL1, 2048, 128, 1024, mu + 4 * 1024, 2, 16, 4)
            JOB(a.in[20], 160, 1024, 160, WS_WL1, 2048, 256, 0, mu + 5 * 1024, 1, 16, 8)
            JOB(a.in[20], 160, 1024, 160, WS_WL1, 2048, 256, 1024, mu + 5 * 1024, 2, 16, 8)
            JOB(a.in[16], 1024, 64, 1024, WS_WL2, 512, 0, 0, mu, 0, 2, 32)
            JOB(a.in[16], 1024, 0, 1024, WS_WL2, 512, 0, 128, mu, 0, 6, 32)
            JOB(a.in[19], 1024, 0, 1024, WS_WL2, 512, 1024, 0, mu, 0, 2, 32)
            JOB(a.in[19], 1024, 64, 1024, WS_WL2, 512, 1024, 128, mu, 0, 2, 32)
            JOB(a.in[19], 1024, 0, 1024, WS_WL2, 512, 1024, 256, mu, 0, 4, 32)
            JOB(a.in[21], 1024, 0, 1024, WS_WL2, 512, 2048, 0, mu, 0, 4, 32)
            JOB(a.in[21], 1024, 160, 1024, WS_WL2, 512, 2048, 256, mu, 0, 4, 32)
            JOB(a.in[27], 1024, 1024, 1024, WS_WOUT1, 1024, 0, 0, mu, 0, 16, 32)
#undef JOB
        }
        bf16_t* wsb = (bf16_t*)(ws + WS_WS);
        for (int e = blockIdx.x * NTHREADS + tid; e < 8 * 128 * 128 / 2; e += gridDim.x * NTHREADS) {
            const int i = e * 2, s = i & 127, t = (i >> 7) & 127;
            const float v0 = (s <= t) ? a.in[9][i] : 0.f, v1 = (s + 1 <= t) ? a.in[9][i + 1] : 0.f;
            ((unsigned*)wsb)[e] = cvt_pk_bf16(v0, v1);
        }
    }
}

__device__ __forceinline__ void phase_norm_mod(const float* x, const float* mod_shift, const float* mod_scale, bf16_t* H, int) {
    const int tid = opaque_tid(), lane = tid & 63, wave = tid >> 6;
    const int gw = blockIdx.x * NWAVES + wave, NGW = gridDim.x * NWAVES;
    constexpr int NR = 4;
    for (int m0 = gw; m0 < M; m0 += NR * NGW) {
        f32x4 v[NR][4];
#pragma unroll
        for (int r = 0; r < NR; ++r) { const int m = M - 1 - (m0 + r * NGW < M ? m0 + r * NGW : m0); const f32x4* xr = (const f32x4*)(x + (size_t)m * D) + lane;
#pragma unroll
            for (int j = 0; j < 4; ++j) v[r][j] = xr[64 * j]; }
#pragma unroll
        for (int r = 0; r < NR; ++r) { const int m = M - 1 - (m0 + r * NGW); if (m >= 0) {
            const int b = m >> 12; float s = 0.f;
#pragma unroll
            for (int j = 0; j < 4; ++j) s += (v[r][j].x * v[r][j].x + v[r][j].y * v[r][j].y) + (v[r][j].z * v[r][j].z + v[r][j].w * v[r][j].w);
            const float rstd = 1.0f / sqrtf(wave_sum(s) * (1.f / D) + 1e-6f);
            const f32x4* sh = (const f32x4*)(mod_shift + (size_t)b * 6144) + lane;
            const f32x4* sc = (const f32x4*)(mod_scale + (size_t)b * 6144) + lane;
            u32x2* o = (u32x2*)(H + (size_t)m * D) + lane;
#pragma unroll
            for (int j = 0; j < 4; ++j) { const f32x4 a = sh[64 * j], c = sc[64 * j]; const f32x4 h = v[r][j] * rstd * (c + 1.0f) + a;
                u32x2 w; w.x = cvt_pk_bf16(h.x, h.y); w.y = cvt_pk_bf16(h.z, h.w); o[64 * j] = w; } } }
    }
}
__device__ __forceinline__ void phase_final_norm(float* x, const float* g) {
    const int tid = opaque_tid(), lane = tid & 63, wave = tid >> 6;
    const int gw = blockIdx.x * NWAVES + wave, NGW = gridDim.x * NWAVES;
    constexpr int NR = 4;
    f32x4 gg[4];
#pragma unroll
    for (int j = 0; j < 4; ++j) gg[j] = ((const f32x4*)g)[lane + 64 * j];
    for (int m0 = gw; m0 < M; m0 += NR * NGW) {
        f32x4 v[NR][4];
#pragma unroll
        for (int r = 0; r < NR; ++r) { const int m = (m0 + r * NGW < M ? m0 + r * NGW : m0); const f32x4* xr = (const f32x4*)(x + (size_t)m * D) + lane;
#pragma unroll
            for (int j = 0; j < 4; ++j) v[r][j] = xr[64 * j]; }
#pragma unroll
        for (int r = 0; r < NR; ++r) { const int m = m0 + r * NGW; if (m < M) {
            float s = 0.f;
#pragma unroll
            for (int j = 0; j < 4; ++j) s += (v[r][j].x * v[r][j].x + v[r][j].y * v[r][j].y) + (v[r][j].z * v[r][j].z + v[r][j].w * v[r][j].w);
            const float rstd = 1.0f / sqrtf(wave_sum(s) * (1.f / D) + 1e-6f);
            f32x4* xr = (f32x4*)(x + (size_t)m * D) + lane;
#pragma unroll
            for (int j = 0; j < 4; ++j) xr[64 * j] = v[r][j] * rstd * gg[j]; } }
    }
}
__device__ __forceinline__ void load_row(const float* x, size_t m, int lane, f32x4 (&v)[4]) {
    const f32x4* xr = (const f32x4*)(x + m * D) + lane;
#pragma unroll
    for (int j = 0; j < 4; ++j) v[j] = xr[64 * j];
}
__device__ __forceinline__ void finish_row(f32x4 (&h)[4], const f32x4 (&sh)[4], const f32x4 (&sc1)[4]) {
    float s = 0.f;
#pragma unroll
    for (int j = 0; j < 4; ++j) s += (h[j].x * h[j].x + h[j].y * h[j].y) + (h[j].z * h[j].z + h[j].w * h[j].w);
    const float rstd = 1.0f / sqrtf(wave_sum(s) * (1.f / D) + 1e-6f);
#pragma unroll
    for (int j = 0; j < 4; ++j) h[j] = h[j] * rstd * sc1[j] + sh[j];
}
__device__ __forceinline__ void phase_norm_shift(const float* x, const float* mod_shift, const float* mod_scale, const float* mu, bf16_t* X3, bf16_t* H2) {
    const int tid = opaque_tid(), lane = tid & 63, wave = tid >> 6;
    const int gw = blockIdx.x * NWAVES + wave, NGW = gridDim.x * NWAVES;
    f32x4 mr[4], mk[4], mv[4];
#pragma unroll
    for (int j = 0; j < 4; ++j) { mr[j] = ((const f32x4*)(mu + 0 * 1024))[lane + 64 * j]; mk[j] = ((const f32x4*)(mu + 2 * 1024))[lane + 64 * j]; mv[j] = ((const f32x4*)(mu + 3 * 1024))[lane + 64 * j]; }
    for (int blk = gw; blk < M / 32; blk += NGW) {
        const size_t m0 = (size_t)blk * 32; const int b = (int)(m0 >> 12);
        f32x4 sh[4], sc1[4];
#pragma unroll
        for (int j = 0; j < 4; ++j) { sh[j] = ((const f32x4*)(mod_shift + (size_t)b * 6144))[lane + 64 * j]; sc1[j] = ((const f32x4*)(mod_scale + (size_t)b * 6144))[lane + 64 * j] + 1.0f; }
        f32x4 hp[4], h[4], n1[4], n2[4];
        const bool first = (m0 & 4095) == 0;
        load_row(x, first ? m0 : m0 - 1, lane, hp); load_row(x, m0, lane, h); load_row(x, m0 + 1, lane, n1);
        finish_row(hp, sh, sc1);
        if (first) {
#pragma unroll
            for (int j = 0; j < 4; ++j) hp[j] = (f32x4){0.f, 0.f, 0.f, 0.f}; }
        for (int i = 0; i < 32; ++i) {
            const size_t m = m0 + i;
            load_row(x, (i + 2 < 32) ? m + 2 : m, lane, n2);
            finish_row(h, sh, sc1);
            u32x2* o2 = (u32x2*)(H2 + (m + b + 1) * D) + lane;
            u32x2* or_ = (u32x2*)(X3 + m * D) + lane;
#pragma unroll
            for (int j = 0; j < 4; ++j) {
                const f32x4 d = hp[j] - h[j];
                const f32x4 xr = h[j] + d * mr[j], xk = h[j] + d * mk[j], xv = h[j] + d * mv[j];
                u32x2 w; w.x = cvt_pk_bf16(h[j].x, h[j].y); w.y = cvt_pk_bf16(h[j].z, h[j].w); o2[64 * j] = w;
                if (first && i == 0) o2[64 * j - D / 4] = (u32x2){0u, 0u};
                w.x = cvt_pk_bf16(xr.x, xr.y); w.y = cvt_pk_bf16(xr.z, xr.w); or_[64 * j] = w;
                w.x = cvt_pk_bf16(xk.x, xk.y); w.y = cvt_pk_bf16(xk.z, xk.w); or_[64 * j + (size_t)M * D / 4] = w;
                w.x = cvt_pk_bf16(xv.x, xv.y); w.y = cvt_pk_bf16(xv.z, xv.w); or_[64 * j + 2 * (size_t)M * D / 4] = w;
                hp[j] = h[j]; h[j] = n1[j]; n1[j] = n2[j];
            }
        }
    }
}

__device__ __forceinline__ void phase_sgu(const Args& a, LAS unsigned char* lds) {
    const int tid = opaque_tid(), lane = tid & 63, wave = tid >> 6, fr = lane & 15, fq = lane >> 4;
    const bf16_t* UV = (const bf16_t*)(a.ws + WS_UV); bf16_t* Z = (bf16_t*)(a.ws + WS_Z);
    const bf16_t* WSB = (const bf16_t*)(a.ws + WS_WS);
    const float* lng = a.in[7]; const float* lnb = a.in[8]; const float* bs = a.in[10];
    constexpr int RS = 272;
    LAS unsigned char* Wl = lds;
    LAS unsigned char* Vl = lds + 128 * RS;
    LAS f32x2* st = (LAS f32x2*)(lds + 2 * 128 * RS);
    const int wt = wave >> 2, wd = wave & 3;
    for (int tile_ = blockIdx.x; tile_ < M / 128; tile_ += gridDim.x) {
        const int tile = M / 128 - 1 - tile_;
        const size_t m0 = (size_t)tile * 128;
        for (int r = wave * 16; r < wave * 16 + 16; ++r) {
            const u32x4* p = (const u32x4*)(UV + (m0 + r) * 2048 + 1024) + lane;
            const u32x4 q0 = p[0], q1 = p[64];
            float f[16];
            f[0] = bf_lo(q0.x); f[1] = bf_hi(q0.x); f[2] = bf_lo(q0.y); f[3] = bf_hi(q0.y); f[4] = bf_lo(q0.z); f[5] = bf_hi(q0.z); f[6] = bf_lo(q0.w); f[7] = bf_hi(q0.w);
            f[8] = bf_lo(q1.x); f[9] = bf_hi(q1.x); f[10] = bf_lo(q1.y); f[11] = bf_hi(q1.y); f[12] = bf_lo(q1.z); f[13] = bf_hi(q1.z); f[14] = bf_lo(q1.w); f[15] = bf_hi(q1.w);
            float s = 0.f;
#pragma unroll
            for (int e = 0; e < 16; ++e) s += f[e];
            const float mean = wave_sum(s) * (1.f / 1024.f);
            float q = 0.f;
#pragma unroll
            for (int e = 0; e < 16; ++e) { const float d = f[e] - mean; q += d * d; }
            const float var = wave_sum(q) * (1.f / 1024.f);
            if (lane == 0) st[r] = (f32x2){mean, 1.0f / sqrtf(var + 1e-5f)};
        }
        __syncthreads();
        for (int g = 0; g < 8; ++g) {
            {
                const u32x4* src = (const u32x4*)(WSB + (size_t)g * 128 * 128);
#pragma unroll
                for (int i = 0; i < 4; ++i) { const int idx = tid + i * NTHREADS; const int t = idx >> 4, c = idx & 15;
                    *(LAS u32x4*)(Wl + t * RS + c * 16) = src[idx]; }
            }
            {
                const int sp = tid & 63, dq = tid >> 6, s0 = 2 * sp, d0 = dq * 16;
                const f32x2 st0 = st[s0], st1 = st[s0 + 1];
                const bf16_t* p0 = UV + (m0 + s0) * 2048 + 1024 + g * 128 + d0;
                const u32x4 a0 = *(const u32x4*)p0, a1 = *(const u32x4*)(p0 + 8), b0 = *(const u32x4*)(p0 + 2048), b1 = *(const u32x4*)(p0 + 2048 + 8);
                const unsigned ua[8] = {a0.x, a0.y, a0.z, a0.w, a1.x, a1.y, a1.z, a1.w}, ub[8] = {b0.x, b0.y, b0.z, b0.w, b1.x, b1.y, b1.z, b1.w};
                const float* gp = lng + g * 128 + d0; const float* bp = lnb + g * 128 + d0;
#pragma unroll
                for (int e = 0; e < 8; ++e) {
                    const float g0 = gp[2 * e], g1 = gp[2 * e + 1], c0 = bp[2 * e], c1 = bp[2 * e + 1];
                    const float x00 = (bf_lo(ua[e]) - st0.x) * st0.y * g0 + c0, x01 = (bf_hi(ua[e]) - st0.x) * st0.y * g1 + c1;
                    const float x10 = (bf_lo(ub[e]) - st1.x) * st1.y * g0 + c0, x11 = (bf_hi(ub[e]) - st1.x) * st1.y * g1 + c1;
                    *(LAS unsigned*)(Vl + (d0 + 2 * e) * RS + s0 * 2) = cvt_pk_bf16(x00, x10);
                    *(LAS unsigned*)(Vl + (d0 + 2 * e + 1) * RS + s0 * 2) = cvt_pk_bf16(x01, x11);
                }
            }
            __syncthreads();
            f32x4 acc[4][2];
#pragma unroll
            for (int mi = 0; mi < 4; ++mi)
#pragma unroll
                for (int ni = 0; ni < 2; ++ni) acc[mi][ni] = (f32x4){0.f, 0.f, 0.f, 0.f};
#pragma unroll
            for (int ks = 0; ks < 4; ++ks) {
                if (ks * 32 <= 64 * wt + 63) {
                    bf16x8 bfr[2];
#pragma unroll
                    for (int ni = 0; ni < 2; ++ni) bfr[ni] = *(const LAS bf16x8*)(Vl + (32 * wd + 16 * ni + fr) * RS + (ks * 32 + fq * 8) * 2);
#pragma unroll
                    for (int mi = 0; mi < 4; ++mi) {
                        if (ks * 32 <= 64 * wt + 16 * mi + 15) {
                            const bf16x8 afr = *(const LAS bf16x8*)(Wl + (64 * wt + 16 * mi + fr) * RS + (ks * 32 + fq * 8) * 2);
#pragma unroll
                            for (int ni = 0; ni < 2; ++ni) acc[mi][ni] = __builtin_amdgcn_mfma_f32_16x16x32_bf16(bfr[ni], afr, acc[mi][ni], 0, 0, 0);
                        }
                    }
                }
            }
#pragma unroll
            for (int mi = 0; mi < 4; ++mi) {
                const int t = 64 * wt + 16 * mi + fr; const float bias = bs[g * 128 + t];
#pragma unroll
                for (int ni = 0; ni < 2; ++ni) {
                    const int col = g * 128 + 32 * wd + 16 * ni + 4 * fq;
                    const u32x2 uu = *(const u32x2*)(UV + (m0 + t) * 2048 + col);
                    const f32x4 sv = acc[mi][ni];
                    u32x2 o; o.x = cvt_pk_bf16(bf_lo(uu.x) * (sv[0] + bias), bf_hi(uu.x) * (sv[1] + bias)); o.y = cvt_pk_bf16(bf_lo(uu.y) * (sv[2] + bias), bf_hi(uu.y) * (sv[3] + bias));
                    *(u32x2*)(Z + (m0 + t) * 1024 + col) = o;
                }
            }
            __syncthreads();
        }
    }
}

__device__ __forceinline__ float fma_(float a, float b, float c) { float d; asm("v_fma_f32 %0, %1, %2, %3" : "=v"(d) : "v"(a), "v"(b), "v"(c)); return d; }
__device__ __forceinline__ float mul_(float a, float b) { float d; asm("v_mul_f32 %0, %1, %2" : "=v"(d) : "v"(a), "v"(b)); return d; }
__device__ __forceinline__ float dot4_(const f32x4& s, const f32x4& o) { return fma_(s.w, o.w, fma_(s.z, o.z, fma_(s.y, o.y, mul_(s.x, o.x)))); }
__device__ __forceinline__ void upd4_(f32x4& s, const f32x4& w, const f32x4& b, const f32x4& k, float sa, float v) {
    s.x = fma_(v, k.x, fma_(sa, b.x, mul_(s.x, w.x))); s.y = fma_(v, k.y, fma_(sa, b.y, mul_(s.y, w.y)));
    s.z = fma_(v, k.z, fma_(sa, b.z, mul_(s.z, w.z))); s.w = fma_(v, k.w, fma_(sa, b.w, mul_(s.w, w.w)));
}
__device__ __forceinline__ f32x2 pkmul_(f32x2 a, f32x2 b) { f32x2 d; asm("v_pk_mul_f32 %0, %1, %2" : "=v"(d) : "v"(a), "v"(b)); return d; }
__device__ __forceinline__ f32x2 pkfma_(f32x2 a, f32x2 b, f32x2 c) { f32x2 d; asm("v_pk_fma_f32 %0, %1, %2, %3" : "=v"(d) : "v"(a), "v"(b), "v"(c)); return d; }
__device__ __forceinline__ f32x2 pkfma_lo_(f32x2 a, f32x2 b, f32x2 c) { f32x2 d; asm("v_pk_fma_f32 %0, %1, %2, %3 op_sel_hi:[0,1,1]" : "=v"(d) : "v"(a), "v"(b), "v"(c)); return d; }
__device__ __forceinline__ f32x2 pkfma_hi_(f32x2 a, f32x2 b, f32x2 c) { f32x2 d; asm("v_pk_fma_f32 %0, %1, %2, %3 op_sel:[1,0,0]" : "=v"(d) : "v"(a), "v"(b), "v"(c)); return d; }
__device__ __forceinline__ float add_(float a, float b) { float d; asm("v_add_f32 %0, %1, %2" : "=v"(d) : "v"(a), "v"(b)); return d; }
#define LO2(v) __builtin_shufflevector(v, v, 0, 1)
#define HI2(v) __builtin_shufflevector(v, v, 2, 3)
__device__ __forceinline__ void phase_scan(const Args& a, LAS unsigned char* lds) {
    const int tid = opaque_tid(), lane = tid & 63, wave = tid >> 6;
    constexpr int TC = 32;
    LAS float* op = (LAS float*)lds;
    LAS float* vb = (LAS float*)(lds + (TC + 1) * 1280);
    LAS float* yb = (LAS float*)(lds + (TC + 1) * 1280 + (TC + 1) * 256);
    const bf16_t* Rg = (const bf16_t*)(a.ws + WS_R); const bf16_t* Kg = (const bf16_t*)(a.ws + WS_K); const bf16_t* Vg = (const bf16_t*)(a.ws + WS_V);
    const bf16_t* Lg = (const bf16_t*)(a.ws + WS_L); const bf16_t* WL2 = (const bf16_t*)(a.ws + WS_WL2);
    constexpr int XS = 68;
    LAS float* xb = (LAS float*)(lds + (TC + 1) * 1280 + (TC + 1) * 256 + TC * 1024);
    const int fr = lane & 15, fq = lane >> 4, stile = wave >> 2, ntile = wave & 3;
    bf16_t* YG = (bf16_t*)(a.ws + WS_YG);
    const int ts = tid >> 4, jg = tid & 15;
    const int ig = lane >> 4;
    const int r0 = wave * 8 + ig * 2;
    for (int hd = blockIdx.x; hd < NB * 16; hd += gridDim.x) {
        const int b = hd >> 4, h = hd & 15;
        const int ch = h * 64 + jg * 4;
        const f32x4 kk4 = *(const f32x4*)(a.in[22] + ch), ka4 = *(const f32x4*)(a.in[23] + ch), rk4 = *(const f32x4*)(a.in[24] + ch);
        const f32x4 lg4 = *(const f32x4*)(a.in[25] + ch), lb4 = *(const f32x4*)(a.in[26] + ch);
        const size_t base = ((size_t)b * T) * D + ch;
        f32x2 S0a = {0.f, 0.f}, S0b = {0.f, 0.f}, S1a = {0.f, 0.f}, S1b = {0.f, 0.f};
        size_t off = base + (size_t)ts * D;
        u32x2 pr = *(const u32x2*)(Rg + off), pk = *(const u32x2*)(Kg + off), pv = *(const u32x2*)(Vg + off);
        const int chn = h * 64 + ntile * 16 + fr;
        bf16x8 bw[2], ba[2], bg[5];
#pragma unroll
        for (int ks = 0; ks < 2; ++ks) { bw[ks] = *(const bf16x8*)(WL2 + (size_t)chn * 512 + ks * 32 + fq * 8); ba[ks] = *(const bf16x8*)(WL2 + (size_t)(1024 + chn) * 512 + 128 + ks * 32 + fq * 8); }
#pragma unroll
        for (int ks = 0; ks < 5; ++ks) bg[ks] = *(const bf16x8*)(WL2 + (size_t)(2048 + chn) * 512 + 256 + ks * 32 + fq * 8);
        const float w0c = a.in[14][chn], a0c = a.in[17][chn];
        bf16x8 aw[2], aa[2], ag[5];
#define LORA_LOAD(cc) do { const bf16_t* lrow = Lg + ((size_t)b * T + (size_t)(cc) * TC + stile * 16 + fr) * 512 + fq * 8; \
            _Pragma("unroll") for (int ks = 0; ks < 2; ++ks) { aw[ks] = *(const bf16x8*)(lrow + ks * 32); aa[ks] = *(const bf16x8*)(lrow + 128 + ks * 32); } \
            _Pragma("unroll") for (int ks = 0; ks < 5; ++ks) ag[ks] = *(const bf16x8*)(lrow + 256 + ks * 32); } while (0)
#define LORA_RUN() do { f32x4 cw = {0.f, 0.f, 0.f, 0.f}, ca = {0.f, 0.f, 0.f, 0.f}, cg_ = {0.f, 0.f, 0.f, 0.f}; \
            _Pragma("unroll") for (int ks = 0; ks < 2; ++ks) { cw = __builtin_amdgcn_mfma_f32_16x16x32_bf16(aw[ks], bw[ks], cw, 0, 0, 0); ca = __builtin_amdgcn_mfma_f32_16x16x32_bf16(aa[ks], ba[ks], ca, 0, 0, 0); } \
            _Pragma("unroll") for (int ks = 0; ks < 5; ++ks) cg_ = __builtin_amdgcn_mfma_f32_16x16x32_bf16(ag[ks], bg[ks], cg_, 0, 0, 0); \
            _Pragma("unroll") for (int e = 0; e < 4; ++e) { const int xi = (stile * 16 + 4 * fq + e) * XS + ntile * 16 + fr; \
                xb[xi] = __builtin_amdgcn_exp2f(-0.87503988f * __builtin_amdgcn_rcpf(1.0f + __expf(-(w0c + cw[e])))); \
                xb[TC * XS + xi] = __builtin_amdgcn_rcpf(1.0f + __expf(-(a0c + ca[e]))); \
                xb[2 * TC * XS + xi] = cg_[e]; } } while (0)
        LORA_LOAD(0); LORA_RUN();
        __syncthreads();
        u32x2 ypend = {0u, 0u};
        for (int c = 0; c < T / TC; ++c) {
            const f32x4 r4 = {bf_lo(pr.x), bf_hi(pr.x), bf_lo(pr.y), bf_hi(pr.y)};
            const f32x4 k4 = {bf_lo(pk.x), bf_hi(pk.x), bf_lo(pk.y), bf_hi(pk.y)};
            const f32x4 v4 = {bf_lo(pv.x), bf_hi(pv.x), bf_lo(pv.y), bf_hi(pv.y)};
            const f32x4 w4 = *(const LAS f32x4*)(xb + ts * XS + jg * 4), a4 = *(const LAS f32x4*)(xb + TC * XS + ts * XS + jg * 4), g4 = *(const LAS f32x4*)(xb + 2 * TC * XS + ts * XS + jg * 4);
            const f32x4 kkx = k4 * kk4;
            const float ss = reduce16((kkx.x * kkx.x + kkx.y * kkx.y) + (kkx.z * kkx.z + kkx.w * kkx.w));
            const float inv = __builtin_amdgcn_rsqf(fmaxf(ss, 1e-24f));
            const f32x4 kk = kkx * inv;
            const f32x4 kf = k4 * ((a4 - 1.0f) * ka4 + 1.0f);
            const f32x4 am = -kk, bm = kk * a4;
            const f32x4 rkr = r4 * kf * rk4;
            const float ct = reduce16((rkr.x + rkr.y) + (rkr.z + rkr.w));
            {
                LAS f32x4* o = (LAS f32x4*)(op + (ts * 16 + jg) * 20);
                o[0] = w4; o[1] = am; o[2] = bm; o[3] = kf; o[4] = r4;
                *(LAS f32x4*)(vb + ts * 64 + jg * 4) = v4;
            }
            __syncthreads();
            if (c > 0) *(u32x2*)(YG + base + (size_t)((c - 1) * TC + ts) * D) = ypend;
            if (c + 1 < T / TC) { off = base + (size_t)((c + 1) * TC + ts) * D;
                pr = *(const u32x2*)(Rg + off); pk = *(const u32x2*)(Kg + off); pv = *(const u32x2*)(Vg + off);
                LORA_LOAD(c + 1); }
            {
                const LAS float* obase = op + (lane & 15) * 20;
                const LAS float* vbase = vb + r0;
                f32x4 ow = *(const LAS f32x4*)(obase), oa = *(const LAS f32x4*)(obase + 4), ob = *(const LAS f32x4*)(obase + 8), ok = *(const LAS f32x4*)(obase + 12), orr = *(const LAS f32x4*)(obase + 16);
                f32x2 vv = *(const LAS f32x2*)(vbase);
#pragma unroll 2
                for (int s = 0; s < TC; ++s) {
                    const LAS float* o = obase + (s + 1) * 320;
                    const f32x4 now = *(const LAS f32x4*)(o), noa = *(const LAS f32x4*)(o + 4), nob = *(const LAS f32x4*)(o + 8), nok = *(const LAS f32x4*)(o + 12), norr = *(const LAS f32x4*)(o + 16);
                    const f32x2 nvv = *(const LAS f32x2*)(vbase + (s + 1) * 64);
                    const f32x2 p0 = pkfma_(S0b, HI2(oa), pkmul_(S0a, LO2(oa))), p1 = pkfma_(S1b, HI2(oa), pkmul_(S1a, LO2(oa)));
                    float sa0 = add_(p0.x, p0.y), sa1 = add_(p1.x, p1.y);
                    sa0 = reduce16(sa0); asm volatile("" : "+v"(sa0)); sa1 = reduce16(sa1);
                    const f32x2 sap = {sa0, sa1};
                    S0a = pkfma_lo_(vv, LO2(ok), pkfma_lo_(sap, LO2(ob), pkmul_(S0a, LO2(ow))));
                    S0b = pkfma_lo_(vv, HI2(ok), pkfma_lo_(sap, HI2(ob), pkmul_(S0b, HI2(ow))));
                    S1a = pkfma_hi_(vv, LO2(ok), pkfma_hi_(sap, LO2(ob), pkmul_(S1a, LO2(ow))));
                    S1b = pkfma_hi_(vv, HI2(ok), pkfma_hi_(sap, HI2(ob), pkmul_(S1b, HI2(ow))));
                    const f32x2 q0 = pkfma_(S0b, HI2(orr), pkmul_(S0a, LO2(orr))), q1 = pkfma_(S1b, HI2(orr), pkmul_(S1a, LO2(orr)));
                    float y0 = add_(q0.x, q0.y), y1 = add_(q1.x, q1.y);
                    y0 += dppf<0xB1>(y0); y1 += dppf<0xB1>(y1); y0 += dppf<0x4E>(y0); y1 += dppf<0x4E>(y1);
                    if ((lane & 3) == 0) *(LAS f32x2*)(yb + (s * 4 + ((lane >> 2) & 3)) * 64 + r0) = (f32x2){y0, y1};
                    ow = now; oa = noa; ob = nob; ok = nok; orr = norr; vv = nvv;
                }
            }
            __syncthreads();
            {
                const f32x4 y4 = (*(const LAS f32x4*)(yb + (ts * 4 + 0) * 64 + jg * 4) + *(const LAS f32x4*)(yb + (ts * 4 + 1) * 64 + jg * 4)) + (*(const LAS f32x4*)(yb + (ts * 4 + 2) * 64 + jg * 4) + *(const LAS f32x4*)(yb + (ts * 4 + 3) * 64 + jg * 4));
                const float mean = reduce16((y4.x + y4.y) + (y4.z + y4.w)) * (1.f / 64.f);
                const f32x4 d = y4 - mean;
                const float var = reduce16((d.x * d.x + d.y * d.y) + (d.z * d.z + d.w * d.w)) * (1.f / 64.f);
                const float rstd = __builtin_amdgcn_rsqf(var + 64e-5f);
                const f32x4 o = ((d * rstd) * lg4 + lb4 + v4 * ct) * g4;
                u32x2 w; w.x = cvt_pk_bf16(o.x, o.y); w.y = cvt_pk_bf16(o.z, o.w);
                ypend = w;
            }
            if (c + 1 < T / TC) LORA_RUN();
            __syncthreads();
        }
        *(u32x2*)(YG + base + (size_t)((T / TC - 1) * TC + ts) * D) = ypend;
#undef LORA_LOAD
#undef LORA_RUN
    }
}


#define SEAM() do { ++ph; if (lo < ph && ph < hi) { if (ph == 1) gsync(grid); else xcd_barrier(xbar); } } while (0)
#define RUN (lo <= ph && ph < hi)
template <int l> __device__ __forceinline__ void layer(const Args& a, LAS unsigned char* lds, cg::grid_group& grid, const XcdBarrier& xbar, int& ph, const int lo, const int hi) {
    unsigned char* ws = a.ws;
    const float* MOD = (const float*)(ws + WS_MOD);
    bf16_t* H = (bf16_t*)(ws + WS_H);
    const int G = gridDim.x, c = blockIdx.x;
    const float* mod = MOD + (size_t)l * 16 * 6144;
    const float* xin = (l == 0) ? a.in[0] : a.out;
    if (RUN) { if (l == 0) phase_weights(a, lds); if (l == 1) phase_norm_shift(xin, mod + 0 * 1024, mod + 1 * 1024, a.in[12], (bf16_t*)(ws + WS_X3), (bf16_t*)(ws + WS_H2)); else phase_norm_mod(xin, mod + 0 * 1024, mod + 1 * 1024, H, 0); }
    SEAM();
    if (l == 0) {
        if (RUN) { pg8::Gemm g{H, (const bf16_t*)(ws + WS_WIN0), M, 2048, 1024, 0, 0}; pg8::StaticOrder S; S.init(M, 2048, G, c);
          pg8::EpiAct<1> E{(bf16_t*)(ws + WS_UV), 2048}; pg8::gemm_phase(lds, g, S, E); }
        SEAM();
        if (RUN) phase_sgu(a, lds);
        SEAM();
        if (RUN) { pg8::Gemm g{(const bf16_t*)(ws + WS_Z), (const bf16_t*)(ws + WS_WOUT0), M, 1024, 1024, 0, 0}; pg8::StaticOrder S; S.init(M, 1024, G, c);
          pg8::EpiRes E{a.in[0], a.out, mod + 2 * 1024, 6144}; pg8::gemm_phase(lds, g, S, E); }
    } else {
        if (RUN) {
          { pg8::Gemm g{(const bf16_t*)(ws + WS_H2), (const bf16_t*)(ws + WS_WL1), M, 512, 2048, 0, 1}; pg8::StaticOrder S; S.init(M, 512, G, c, 1);
            pg8::EpiRkvL E{(bf16_t*)(ws + WS_R), (size_t)(WS_K - WS_R) / 2, (bf16_t*)(ws + WS_L), 12}; pg8::gemm_phase(lds, g, S, E); }
          { pg8::Gemm g{(const bf16_t*)(ws + WS_X3), (const bf16_t*)(ws + WS_WRKV), M, 3072, 1024, (long)M * D, 0}; pg8::StaticOrder S; S.init(M, 3072, G, c, 1);
            pg8::EpiRkvL E{(bf16_t*)(ws + WS_R), (size_t)(WS_K - WS_R) / 2, (bf16_t*)(ws + WS_L), 0}; pg8::gemm_phase(lds, g, S, E); }
        }
        SEAM();
        if (RUN) phase_scan(a, lds);
        SEAM();
        if (RUN) { pg8::Gemm g{(const bf16_t*)(ws + WS_YG), (const bf16_t*)(ws + WS_WOUT1), M, 1024, 1024, 0, 0}; pg8::StaticOrder S; S.init(M, 1024, G, c);
          pg8::EpiRes E{a.out, a.out, mod + 2 * 1024, 6144}; pg8::gemm_phase(lds, g, S, E); }
    }
    SEAM();
    if (RUN) phase_norm_mod(a.out, mod + 3 * 1024, mod + 4 * 1024, H, 0);
    SEAM();
    if (RUN) { pg8::Gemm g{H, (const bf16_t*)(ws + WS_W1 + (size_t)l * 4096 * 1024 * 2), M, 4096, 1024, 0, 0}; pg8::StaticOrder S; S.init(M, 4096, G, c);
      pg8::EpiAct<2> E{(bf16_t*)(ws + WS_HID), 4096}; pg8::gemm_phase(lds, g, S, E); }
    SEAM();
    if (RUN) { pg8::Gemm g{(const bf16_t*)(ws + WS_HID), (const bf16_t*)(ws + WS_W2 + (size_t)l * 1024 * 4096 * 2), M, 1024, 4096, 0, 0}; pg8::StaticOrder S; S.init(M, 1024, G, c, 1);
      pg8::EpiRes E{a.out, a.out, mod + 5 * 1024, 6144}; pg8::gemm_phase(lds, g, S, E); }
    SEAM();
}
constexpr int NPHASES = 16;

__global__ void __launch_bounds__(NTHREADS, 2) fwd_megakernel(Args a) {
    extern __shared__ __attribute__((aligned(16))) unsigned char lds_raw[];
    LAS unsigned char* lds = (LAS unsigned char*)lds_raw;
    cg::grid_group grid = cg::this_grid();
    const int lo = a.lo, hi = a.hi;
    int ph = 0;
    volatile LAS unsigned* bst = (volatile LAS unsigned*)(lds + 131072 + 512);
    if (threadIdx.x < 2) bst[threadIdx.x] = 0u;
    __syncthreads();
    XcdBarrier xbar; xbar.bar = (unsigned*)a.ws; xbar.x = 0; xbar.st = nullptr;
    if (hi - lo > 1) xbar = xcd_barrier_post((unsigned*)a.ws, bst);
    if (RUN) phase_prep(a, lds);
    SEAM();
    layer<0>(a, lds, grid, xbar, ph, lo, hi);
    layer<1>(a, lds, grid, xbar, ph, lo, hi);
    if (RUN) phase_final_norm(a.out, a.in[28]);
}
#ifndef N_LAUNCHES
#define N_LAUNCHES 1
#endif

extern "C" void kernel_launch(void* const* d_in, const int* in_sizes, int n_in, void* d_out, int out_size, void* d_ws, size_t ws_size, hipStream_t stream) {
    static int grid = 0;
    if (grid == 0) {
        if (n_in != 29 || out_size != M * D || ws_size < WS_END) { fprintf(stderr, "kernel_launch: unexpected problem: n_in %d out %d ws %zu (need %zu)\n", n_in, out_size, ws_size, (size_t)WS_END); grid = -1; return; }
        int dev = 0, cus = 0, per_cu = 0;
        hipGetDevice(&dev);
        hipDeviceGetAttribute(&cus, hipDeviceAttributeMultiprocessorCount, dev);
        if (hipFuncSetAttribute((const void*)fwd_megakernel, hipFuncAttributeMaxDynamicSharedMemorySize, LDS_BYTES) != hipSuccess) { fprintf(stderr, "kernel_launch: hipFuncSetAttribute failed\n"); grid = -1; return; }
        if (hipOccupancyMaxActiveBlocksPerMultiprocessor(&per_cu, (const void*)fwd_megakernel, NTHREADS, LDS_BYTES) != hipSuccess || per_cu < 1) { fprintf(stderr, "kernel_launch: occupancy query says %d blocks/CU\n", per_cu); per_cu = 1; }
        (void)hipGetLastError();
        grid = cus;
    }
    if (grid < 0) return;
    Args a{};
    for (int i = 0; i < 29; ++i) a.in[i] = (const float*)d_in[i];
    a.out = (float*)d_out; a.ws = (unsigned char*)d_ws;
    if (N_LAUNCHES == 1) {
        if (hipMemsetAsync(d_ws, 0, 16384, stream) != hipSuccess) { fprintf(stderr, "kernel_launch: memset of the barrier words failed\n"); return; }
        a.lo = 0; a.hi = NPHASES;
        void* args[] = {&a};
        hipError_t e = hipLaunchCooperativeKernel((const void*)fwd_megakernel, dim3(grid), dim3(NTHREADS), args, LDS_BYTES, stream);
        if (e != hipSuccess) fprintf(stderr, "kernel_launch: cooperative launch failed: %s (grid %d)\n", hipGetErrorString(e), grid);
    } else {
        for (int p = 0; p < NPHASES; ++p) { a.lo = p; a.hi = p + 1;
            hipLaunchKernelGGL(fwd_megakernel, dim3(grid), dim3(NTHREADS), LDS_BYTES, stream, a); }
    }
}
```

```cpp
#include <hip/hip_runtime.h>
#include <hip/hip_cooperative_groups.h>
#include <cstdio>
#include <cstdint>
namespace cg = cooperative_groups;

#define LAS __attribute__((address_space(3)))
typedef unsigned short bf16_t;
typedef short bf16x8 __attribute__((ext_vector_type(8)));
typedef float f32x4 __attribute__((ext_vector_type(4)));
typedef float f32x2 __attribute__((ext_vector_type(2)));
typedef unsigned u32x4 __attribute__((ext_vector_type(4)));
typedef unsigned u32x2 __attribute__((ext_vector_type(2)));

constexpr int D = 1024, NB = 16, T = 4096, M = NB * T, FF = 4096, NMOD = 6;
constexpr int NTHREADS = 512, NWAVES = 8;

__device__ __forceinline__ int opaque_tid() { int t = threadIdx.x; asm volatile("" : "+v"(t)); return t; }
__device__ __forceinline__ unsigned cvt_pk_bf16(float lo, float hi) { unsigned r; asm volatile("v_cvt_pk_bf16_f32 %0, %1, %2" : "=v"(r) : "v"(lo), "v"(hi)); return r; }
__device__ __forceinline__ float bf_lo(unsigned u) { return __builtin_bit_cast(float, u << 16); }
__device__ __forceinline__ float bf_hi(unsigned u) { return __builtin_bit_cast(float, u & 0xffff0000u); }
__device__ __forceinline__ float sigmoidf_(float x) { return __builtin_amdgcn_rcpf(1.0f + __expf(-x)); }

namespace pg8 {
constexpr int BM = 256, BK = 64, HALF = 128, HTB = HALF * BK * 2, STAGE_BYTES = 8 * HTB, NXCD = 8, WGM = 8;
__host__ __device__ __forceinline__ int lds_byte(int r, int c) { const int st = (r >> 4) * 2 + (c >> 5), rr = r & 15, cc = c & 31, ob = rr * 64 + cc * 2; return st * 1024 + (ob ^ (((ob >> 9) & 1) << 5)); }
__host__ __device__ __forceinline__ void stage_rc(int b, int& R, int& C) { const int st = b / 1024, sb = b % 1024, swz = sb ^ (((sb >> 9) & 1) << 5); R = (st >> 1) * 16 + swz / 64; C = (st & 1) * 32 + (swz % 64) / 2; }
__host__ __device__ __forceinline__ int perm32(int rho) { const int n = rho >> 4, i = rho & 15; return 8 * (i >> 2) + 4 * n + (i & 3); }

struct Unit { int pm, pn; };
struct Gemm { const bf16_t* A; const bf16_t* Bt; int M, N, K; long asplit; int shift; };

struct StaticOrder {
    int nM, nN, nwg, G, c, rev;
    __device__ void init(int M_, int N_, int G_, int c_, int rev_ = 0) { nM = M_ / BM; nN = N_ / BM; nwg = nM * nN; G = G_; c = c_; rev = rev_; }
    __device__ bool next(int i, Unit& u) const {
        const long L = (long)i * G + c; if (L >= nwg) return false;
        int wgid = (int)L; { const int q = nwg / NXCD, r = nwg % NXCD, xcd = wgid % NXCD, off = wgid / NXCD; wgid = (xcd < r ? xcd * (q + 1) : r * (q + 1) + (xcd - r) * q) + off; }
        const int nig = WGM * nN, gid = wgid / nig, fm = gid * WGM, gsz = (nM - fm) < WGM ? (nM - fm) : WGM;
        u.pm = fm + ((wgid % nig) % gsz); u.pn = (wgid % nig) / gsz; if (rev) u.pm = nM - 1 - u.pm; return true;
    }
};

__device__ __forceinline__ f32x2 gelu_pk(f32x2 v) {
    const f32x2 av = __builtin_elementwise_abs(v), d = av * 0.2316418882f + 1.0f;
    f32x2 t; t.x = __builtin_amdgcn_rcpf(d.x); t.y = __builtin_amdgcn_rcpf(d.y);
    f32x2 q = t * 0.5307027145f + (-0.7265760135f); q = q * t + 0.7107068705f; q = q * t + (-0.142248368f); q = q * t + 0.127414796f; q = q * t;
    const f32x2 s = (v * v) * (-0.72134752044f);
    f32x2 e; e.x = __builtin_amdgcn_exp2f(s.x); e.y = __builtin_amdgcn_exp2f(s.y);
    const f32x2 m = v * (q * e), r = v - m;
    f32x2 o; o.x = v.x < 0.f ? m.x : r.x; o.y = v.y < 0.f ? m.y : r.y; return o;
}

template <int ACT  > struct EpiAct {
    static constexpr bool PERM = true;
    bf16_t* O; int ldc;
    __device__ __forceinline__ void operator()(const f32x4 (&acc)[2][2][4][2], const Unit& u, int wr, int wc, int fr, int fq) const {
        const int row0 = u.pm * BM + wr * 64 + fr; const int col0 = u.pn * BM + wc * 32 + 8 * fq;
#pragma unroll
        for (int ai = 0; ai < 2; ++ai)
#pragma unroll
            for (int m = 0; m < 4; ++m) { bf16_t* rowp = O + (size_t)(row0 + ai * HALF + m * 16) * ldc + col0;
#pragma unroll
                for (int bj = 0; bj < 2; ++bj) { f32x4 v0 = acc[ai][bj][m][0], v1 = acc[ai][bj][m][1];
                    if (ACT == 1) { f32x2 a = gelu_pk((f32x2){v0[0], v0[1]}), b = gelu_pk((f32x2){v0[2], v0[3]}), c = gelu_pk((f32x2){v1[0], v1[1]}), d = gelu_pk((f32x2){v1[2], v1[3]});
                        v0 = (f32x4){a.x, a.y, b.x, b.y}; v1 = (f32x4){c.x, c.y, d.x, d.y}; }
                    if (ACT == 2) {
#pragma unroll
                        for (int e = 0; e < 4; ++e) { float p = fmaxf(v0[e], 0.f), q = fmaxf(v1[e], 0.f); v0[e] = p * p; v1[e] = q * q; } }
                    u32x4 w; w.x = cvt_pk_bf16(v0[0], v0[1]); w.y = cvt_pk_bf16(v0[2], v0[3]); w.z = cvt_pk_bf16(v1[0], v1[1]); w.w = cvt_pk_bf16(v1[2], v1[3]);
                    *(u32x4*)(rowp + bj * HALF) = w; } }
    }
};
struct EpiRkvL {
    static constexpr bool PERM = true;
    bf16_t* R; size_t split_stride; bf16_t* L; int pn_off;
    __device__ __forceinline__ void operator()(const f32x4 (&acc)[2][2][4][2], const Unit& u0, int wr, int wc, int fr, int fq) const {
        Unit u = u0; u.pn += pn_off;
        const int row0 = u.pm * BM + wr * 64 + fr;
        bf16_t* base; int ldc, colt, mode;
        if (u.pn < 12) { base = R + (size_t)(u.pn >> 2) * split_stride; colt = (u.pn & 3) * BM; ldc = 1024; mode = 0; }
        else { base = L; colt = (u.pn - 12) * BM; ldc = 512; mode = (u.pn == 12) ? 1 : 2; }
        const int col0 = colt + wc * 32 + 8 * fq;
#pragma unroll
        for (int ai = 0; ai < 2; ++ai)
#pragma unroll
            for (int m = 0; m < 4; ++m) { bf16_t* rowp = base + (size_t)(row0 + ai * HALF + m * 16) * ldc + col0;
#pragma unroll
                for (int bj = 0; bj < 2; ++bj) { f32x4 v0 = acc[ai][bj][m][0], v1 = acc[ai][bj][m][1];
                    if (mode == 1 && bj == 0) {
#pragma unroll
                        for (int e = 0; e < 4; ++e) { v0[e] = tanhf(v0[e]); v1[e] = tanhf(v1[e]); } }
                    if (mode == 2) {
#pragma unroll
                        for (int e = 0; e < 4; ++e) { v0[e] = sigmoidf_(v0[e]); v1[e] = sigmoidf_(v1[e]); } }
                    u32x4 w; w.x = cvt_pk_bf16(v0[0], v0[1]); w.y = cvt_pk_bf16(v0[2], v0[3]); w.z = cvt_pk_bf16(v1[0], v1[1]); w.w = cvt_pk_bf16(v1[2], v1[3]);
                    *(u32x4*)(rowp + bj * HALF) = w; } }
    }
};
struct EpiL2 {
    static constexpr bool PERM = true;
    bf16_t* O0; bf16_t* O1; bf16_t* O2; const float* w0; const float* a0;
    __device__ __forceinline__ void operator()(const f32x4 (&acc)[2][2][4][2], const Unit& u, int wr, int wc, int fr, int fq) const {
        const int mode = u.pn >> 2;
        const int row0 = u.pm * BM + wr * 64 + fr; const int col0 = (u.pn & 3) * BM + wc * 32 + 8 * fq;
        bf16_t *o0 = O0, *o1 = O1, *o2 = O2; const float *bw = w0, *ba = a0;
        asm volatile("" : "+s"(o0), "+s"(o1), "+s"(o2), "+s"(bw), "+s"(ba));
        bf16_t* base = (mode == 0) ? o0 : ((mode == 1) ? o1 : o2);
        const float* bias = (mode == 0) ? bw : ba;
#pragma unroll
        for (int bj = 0; bj < 2; ++bj) {
            f32x4 b0 = {0.f, 0.f, 0.f, 0.f}, b1 = {0.f, 0.f, 0.f, 0.f};
            if (mode != 2) { b0 = *(const f32x4*)(bias + col0 + bj * HALF); b1 = *(const f32x4*)(bias + col0 + bj * HALF + 4); }
#pragma unroll
            for (int ai = 0; ai < 2; ++ai)
#pragma unroll
                for (int m = 0; m < 4; ++m) { bf16_t* rowp = base + (size_t)(row0 + ai * HALF + m * 16) * 1024 + col0;
                    f32x4 v0 = acc[ai][bj][m][0] + b0, v1 = acc[ai][bj][m][1] + b1;
                    if (mode != 2) {
                        const float sc = (mode == 0) ? -0.87503988f : 1.0f;
#pragma unroll
                        for (int e = 0; e < 4; ++e) { v0[e] = sc * __builtin_amdgcn_rcpf(1.0f + __expf(-v0[e])); v1[e] = sc * __builtin_amdgcn_rcpf(1.0f + __expf(-v1[e])); } }
                    u32x4 w; w.x = cvt_pk_bf16(v0[0], v0[1]); w.y = cvt_pk_bf16(v0[2], v0[3]); w.z = cvt_pk_bf16(v1[0], v1[1]); w.w = cvt_pk_bf16(v1[2], v1[3]);
                    *(u32x4*)(rowp + bj * HALF) = w;
                    if (m & 1) asm volatile("" ::: "memory"); }
        }
    }
};
struct EpiRes {
    static constexpr bool PERM = false;
    const float* base; float* out; const float* gate;
    int gstride;
    __device__ __forceinline__ void operator()(const f32x4 (&acc)[2][2][4][2], const Unit& u, int wr, int wc, int fr, int fq) const {
        const int col0 = u.pn * BM + wc * 32 + 4 * fq;
        const float* gp = gate + (size_t)(u.pm >> 4) * gstride + col0;
        f32x4 gv[2][2];
#pragma unroll
        for (int bj = 0; bj < 2; ++bj)
#pragma unroll
            for (int n = 0; n < 2; ++n) gv[bj][n] = *(const f32x4*)(gp + bj * HALF + n * 16);
#pragma unroll
        for (int ai = 0; ai < 2; ++ai)
#pragma unroll
            for (int m = 0; m < 4; ++m) { const size_t off = (size_t)(u.pm * BM + ai * HALF + wr * 64 + m * 16 + fr) * 1024 + col0;
#pragma unroll
                for (int bj = 0; bj < 2; ++bj)
#pragma unroll
                    for (int n = 0; n < 2; ++n) { const f32x4 bs = *(const f32x4*)(base + off + bj * HALF + n * 16);
                        *(f32x4*)(out + off + bj * HALF + n * 16) = bs + gv[bj][n] * acc[ai][bj][m][n]; } }
    }
};

template <class Epi>
__device__ __forceinline__ void gemm_phase(LAS unsigned char* lds, const Gemm g, const StaticOrder& S, const Epi& E) {
    const int tid = opaque_tid(), wid = __builtin_amdgcn_readfirstlane(tid >> 6), lane = tid & 63, wr = wid >> 2, wc = wid & 3, fr = lane & 15, fq = lane >> 4;
    int K_ = g.K; asm volatile("" : "+s"(K_));
    const int K = K_, nt = K / BK, lda = g.shift ? (K_ >> 1) : K_;
    const int ntA = g.shift ? (nt >> 1) : (1 << 30);
    const long adj = g.shift ? ((long)lda * 2 + (long)ntA * (BK * 2)) : 0;
    unsigned voffA[2], voffB[2];
#pragma unroll
    for (int i = 0; i < 2; ++i) { int R, C; stage_rc(tid * 16 + i * 8192, R, C); const int Rb = Epi::PERM ? ((R & ~31) + perm32(R & 31)) : R;
        voffA[i] = (unsigned)(R * lda + C) * 2u; voffB[i] = (unsigned)(Rb * K + C) * 2u; }
    const long kstep = (long)(BK * 2);
    const long hstepA = (long)HALF * lda * 2, hstepB = (long)HALF * K * 2, tstepB = 2 * hstepB;
    const unsigned ldsw = (unsigned)wid * 1024u;
    const int aoff = lds_byte(wr * 64 + fr, fq * 8), boff = lds_byte(wc * 32 + fr, fq * 8);
#define PG8_ABASE(u) ((const char*)g.A + ((long)((u).pn >> 2) * g.asplit + ((long)(u).pm * BM + (g.shift ? ((u).pm >> 4) + 1 : 0)) * (long)lda) * 2)
#define PG8_APTR(base, kt) ((base) + ((long)(kt) * kstep - (((kt) >= ntA) ? adj : 0)))
#define PG8_SA(b, h) (((b) * 2 + (h)) * HTB)
#define PG8_SB(b, h) ((4 + (b) * 2 + (h)) * HTB)
#define PG8_STAGE(bufoff, gbase, voff) do { _Pragma("unroll") for (int _i = 0; _i < 2; ++_i) \
        __builtin_amdgcn_global_load_lds((const unsigned*)((const char*)(gbase) + (voff)[_i]), (LAS unsigned*)(lds + (bufoff) + ldsw + _i * 8192), 16, 0, 0); } while (0)
#define PG8_LDA(dst, b, h) do { _Pragma("unroll") for (int m = 0; m < 4; ++m) _Pragma("unroll") for (int k = 0; k < 2; ++k) dst[m][k] = *(const LAS bf16x8*)(lds + PG8_SA(b, h) + aoff + m * 2048 + k * 1024); } while (0)
#define PG8_LDB(dst, b, h) do { _Pragma("unroll") for (int n = 0; n < 2; ++n) _Pragma("unroll") for (int k = 0; k < 2; ++k) dst[n][k] = *(const LAS bf16x8*)(lds + PG8_SB(b, h) + boff + n * 2048 + k * 1024); } while (0)
#define PG8_MMA(ai, bj, At, Bt) do { __builtin_amdgcn_s_setprio(1); _Pragma("unroll") for (int m = 0; m < 4; ++m) _Pragma("unroll") for (int n = 0; n < 2; ++n) _Pragma("unroll") for (int k = 0; k < 2; ++k) \
        acc[ai][bj][m][n] = __builtin_amdgcn_mfma_f32_16x16x32_bf16(Bt[n][k], At[m][k], acc[ai][bj][m][n], 0, 0, 0); __builtin_amdgcn_s_setprio(0); } while (0)
#define PG8_WAIT_V(n) asm volatile("s_waitcnt vmcnt(" #n ")" ::: "memory")
#define PG8_WAIT_L(n) asm volatile("s_waitcnt lgkmcnt(" #n ")" ::: "memory")
#define PG8_BAR __builtin_amdgcn_s_barrier()
#define PG8_SCHED __builtin_amdgcn_sched_barrier(0)
    Unit cur, nxt; int ui = 0;
    if (!S.next(0, cur)) return;
    f32x4 acc[2][2][4][2];
#pragma unroll
    for (int a = 0; a < 2; ++a)
#pragma unroll
        for (int b = 0; b < 2; ++b)
#pragma unroll
            for (int m = 0; m < 4; ++m)
#pragma unroll
                for (int n = 0; n < 2; ++n) acc[a][b][m][n] = (f32x4){0.f, 0.f, 0.f, 0.f};
    bf16x8 At[4][2], B0[2][2], B1[2][2];
    const char* cA = PG8_ABASE(cur); const char* cB = (const char*)g.Bt + (long)cur.pn * tstepB;
    PG8_STAGE(PG8_SB(0, 0), cB, voffB); PG8_STAGE(PG8_SB(0, 1), cB + hstepB, voffB); PG8_STAGE(PG8_SA(0, 0), cA, voffA); PG8_STAGE(PG8_SA(0, 1), cA + hstepA, voffA);
    if (wr == 1) PG8_BAR;
    PG8_WAIT_V(2); PG8_BAR;
    PG8_STAGE(PG8_SB(1, 0), cB + kstep, voffB); PG8_STAGE(PG8_SA(1, 0), cA + kstep, voffA); PG8_STAGE(PG8_SB(1, 1), cB + hstepB + kstep, voffB);
    PG8_WAIT_V(6); PG8_BAR;
    for (;;) {
        const bool has_next = S.next(ui + 1, nxt);
        const char* nA = has_next ? PG8_ABASE(nxt) : cA; const char* nB = has_next ? (const char*)g.Bt + (long)nxt.pn * tstepB : cB;
        for (int t = 0; t < nt; t += 2) {
            const bool last = (t == nt - 2);
            const char* a1 = PG8_APTR(cA, t + 1);
            const char* a2 = last ? nA : PG8_APTR(cA, t + 2); const char* b2 = last ? nB : cB + (long)(t + 2) * kstep;
            const char* a3 = a2 + kstep; const char* b3 = b2 + kstep;
            PG8_LDB(B0, 0, 0); PG8_LDB(B1, 0, 1); PG8_SCHED; PG8_LDA(At, 0, 0); PG8_STAGE(PG8_SA(1, 1), a1 + hstepA, voffA);
            PG8_WAIT_V(8); PG8_WAIT_L(0); PG8_BAR; PG8_MMA(0, 0, At, B0); PG8_MMA(0, 1, At, B1); PG8_BAR; PG8_SCHED;
            PG8_LDA(At, 0, 1); PG8_STAGE(PG8_SB(0, 0), b2, voffB); PG8_STAGE(PG8_SB(0, 1), b2 + hstepB, voffB); PG8_STAGE(PG8_SA(0, 0), a2, voffA);
            PG8_WAIT_V(8); PG8_WAIT_L(0); PG8_BAR; PG8_MMA(1, 0, At, B0); PG8_MMA(1, 1, At, B1); PG8_BAR; PG8_SCHED;
            PG8_LDB(B0, 1, 0); PG8_LDB(B1, 1, 1); PG8_SCHED; PG8_LDA(At, 1, 0); PG8_STAGE(PG8_SA(0, 1), a2 + hstepA, voffA);
            PG8_WAIT_V(8); PG8_WAIT_L(0); PG8_BAR; PG8_MMA(0, 0, At, B0); PG8_MMA(0, 1, At, B1); PG8_BAR; PG8_SCHED;
            PG8_LDA(At, 1, 1); PG8_STAGE(PG8_SB(1, 0), b3, voffB); PG8_STAGE(PG8_SB(1, 1), b3 + hstepB, voffB); PG8_STAGE(PG8_SA(1, 0), a3, voffA);
            PG8_WAIT_V(8); PG8_WAIT_L(0); PG8_BAR; PG8_MMA(1, 0, At, B0); PG8_MMA(1, 1, At, B1); PG8_BAR; PG8_SCHED;
        }
        if (wr == 0) PG8_BAR;
        E(acc, cur, wr, wc, fr, fq);
        if (!has_next) break;
#pragma unroll
        for (int a = 0; a < 2; ++a)
#pragma unroll
            for (int b = 0; b < 2; ++b)
#pragma unroll
                for (int m = 0; m < 4; ++m)
#pragma unroll
                    for (int n = 0; n < 2; ++n) acc[a][b][m][n] = (f32x4){0.f, 0.f, 0.f, 0.f};
        cur = nxt; cA = nA; cB = nB; ++ui;
        if (wr == 1) PG8_BAR;
    }
    PG8_WAIT_V(0);
    PG8_BAR;
#undef PG8_ABASE
#undef PG8_APTR
#undef PG8_SA
#undef PG8_SB
#undef PG8_STAGE
#undef PG8_LDA
#undef PG8_LDB
#undef PG8_MMA
#undef PG8_WAIT_V
#undef PG8_WAIT_L
#undef PG8_BAR
#undef PG8_SCHED
}
}

constexpr size_t MiB = 1u << 20;
constexpr size_t WS_MOD = 1 * MiB;
constexpr size_t WS_WIN0 = 2 * MiB;
constexpr size_t WS_WOUT0 = 6 * MiB;
constexpr size_t WS_W1 = 8 * MiB;
constexpr size_t WS_W2 = 24 * MiB;
constexpr size_t WS_WRKV = 40 * MiB;
constexpr size_t WS_WL1 = 46 * MiB;
constexpr size_t WS_WL2 = 48 * MiB;
constexpr size_t WS_WOUT1 = 51 * MiB;
constexpr size_t WS_WS = 53 * MiB;
constexpr size_t WS_H = 60 * MiB;
constexpr size_t WS_UV = 188 * MiB;
constexpr size_t WS_Z = 444 * MiB;
constexpr size_t WS_HID = 188 * MiB;
constexpr size_t WS_X3 = 54 * MiB;
constexpr size_t WS_H2 = 438 * MiB;
constexpr size_t WS_L = 952 * MiB;
constexpr size_t WS_R = 567 * MiB, WS_K = 695 * MiB, WS_V = 823 * MiB;
constexpr size_t WS_WE = 60 * MiB, WS_A = 188 * MiB, WS_G = 316 * MiB;
constexpr size_t WS_YG = 54 * MiB;
constexpr size_t WS_END = 1020 * MiB;
constexpr int LDS_BYTES = 147456;

struct Args {
    const float* in[29];
    float* out; unsigned char* ws;
    int lo, hi;
};

__device__ __forceinline__ float wave_sum(float v) {
#pragma unroll
    for (int o = 1; o < 64; o <<= 1) v += __shfl_xor(v, o);
    return v;
}
template <int CTRL> __device__ __forceinline__ float dppf(float v) { return __builtin_bit_cast(float, __builtin_amdgcn_update_dpp(0, __builtin_bit_cast(int, v), CTRL, 0xF, 0xF, true)); }
__device__ __forceinline__ float reduce16(float v) {
    v += dppf<0xB1>(v); v += dppf<0x4E>(v); v += dppf<0x141>(v); v += dppf<0x140>(v); return v;
}

#define XB_TMO      128
#define XB_XCNT(j)  (256  + 64 * (j))
#define XB_XSUB(j)  (1280 + 64 * (j))
#define XB_XGEN(j)  (2304 + 64 * (j))
#define XB_TOP      3328
#define XB_TOPGEN   3392
#define XCD_BAR_WORDS 3456
#define XB_SPIN_CAP (1u << 18)

__device__ __forceinline__ unsigned xb_ld(unsigned* p)              { return __hip_atomic_load(p, __ATOMIC_RELAXED, __HIP_MEMORY_SCOPE_AGENT); }
__device__ __forceinline__ unsigned xb_add(unsigned* p, unsigned v) { return __hip_atomic_fetch_add(p, v, __ATOMIC_RELAXED, __HIP_MEMORY_SCOPE_AGENT); }
__device__ __forceinline__ unsigned xb_xcc_id() { return (unsigned)__builtin_amdgcn_s_getreg((3 << 11) | 20) & 0xFu; }
#define XB_SPIN(cond, bar) do { unsigned _sp = 0; while (cond) { __builtin_amdgcn_s_sleep(1); \
    if ((++_sp & 255u) == 0u) { if (xb_ld(&(bar)[XB_TMO])) break; if (_sp > XB_SPIN_CAP) { atomicAdd(&(bar)[XB_TMO], 1u); break; } } } } while (0)

struct XcdBarrier {
    unsigned* bar; unsigned x;
    volatile LAS unsigned* st;
};

__device__ __forceinline__ XcdBarrier xcd_barrier_post(unsigned* bar, volatile LAS unsigned* st) {
    XcdBarrier b; b.bar = bar; b.x = xb_xcc_id(); b.st = st;
    if (threadIdx.x == 0) (void)xb_add(&bar[XB_XCNT(b.x)], 1u);
    return b;
}
__device__ __forceinline__ void xcd_barrier_complete(unsigned* bar, unsigned x, unsigned& nloc, unsigned& nx) {
    const unsigned G = gridDim.x * gridDim.y * gridDim.z;
    unsigned sum, cnt, mine, sp = 0u;
    for (;;) {
        sum = 0u; cnt = 0u; mine = 0u;
#pragma unroll
        for (unsigned j = 0; j < 16; ++j) { const unsigned c = xb_ld(&bar[XB_XCNT(j)]); sum += c; cnt += (c > 0u) ? 1u : 0u; mine = (j == x) ? c : mine; }
        if (sum == G) break;
        __builtin_amdgcn_s_sleep(1);
        if ((++sp & 255u) == 0u) { if (xb_ld(&bar[XB_TMO])) break; if (sp > XB_SPIN_CAP) { atomicAdd(&bar[XB_TMO], 1u); break; } }
    }
    nloc = mine > 0u ? mine : 1u; nx = cnt > 0u ? cnt : 1u;
}

__device__ __forceinline__ void xcd_barrier(const XcdBarrier& b) {
    asm volatile("s_waitcnt vmcnt(0)" ::: "memory");
    __syncthreads();
    if (threadIdx.x == 0) {
        unsigned* bar = b.bar;
        __builtin_amdgcn_s_waitcnt(0);
        unsigned nloc = b.st[0], nx = b.st[1];
        if (nloc == 0u) { xcd_barrier_complete(bar, b.x, nloc, nx); b.st[0] = nloc; b.st[1] = nx; }
        const unsigned old = xb_add(&bar[XB_XSUB(b.x)], 1u);
        const unsigned gen = old / nloc;
        if (old + 1u == (gen + 1u) * nloc) {
            __builtin_amdgcn_fence(__ATOMIC_RELEASE, "agent");
            asm volatile("s_waitcnt vmcnt(0)" ::: "memory");
            const unsigned og = xb_add(&bar[XB_TOP], 1u);
            const unsigned tg = og / nx;
            if (og + 1u == (tg + 1u) * nx) xb_add(&bar[XB_TOPGEN], 1u);
            else XB_SPIN(xb_ld(&bar[XB_TOPGEN]) == tg, bar);
            __builtin_amdgcn_fence(__ATOMIC_ACQUIRE, "agent");
            xb_add(&bar[XB_XGEN(b.x)], 1u);
            asm volatile("s_waitcnt vmcnt(0)" ::: "memory");
        } else {
            XB_SPIN(xb_ld(&bar[XB_XGEN(b.x)]) == gen, bar);
            __builtin_amdgcn_fence(__ATOMIC_ACQUIRE, "agent");
            asm volatile("s_waitcnt vmcnt(0)" ::: "memory");
        }
    }
    __syncthreads();
}


__device__ __forceinline__ void gsync(cg::grid_group& grid) {
    asm volatile("s_waitcnt vmcnt(0) lgkmcnt(0)" ::: "memory");
    grid.sync();
    if (threadIdx.x < 64) { __builtin_amdgcn_fence(__ATOMIC_ACQUIRE, "agent"); asm volatile("s_waitcnt vmcnt(0)" ::: "memory"); }
    __syncthreads();
}
__device__ __forceinline__ void transpose_item(const float* W, int lds_, int Ksrc, int Nsrc, bf16_t* WT, int ldd, int row_off, int col_off,
                                               const float* mu, int mode, LAS float* scr, int kb, int nb, int lane) {
    const int k0 = 64 * kb, n0 = 32 * nb;
#pragma unroll 8
    for (int i = 0; i < 32; ++i) { const int kk = 2 * i + (lane >> 5), nn = lane & 31, k = k0 + kk, n = n0 + nn;
        float v = (k < Ksrc && n < Nsrc) ? W[(size_t)k * lds_ + n] : 0.f;
        if (mode) { const float m = mu[k & 1023]; v *= (mode == 1) ? (1.f - m) : m; }
        scr[kk * 33 + nn] = v; }
    asm volatile("s_waitcnt lgkmcnt(0)" ::: "memory");
    const int c = lane & 7;
#pragma unroll
    for (int j = 0; j < 4; ++j) { const int n = (lane >> 3) + 8 * j; const LAS float* s = scr + (8 * c) * 33 + n;
        u32x4 o; o.x = cvt_pk_bf16(s[0 * 33], s[1 * 33]); o.y = cvt_pk_bf16(s[2 * 33], s[3 * 33]); o.z = cvt_pk_bf16(s[4 * 33], s[5 * 33]); o.w = cvt_pk_bf16(s[6 * 33], s[7 * 33]);
        *(u32x4*)(WT + (size_t)(row_off + n0 + n) * ldd + col_off + k0 + 8 * c) = o; }
    asm volatile("s_waitcnt lgkmcnt(0)" ::: "memory");
}

__device__ __forceinline__ void phase_prep(const Args& a, LAS unsigned char* lds) {
    const int tid = opaque_tid(), lane = tid & 63, wave = tid >> 6;
    unsigned char* ws = a.ws;
    {
        LAS float* sc = (LAS float*)lds;
        LAS float* red = (LAS float*)(lds + 65536);
        bool have = false;
        for (int it = blockIdx.x; it < 2 * 96; it += gridDim.x) {
            if (!have) { const float* c = a.in[1];
                for (int e = tid; e < 16 * 1024; e += NTHREADS) { const int b = e >> 10, k = e & 1023; const float x = c[e]; sc[k * 16 + b] = x / (1.f + __expf(-x)); }
                have = true; }
            __syncthreads();
            const int l = it / 96, n0 = (it % 96) * 64;
            const float* w = a.in[2] + (size_t)l * 1024 * 6144 + n0 + lane;
            float acc[16];
#pragma unroll
            for (int b = 0; b < 16; ++b) acc[b] = 0.f;
            const int kbeg = wave * 128;
#pragma unroll 8
            for (int k = kbeg; k < kbeg + 128; ++k) { const float wv = w[(size_t)k * 6144];
                const LAS f32x4* s4 = (const LAS f32x4*)(sc + k * 16);
#pragma unroll
                for (int q = 0; q < 4; ++q) { const f32x4 s = s4[q]; acc[4 * q] += s[0] * wv; acc[4 * q + 1] += s[1] * wv; acc[4 * q + 2] += s[2] * wv; acc[4 * q + 3] += s[3] * wv; } }
#pragma unroll
            for (int b = 0; b < 16; ++b) red[(wave * 16 + b) * 64 + lane] = acc[b];
            __syncthreads();
            float* mod = (float*)(ws + WS_MOD);
            for (int e = tid; e < 1024; e += NTHREADS) { const int b = e >> 6, n = e & 63; float s = 0.f;
#pragma unroll
                for (int wv = 0; wv < 8; ++wv) s += red[(wv * 16 + b) * 64 + n];
                mod[((size_t)l * 16 + b) * 6144 + n0 + n] = s + a.in[3][l * 6144 + n0 + n]; }
            __syncthreads();
        }
        __syncthreads();
    }
}
__device__ __forceinline__ void phase_weights(const Args& a, LAS unsigned char* lds) {
    const int tid = opaque_tid(), lane = tid & 63, wave = tid >> 6;
    unsigned char* ws = a.ws;
    {
        LAS float* scr = (LAS float*)(lds + wave * 16384);
        const int gw = blockIdx.x * NWAVES + wave, NGW = gridDim.x * NWAVES;
        const float* mu = a.in[12];
        constexpr int TOTAL = 16 * 64 + 16 * 32 + 2 * 16 * 128 + 2 * 64 * 32 + 3 * 16 * 32 + 2 * (16 * 4 + 16 * 4 + 16 * 8) + 24 * 32 + 16 * 32;
        for (int it = gw; it < TOTAL; it += NGW) {
            int r = it;
#define JOB(W, LDSRC, KS, NS, DST, LDD, RO, CO, MU, MODE, KB, NBK) if (r >= 0) { if (r < (KB) * (NBK)) { transpose_item((W), (LDSRC), (KS), (NS), (bf16_t*)(ws + (DST)), (LDD), (RO), (CO), (MU), (MODE), scr, r / (NBK), r % (NBK), lane); r = -1; } else r -= (KB) * (NBK); }
            JOB(a.in[6], 2048, 1024, 2048, WS_WIN0, 1024, 0, 0, mu, 0, 16, 64)
            JOB(a.in[11], 1024, 1024, 1024, WS_WOUT0, 1024, 0, 0, mu, 0, 16, 32)
            JOB(a.in[4], 4096, 1024, 4096, WS_W1, 1024, 0, 0, mu, 0, 16, 128)
            JOB(a.in[4] + (size_t)1024 * 4096, 4096, 1024, 4096, WS_W1 + (size_t)4096 * 1024 * 2, 1024, 0, 0, mu, 0, 16, 128)
            JOB(a.in[5], 1024, 4096, 1024, WS_W2, 4096, 0, 0, mu, 0, 64, 32)
            JOB(a.in[5] + (size_t)4096 * 1024, 1024, 4096, 1024, WS_W2 + (size_t)1024 * 4096 * 2, 4096, 0, 0, mu, 0, 64, 32)
            JOB(a.in[13] + 0, 3072, 1024, 1024, WS_WRKV, 1024, 0, 0, mu, 0, 16, 32)
            JOB(a.in[13] + 1024, 3072, 1024, 1024, WS_WRKV, 1024, 1024, 0, mu, 0, 16, 32)
            JOB(a.in[13] + 2048, 3072, 1024, 1024, WS_WRKV, 1024, 2048, 0, mu, 0, 16, 32)
            JOB(a.in[15], 64, 1024, 64, WS_WL1, 2048, 0, 0, mu + 1 * 1024, 1, 16, 4)
            JOB(a.in[15], 64, 1024, 64, WS_WL1, 2048, 0, 1024, mu + 1 * 1024, 2, 16, 4)
            JOB(a.in[18], 64, 1024, 64, WS_WL1, 2048, 128, 0, mu + 4 * 1024, 1, 16, 4)
            JOB(a.in[18], 64, 1024, 64, WS_WL1, 2048, 128, 1024, mu + 4 * 1024, 2, 16, 4)
            JOB(a.in[20], 160, 1024, 160, WS_WL1, 2048, 256, 0, mu + 5 * 1024, 1, 16, 8)
            JOB(a.in[20], 160, 1024, 160, WS_WL1, 2048, 256, 1024, mu + 5 * 1024, 2, 16, 8)
            JOB(a.in[16], 1024, 64, 1024, WS_WL2, 512, 0, 0, mu, 0, 2, 32)
            JOB(a.in[16], 1024, 0, 1024, WS_WL2, 512, 0, 128, mu, 0, 6, 32)
            JOB(a.in[19], 1024, 0, 1024, WS_WL2, 512, 1024, 0, mu, 0, 2, 32)
            JOB(a.in[19], 1024, 64, 1024, WS_WL2, 512, 1024, 128, mu, 0, 2, 32)
            JOB(a.in[19], 1024, 0, 1024, WS_WL2, 512, 1024, 256, mu, 0, 4, 32)
            JOB(a.in[21], 1024, 0, 1024, WS_WL2, 512, 2048, 0, mu, 0, 4, 32)
            JOB(a.in[21], 1024, 160, 1024, WS_WL2, 512, 2048, 256, mu, 0, 4, 32)
            JOB(a.in[27], 1024, 1024, 1024, WS_WOUT1, 1024, 0, 0, mu, 0, 16, 32)
#undef JOB
        }
        bf16_t* wsb = (bf16_t*)(ws + WS_WS);
        for (int e = blockIdx.x * NTHREADS + tid; e < 8 * 128 * 128 / 2; e += gridDim.x * NTHREADS) {
            const int i = e * 2, s = i & 127, t = (i >> 7) & 127;
            const float v0 = (s <= t) ? a.in[9][i] : 0.f, v1 = (s + 1 <= t) ? a.in[9][i + 1] : 0.f;
            ((unsigned*)wsb)[e] = cvt_pk_bf16(v0, v1);
        }
    }
}

__device__ __forceinline__ void phase_norm_mod(const float* x, const float* mod_shift, const float* mod_scale, bf16_t* H, int) {
    const int tid = opaque_tid(), lane = tid & 63, wave = tid >> 6;
    const int gw = blockIdx.x * NWAVES + wave, NGW = gridDim.x * NWAVES;
    constexpr int NR = 4;
    for (int m0 = gw; m0 < M; m0 += NR * NGW) {
        f32x4 v[NR][4];
#pragma unroll
        for (int r = 0; r < NR; ++r) { const int m = M - 1 - (m0 + r * NGW < M ? m0 + r * NGW : m0); const f32x4* xr = (const f32x4*)(x + (size_t)m * D) + lane;
#pragma unroll
            for (int j = 0; j < 4; ++j) v[r][j] = xr[64 * j]; }
#pragma unroll
        for (int r = 0; r < NR; ++r) { const int m = M - 1 - (m0 + r * NGW); if (m >= 0) {
            const int b = m >> 12; float s = 0.f;
#pragma unroll
            for (int j = 0; j < 4; ++j) s += (v[r][j].x * v[r][j].x + v[r][j].y * v[r][j].y) + (v[r][j].z * v[r][j].z + v[r][j].w * v[r][j].w);
            const float rstd = 1.0f / sqrtf(wave_sum(s) * (1.f / D) + 1e-6f);
            const f32x4* sh = (const f32x4*)(mod_shift + (size_t)b * 6144) + lane;
            const f32x4* sc = (const f32x4*)(mod_scale + (size_t)b * 6144) + lane;
            u32x2* o = (u32x2*)(H + (size_t)m * D) + lane;
#pragma unroll
            for (int j = 0; j < 4; ++j) { const f32x4 a = sh[64 * j], c = sc[64 * j]; const f32x4 h = v[r][j] * rstd * (c + 1.0f) + a;
                u32x2 w; w.x = cvt_pk_bf16(h.x, h.y); w.y = cvt_pk_bf16(h.z, h.w); o[64 * j] = w; } } }
    }
}
__device__ __forceinline__ void phase_final_norm(float* x, const float* g) {
    const int tid = opaque_tid(), lane = tid & 63, wave = tid >> 6;
    const int gw = blockIdx.x * NWAVES + wave, NGW = gridDim.x * NWAVES;
    constexpr int NR = 4;
    f32x4 gg[4];
#pragma unroll
    for (int j = 0; j < 4; ++j) gg[j] = ((const f32x4*)g)[lane + 64 * j];
    for (int m0 = gw; m0 < M; m0 += NR * NGW) {
        f32x4 v[NR][4];
#pragma unroll
        for (int r = 0; r < NR; ++r) { const int m = (m0 + r * NGW < M ? m0 + r * NGW : m0); const f32x4* xr = (const f32x4*)(x + (size_t)m * D) + lane;
#pragma unroll
            for (int j = 0; j < 4; ++j) v[r][j] = xr[64 * j]; }
#pragma unroll
        for (int r = 0; r < NR; ++r) { const int m = m0 + r * NGW; if (m < M) {
            float s = 0.f;
#pragma unroll
            for (int j = 0; j < 4; ++j) s += (v[r][j].x * v[r][j].x + v[r][j].y * v[r][j].y) + (v[r][j].z * v[r][j].z + v[r][j].w * v[r][j].w);
            const float rstd = 1.0f / sqrtf(wave_sum(s) * (1.f / D) + 1e-6f);
            f32x4* xr = (f32x4*)(x + (size_t)m * D) + lane;
#pragma unroll
            for (int j = 0; j < 4; ++j) xr[64 * j] = v[r][j] * rstd * gg[j]; } }
    }
}
__device__ __forceinline__ void load_row(const float* x, size_t m, int lane, f32x4 (&v)[4]) {
    const f32x4* xr = (const f32x4*)(x + m * D) + lane;
#pragma unroll
    for (int j = 0; j < 4; ++j) v[j] = xr[64 * j];
}
__device__ __forceinline__ void finish_row(f32x4 (&h)[4], const f32x4 (&sh)[4], const f32x4 (&sc1)[4]) {
    float s = 0.f;
#pragma unroll
    for (int j = 0; j < 4; ++j) s += (h[j].x * h[j].x + h[j].y * h[j].y) + (h[j].z * h[j].z + h[j].w * h[j].w);
    const float rstd = 1.0f / sqrtf(wave_sum(s) * (1.f / D) + 1e-6f);
#pragma unroll
    for (int j = 0; j < 4; ++j) h[j] = h[j] * rstd * sc1[j] + sh[j];
}
__device__ __forceinline__ void phase_norm_shift(const float* x, const float* mod_shift, const float* mod_scale, const float* mu, bf16_t* X3, bf16_t* H2) {
    const int tid = opaque_tid(), lane = tid & 63, wave = tid >> 6;
    const int gw = blockIdx.x * NWAVES + wave, NGW = gridDim.x * NWAVES;
    f32x4 mr[4], mk[4], mv[4];
#pragma unroll
    for (int j = 0; j < 4; ++j) { mr[j] = ((const f32x4*)(mu + 0 * 1024))[lane + 64 * j]; mk[j] = ((const f32x4*)(mu + 2 * 1024))[lane + 64 * j]; mv[j] = ((const f32x4*)(mu + 3 * 1024))[lane + 64 * j]; }
    for (int blk = gw; blk < M / 32; blk += NGW) {
        const size_t m0 = (size_t)blk * 32; const int b = (int)(m0 >> 12);
        f32x4 sh[4], sc1[4];
#pragma unroll
        for (int j = 0; j < 4; ++j) { sh[j] = ((const f32x4*)(mod_shift + (size_t)b * 6144))[lane + 64 * j]; sc1[j] = ((const f32x4*)(mod_scale + (size_t)b * 6144))[lane + 64 * j] + 1.0f; }
        f32x4 hp[4], h[4], n1[4], n2[4];
        const bool first = (m0 & 4095) == 0;
        load_row(x, first ? m0 : m0 - 1, lane, hp); load_row(x, m0, lane, h); load_row(x, m0 + 1, lane, n1);
        finish_row(hp, sh, sc1);
        if (first) {
#pragma unroll
            for (int j = 0; j < 4; ++j) hp[j] = (f32x4){0.f, 0.f, 0.f, 0.f}; }
        for (int i = 0; i < 32; ++i) {
            const size_t m = m0 + i;
            load_row(x, (i + 2 < 32) ? m + 2 : m, lane, n2);
            finish_row(h, sh, sc1);
            u32x2* o2 = (u32x2*)(H2 + (m + b + 1) * D) + lane;
            u32x2* or_ = (u32x2*)(X3 + m * D) + lane;
#pragma unroll
            for (int j = 0; j < 4; ++j) {
                const f32x4 d = hp[j] - h[j];
                const f32x4 xr = h[j] + d * mr[j], xk = h[j] + d * mk[j], xv = h[j] + d * mv[j];
                u32x2 w; w.x = cvt_pk_bf16(h[j].x, h[j].y); w.y = cvt_pk_bf16(h[j].z, h[j].w); o2[64 * j] = w;
                if (first && i == 0) o2[64 * j - D / 4] = (u32x2){0u, 0u};
                w.x = cvt_pk_bf16(xr.x, xr.y); w.y = cvt_pk_bf16(xr.z, xr.w); or_[64 * j] = w;
                w.x = cvt_pk_bf16(xk.x, xk.y); w.y = cvt_pk_bf16(xk.z, xk.w); or_[64 * j + (size_t)M * D / 4] = w;
                w.x = cvt_pk_bf16(xv.x, xv.y); w.y = cvt_pk_bf16(xv.z, xv.w); or_[64 * j + 2 * (size_t)M * D / 4] = w;
                hp[j] = h[j]; h[j] = n1[j]; n1[j] = n2[j];
            }
        }
    }
}

__device__ __forceinline__ void phase_sgu(const Args& a, LAS unsigned char* lds) {
    const int tid = opaque_tid(), lane = tid & 63, wave = tid >> 6, fr = lane & 15, fq = lane >> 4;
    const bf16_t* UV = (const bf16_t*)(a.ws + WS_UV); bf16_t* Z = (bf16_t*)(a.ws + WS_Z);
    const bf16_t* WSB = (const bf16_t*)(a.ws + WS_WS);
    const float* lng = a.in[7]; const float* lnb = a.in[8]; const float* bs = a.in[10];
    constexpr int RS = 272;
    LAS unsigned char* Wl = lds;
    LAS unsigned char* Vl = lds + 128 * RS;
    LAS f32x2* st = (LAS f32x2*)(lds + 2 * 128 * RS);
    const int wt = wave >> 2, wd = wave & 3;
    for (int tile_ = blockIdx.x; tile_ < M / 128; tile_ += gridDim.x) {
        const int tile = M / 128 - 1 - tile_;
        const size_t m0 = (size_t)tile * 128;
        for (int r = wave * 16; r < wave * 16 + 16; ++r) {
            const u32x4* p = (const u32x4*)(UV + (m0 + r) * 2048 + 1024) + lane;
            const u32x4 q0 = p[0], q1 = p[64];
            float f[16];
            f[0] = bf_lo(q0.x); f[1] = bf_hi(q0.x); f[2] = bf_lo(q0.y); f[3] = bf_hi(q0.y); f[4] = bf_lo(q0.z); f[5] = bf_hi(q0.z); f[6] = bf_lo(q0.w); f[7] = bf_hi(q0.w);
            f[8] = bf_lo(q1.x); f[9] = bf_hi(q1.x); f[10] = bf_lo(q1.y); f[11] = bf_hi(q1.y); f[12] = bf_lo(q1.z); f[13] = bf_hi(q1.z); f[14] = bf_lo(q1.w); f[15] = bf_hi(q1.w);
            float s = 0.f;
#pragma unroll
            for (int e = 0; e < 16; ++e) s += f[e];
            const float mean = wave_sum(s) * (1.f / 1024.f);
            float q = 0.f;
#pragma unroll
            for (int e = 0; e < 16; ++e) { const float d = f[e] - mean; q += d * d; }
            const float var = wave_sum(q) * (1.f / 1024.f);
            if (lane == 0) st[r] = (f32x2){mean, 1.0f / sqrtf(var + 1e-5f)};
        }
        __syncthreads();
        for (int g = 0; g < 8; ++g) {
            {
                const u32x4* src = (const u32x4*)(WSB + (size_t)g * 128 * 128);
#pragma unroll
                for (int i = 0; i < 4; ++i) { const int idx = tid + i * NTHREADS; const int t = idx >> 4, c = idx & 15;
                    *(LAS u32x4*)(Wl + t * RS + c * 16) = src[idx]; }
            }
            {
                const int sp = tid & 63, dq = tid >> 6, s0 = 2 * sp, d0 = dq * 16;
                const f32x2 st0 = st[s0], st1 = st[s0 + 1];
                const bf16_t* p0 = UV + (m0 + s0) * 2048 + 1024 + g * 128 + d0;
                const u32x4 a0 = *(const u32x4*)p0, a1 = *(const u32x4*)(p0 + 8), b0 = *(const u32x4*)(p0 + 2048), b1 = *(const u32x4*)(p0 + 2048 + 8);
                const unsigned ua[8] = {a0.x, a0.y, a0.z, a0.w, a1.x, a1.y, a1.z, a1.w}, ub[8] = {b0.x, b0.y, b0.z, b0.w, b1.x, b1.y, b1.z, b1.w};
                const float* gp = lng + g * 128 + d0; const float* bp = lnb + g * 128 + d0;
#pragma unroll
                for (int e = 0; e < 8; ++e) {
                    const float g0 = gp[2 * e], g1 = gp[2 * e + 1], c0 = bp[2 * e], c1 = bp[2 * e + 1];
                    const float x00 = (bf_lo(ua[e]) - st0.x) * st0.y * g0 + c0, x01 = (bf_hi(ua[e]) - st0.x) * st0.y * g1 + c1;
                    const float x10 = (bf_lo(ub[e]) - st1.x) * st1.y * g0 + c0, x11 = (bf_hi(ub[e]) - st1.x) * st1.y * g1 + c1;
                    *(LAS unsigned*)(Vl + (d0 + 2 * e) * RS + s0 * 2) = cvt_pk_bf16(x00, x10);
                    *(LAS unsigned*)(Vl + (d0 + 2 * e + 1) * RS + s0 * 2) = cvt_pk_bf16(x01, x11);
                }
            }
            __syncthreads();
            f32x4 acc[4][2];
#pragma unroll
            for (int mi = 0; mi < 4; ++mi)
#pragma unroll
                for (int ni = 0; ni < 2; ++ni) acc[mi][ni] = (f32x4){0.f, 0.f, 0.f, 0.f};
#pragma unroll
            for (int ks = 0; ks < 4; ++ks) {
                if (ks * 32 <= 64 * wt + 63) {
                    bf16x8 bfr[2];
#pragma unroll
                    for (int ni = 0; ni < 2; ++ni) bfr[ni] = *(const LAS bf16x8*)(Vl + (32 * wd + 16 * ni + fr) * RS + (ks * 32 + fq * 8) * 2);
#pragma unroll
                    for (int mi = 0; mi < 4; ++mi) {
                        if (ks * 32 <= 64 * wt + 16 * mi + 15) {
                            const bf16x8 afr = *(const LAS bf16x8*)(Wl + (64 * wt + 16 * mi + fr) * RS + (ks * 32 + fq * 8) * 2);
#pragma unroll
                            for (int ni = 0; ni < 2; ++ni) acc[mi][ni] = __builtin_amdgcn_mfma_f32_16x16x32_bf16(bfr[ni], afr, acc[mi][ni], 0, 0, 0);
                        }
                    }
                }
            }
#pragma unroll
            for (int mi = 0; mi < 4; ++mi) {
                const int t = 64 * wt + 16 * mi + fr; const float bias = bs[g * 128 + t];
#pragma unroll
                for (int ni = 0; ni < 2; ++ni) {
                    const int col = g * 128 + 32 * wd + 16 * ni + 4 * fq;
                    const u32x2 uu = *(const u32x2*)(UV + (m0 + t) * 2048 + col);
                    const f32x4 sv = acc[mi][ni];
                    u32x2 o; o.x = cvt_pk_bf16(bf_lo(uu.x) * (sv[0] + bias), bf_hi(uu.x) * (sv[1] + bias)); o.y = cvt_pk_bf16(bf_lo(uu.y) * (sv[2] + bias), bf_hi(uu.y) * (sv[3] + bias));
                    *(u32x2*)(Z + (m0 + t) * 1024 + col) = o;
                }
            }
            __syncthreads();
        }
    }
}

__device__ __forceinline__ float fma_(float a, float b, float c) { float d; asm("v_fma_f32 %0, %1, %2, %3" : "=v"(d) : "v"(a), "v"(b), "v"(c)); return d; }
__device__ __forceinline__ float mul_(float a, float b) { float d; asm("v_mul_f32 %0, %1, %2" : "=v"(d) : "v"(a), "v"(b)); return d; }
__device__ __forceinline__ float dot4_(const f32x4& s, const f32x4& o) { return fma_(s.w, o.w, fma_(s.z, o.z, fma_(s.y, o.y, mul_(s.x, o.x)))); }
__device__ __forceinline__ void upd4_(f32x4& s, const f32x4& w, const f32x4& b, const f32x4& k, float sa, float v) {
    s.x = fma_(v, k.x, fma_(sa, b.x, mul_(s.x, w.x))); s.y = fma_(v, k.y, fma_(sa, b.y, mul_(s.y, w.y)));
    s.z = fma_(v, k.z, fma_(sa, b.z, mul_(s.z, w.z))); s.w = fma_(v, k.w, fma_(sa, b.w, mul_(s.w, w.w)));
}
__device__ __forceinline__ f32x2 pkmul_(f32x2 a, f32x2 b) { f32x2 d; asm("v_pk_mul_f32 %0, %1, %2" : "=v"(d) : "v"(a), "v"(b)); return d; }
__device__ __forceinline__ f32x2 pkfma_(f32x2 a, f32x2 b, f32x2 c) { f32x2 d; asm("v_pk_fma_f32 %0, %1, %2, %3" : "=v"(d) : "v"(a), "v"(b), "v"(c)); return d; }
__device__ __forceinline__ f32x2 pkfma_lo_(f32x2 a, f32x2 b, f32x2 c) { f32x2 d; asm("v_pk_fma_f32 %0, %1, %2, %3 op_sel_hi:[0,1,1]" : "=v"(d) : "v"(a), "v"(b), "v"(c)); return d; }
__device__ __forceinline__ f32x2 pkfma_hi_(f32x2 a, f32x2 b, f32x2 c) { f32x2 d; asm("v_pk_fma_f32 %0, %1, %2, %3 op_sel:[1,0,0]" : "=v"(d) : "v"(a), "v"(b), "v"(c)); return d; }
__device__ __forceinline__ float add_(float a, float b) { float d; asm("v_add_f32 %0, %1, %2" : "=v"(d) : "v"(a), "v"(b)); return d; }
#define LO2(v) __builtin_shufflevector(v, v, 0, 1)
#define HI2(v) __builtin_shufflevector(v, v, 2, 3)
__device__ __forceinline__ void phase_scan(const Args& a, LAS unsigned char* lds) {
    const int tid = opaque_tid(), lane = tid & 63, wave = tid >> 6;
    constexpr int TC = 32;
    LAS float* op = (LAS float*)lds;
    LAS float* vb = (LAS float*)(lds + (TC + 1) * 1280);
    LAS float* yb = (LAS float*)(lds + (TC + 1) * 1280 + (TC + 1) * 256);
    const bf16_t* Rg = (const bf16_t*)(a.ws + WS_R); const bf16_t* Kg = (const bf16_t*)(a.ws + WS_K); const bf16_t* Vg = (const bf16_t*)(a.ws + WS_V);
    const bf16_t* Lg = (const bf16_t*)(a.ws + WS_L); const bf16_t* WL2 = (const bf16_t*)(a.ws + WS_WL2);
    constexpr int XS = 68;
    LAS float* xb = (LAS float*)(lds + (TC + 1) * 1280 + (TC + 1) * 256 + TC * 1024);
    const int fr = lane & 15, fq = lane >> 4, stile = wave >> 2, ntile = wave & 3;
    bf16_t* YG = (bf16_t*)(a.ws + WS_YG);
    const int ts = tid >> 4, jg = tid & 15;
    const int ig = lane >> 4;
    const int r0 = wave * 8 + ig * 2;
    for (int hd = blockIdx.x; hd < NB * 16; hd += gridDim.x) {
        const int b = hd >> 4, h = hd & 15;
        const int ch = h * 64 + jg * 4;
        const f32x4 kk4 = *(const f32x4*)(a.in[22] + ch), ka4 = *(const f32x4*)(a.in[23] + ch), rk4 = *(const f32x4*)(a.in[24] + ch);
        const f32x4 lg4 = *(const f32x4*)(a.in[25] + ch), lb4 = *(const f32x4*)(a.in[26] + ch);
        const size_t base = ((size_t)b * T) * D + ch;
        f32x2 S0a = {0.f, 0.f}, S0b = {0.f, 0.f}, S1a = {0.f, 0.f}, S1b = {0.f, 0.f};
        size_t off = base + (size_t)ts * D;
        u32x2 pr = *(const u32x2*)(Rg + off), pk = *(const u32x2*)(Kg + off), pv = *(const u32x2*)(Vg + off);
        const int chn = h * 64 + ntile * 16 + fr;
        bf16x8 bw[2], ba[2], bg[5];
#pragma unroll
        for (int ks = 0; ks < 2; ++ks) { bw[ks] = *(const bf16x8*)(WL2 + (size_t)chn * 512 + ks * 32 + fq * 8); ba[ks] = *(const bf16x8*)(WL2 + (size_t)(1024 + chn) * 512 + 128 + ks * 32 + fq * 8); }
#pragma unroll
        for (int ks = 0; ks < 5; ++ks) bg[ks] = *(const bf16x8*)(WL2 + (size_t)(2048 + chn) * 512 + 256 + ks * 32 + fq * 8);
        const float w0c = a.in[14][chn], a0c = a.in[17][chn];
        bf16x8 aw[2], aa[2], ag[5];
#define LORA_LOAD(cc) do { const bf16_t* lrow = Lg + ((size_t)b * T + (size_t)(cc) * TC + stile * 16 + fr) * 512 + fq * 8; \
            _Pragma("unroll") for (int ks = 0; ks < 2; ++ks) { aw[ks] = *(const bf16x8*)(lrow + ks * 32); aa[ks] = *(const bf16x8*)(lrow + 128 + ks * 32); } \
            _Pragma("unroll") for (int ks = 0; ks < 5; ++ks) ag[ks] = *(const bf16x8*)(lrow + 256 + ks * 32); } while (0)
#define LORA_RUN() do { f32x4 cw = {0.f, 0.f, 0.f, 0.f}, ca = {0.f, 0.f, 0.f, 0.f}, cg_ = {0.f, 0.f, 0.f, 0.f}; \
            _Pragma("unroll") for (int ks = 0; ks < 2; ++ks) { cw = __builtin_amdgcn_mfma_f32_16x16x32_bf16(aw[ks], bw[ks], cw, 0, 0, 0); ca = __builtin_amdgcn_mfma_f32_16x16x32_bf16(aa[ks], ba[ks], ca, 0, 0, 0); } \
            _Pragma("unroll") for (int ks = 0; ks < 5; ++ks) cg_ = __builtin_amdgcn_mfma_f32_16x16x32_bf16(ag[ks], bg[ks], cg_, 0, 0, 0); \
            _Pragma("unroll") for (int e = 0; e < 4; ++e) { const int xi = (stile * 16 + 4 * fq + e) * XS + ntile * 16 + fr; \
                xb[xi] = __builtin_amdgcn_exp2f(-0.87503988f * __builtin_amdgcn_rcpf(1.0f + __expf(-(w0c + cw[e])))); \
                xb[TC * XS + xi] = __builtin_amdgcn_rcpf(1.0f + __expf(-(a0c + ca[e]))); \
                xb[2 * TC * XS + xi] = cg_[e]; } } while (0)
        LORA_LOAD(0); LORA_RUN();
        __syncthreads();
        u32x2 ypend = {0u, 0u};
        for (int c = 0; c < T / TC; ++c) {
            const f32x4 r4 = {bf_lo(pr.x), bf_hi(pr.x), bf_lo(pr.y), bf_hi(pr.y)};
            const f32x4 k4 = {bf_lo(pk.x), bf_hi(pk.x), bf_lo(pk.y), bf_hi(pk.y)};
            const f32x4 v4 = {bf_lo(pv.x), bf_hi(pv.x), bf_lo(pv.y), bf_hi(pv.y)};
            const f32x4 w4 = *(const LAS f32x4*)(xb + ts * XS + jg * 4), a4 = *(const LAS f32x4*)(xb + TC * XS + ts * XS + jg * 4), g4 = *(const LAS f32x4*)(xb + 2 * TC * XS + ts * XS + jg * 4);
            const f32x4 kkx = k4 * kk4;
            const float ss = reduce16((kkx.x * kkx.x + kkx.y * kkx.y) + (kkx.z * kkx.z + kkx.w * kkx.w));
            const float inv = __builtin_amdgcn_rsqf(fmaxf(ss, 1e-24f));
            const f32x4 kk = kkx * inv;
            const f32x4 kf = k4 * ((a4 - 1.0f) * ka4 + 1.0f);
            const f32x4 am = -kk, bm = kk * a4;
            const f32x4 rkr = r4 * kf * rk4;
            const float ct = reduce16((rkr.x + rkr.y) + (rkr.z + rkr.w));
            {
                LAS f32x4* o = (LAS f32x4*)(op + (ts * 16 + jg) * 20);
                o[0] = w4; o[1] = am; o[2] = bm; o[3] = kf; o[4] = r4;
                *(LAS f32x4*)(vb + ts * 64 + jg * 4) = v4;
            }
            __syncthreads();
            if (c > 0) *(u32x2*)(YG + base + (size_t)((c - 1) * TC + ts) * D) = ypend;
            if (c + 1 < T / TC) { off = base + (size_t)((c + 1) * TC + ts) * D;
                pr = *(const u32x2*)(Rg + off); pk = *(const u32x2*)(Kg + off); pv = *(const u32x2*)(Vg + off);
                LORA_LOAD(c + 1); }
            {
                const LAS float* obase = op + (lane & 15) * 20;
                const LAS float* vbase = vb + r0;
                f32x4 ow = *(const LAS f32x4*)(obase), oa = *(const LAS f32x4*)(obase + 4), ob = *(const LAS f32x4*)(obase + 8), ok = *(const LAS f32x4*)(obase + 12), orr = *(const LAS f32x4*)(obase + 16);
                f32x2 vv = *(const LAS f32x2*)(vbase);
#pragma unroll 2
                for (int s = 0; s < TC; ++s) {
                    const LAS float* o = obase + (s + 1) * 320;
                    const f32x4 now = *(const LAS f32x4*)(o), noa = *(const LAS f32x4*)(o + 4), nob = *(const LAS f32x4*)(o + 8), nok = *(const LAS f32x4*)(o + 12), norr = *(const LAS f32x4*)(o + 16);
                    const f32x2 nvv = *(const LAS f32x2*)(vbase + (s + 1) * 64);
                    const f32x2 p0 = pkfma_(S0b, HI2(oa), pkmul_(S0a, LO2(oa))), p1 = pkfma_(S1b, HI2(oa), pkmul_(S1a, LO2(oa)));
                    float sa0 = add_(p0.x, p0.y), sa1 = add_(p1.x, p1.y);
                    sa0 = reduce16(sa0); asm volatile("" : "+v"(sa0)); sa1 = reduce16(sa1);
                    const f32x2 sap = {sa0, sa1};
                    S0a = pkfma_lo_(vv, LO2(ok), pkfma_lo_(sap, LO2(ob), pkmul_(S0a, LO2(ow))));
                    S0b = pkfma_lo_(vv, HI2(ok), pkfma_lo_(sap, HI2(ob), pkmul_(S0b, HI2(ow))));
                    S1a = pkfma_hi_(vv, LO2(ok), pkfma_hi_(sap, LO2(ob), pkmul_(S1a, LO2(ow))));
                    S1b = pkfma_hi_(vv, HI2(ok), pkfma_hi_(sap, HI2(ob), pkmul_(S1b, HI2(ow))));
                    const f32x2 q0 = pkfma_(S0b, HI2(orr), pkmul_(S0a, LO2(orr))), q1 = pkfma_(S1b, HI2(orr), pkmul_(S1a, LO2(orr)));
                    float y0 = add_(q0.x, q0.y), y1 = add_(q1.x, q1.y);
                    y0 += dppf<0xB1>(y0); y1 += dppf<0xB1>(y1); y0 += dppf<0x4E>(y0); y1 += dppf<0x4E>(y1);
                    if ((lane & 3) == 0) *(LAS f32x2*)(yb + (s * 4 + ((lane >> 2) & 3)) * 64 + r0) = (f32x2){y0, y1};
                    ow = now; oa = noa; ob = nob; ok = nok; orr = norr; vv = nvv;
                }
            }
            __syncthreads();
            {
                const f32x4 y4 = (*(const LAS f32x4*)(yb + (ts * 4 + 0) * 64 + jg * 4) + *(const LAS f32x4*)(yb + (ts * 4 + 1) * 64 + jg * 4)) + (*(const LAS f32x4*)(yb + (ts * 4 + 2) * 64 + jg * 4) + *(const LAS f32x4*)(yb + (ts * 4 + 3) * 64 + jg * 4));
                const float mean = reduce16((y4.x + y4.y) + (y4.z + y4.w)) * (1.f / 64.f);
                const f32x4 d = y4 - mean;
                const float var = reduce16((d.x * d.x + d.y * d.y) + (d.z * d.z + d.w * d.w)) * (1.f / 64.f);
                const float rstd = __builtin_amdgcn_rsqf(var + 64e-5f);
                const f32x4 o = ((d * rstd) * lg4 + lb4 + v4 * ct) * g4;
                u32x2 w; w.x = cvt_pk_bf16(o.x, o.y); w.y = cvt_pk_bf16(o.z, o.w);
                ypend = w;
            }
            if (c + 1 < T / TC) LORA_RUN();
            __syncthreads();
        }
        *(u32x2*)(YG + base + (size_t)((T / TC - 1) * TC + ts) * D) = ypend;
#undef LORA_LOAD
#undef LORA_RUN
    }
}


#define SEAM() do { ++ph; if (lo < ph && ph < hi) { if (ph == 1) gsync(grid); else xcd_barrier(xbar); } } while (0)
#define RUN (lo <= ph && ph < hi)
template <int l> __device__ __forceinline__ void layer(const Args& a, LAS unsigned char* lds, cg::grid_group& grid, const XcdBarrier& xbar, int& ph, const int lo, const int hi) {
    unsigned char* ws = a.ws;
    const float* MOD = (const float*)(ws + WS_MOD);
    bf16_t* H = (bf16_t*)(ws + WS_H);
    const int G = gridDim.x, c = blockIdx.x;
    const float* mod = MOD + (size_t)l * 16 * 6144;
    const float* xin = (l == 0) ? a.in[0] : a.out;
    if (RUN) {
        if (l == 1) phase_norm_shift(xin, mod + 0 * 1024, mod + 1 * 1024, a.in[12], (bf16_t*)(ws + WS_X3), (bf16_t*)(ws + WS_H2));
        else if ((threadIdx.x >> 6) < 4) { phase_norm_mod(xin, mod + 0 * 1024, mod + 1 * 1024, H, 0); phase_weights(a, lds); }
        else { phase_weights(a, lds); phase_norm_mod(xin, mod + 0 * 1024, mod + 1 * 1024, H, 0); }
    }
    SEAM();
    if (l == 0) {
        if (RUN) { pg8::Gemm g{H, (const bf16_t*)(ws + WS_WIN0), M, 2048, 1024, 0, 0}; pg8::StaticOrder S; S.init(M, 2048, G, c);
          pg8::EpiAct<1> E{(bf16_t*)(ws + WS_UV), 2048}; pg8::gemm_phase(lds, g, S, E); }
        SEAM();
        if (RUN) phase_sgu(a, lds);
        SEAM();
        if (RUN) { pg8::Gemm g{(const bf16_t*)(ws + WS_Z), (const bf16_t*)(ws + WS_WOUT0), M, 1024, 1024, 0, 0}; pg8::StaticOrder S; S.init(M, 1024, G, c);
          pg8::EpiRes E{a.in[0], a.out, mod + 2 * 1024, 6144}; pg8::gemm_phase(lds, g, S, E); }
    } else {
        if (RUN) {
          { pg8::Gemm g{(const bf16_t*)(ws + WS_H2), (const bf16_t*)(ws + WS_WL1), M, 512, 2048, 0, 1}; pg8::StaticOrder S; S.init(M, 512, G, c, 1);
            pg8::EpiRkvL E{(bf16_t*)(ws + WS_R), (size_t)(WS_K - WS_R) / 2, (bf16_t*)(ws + WS_L), 12}; pg8::gemm_phase(lds, g, S, E); }
          { pg8::Gemm g{(const bf16_t*)(ws + WS_X3), (const bf16_t*)(ws + WS_WRKV), M, 3072, 1024, (long)M * D, 0}; pg8::StaticOrder S; S.init(M, 3072, G, c, 1);
            pg8::EpiRkvL E{(bf16_t*)(ws + WS_R), (size_t)(WS_K - WS_R) / 2, (bf16_t*)(ws + WS_L), 0}; pg8::gemm_phase(lds, g, S, E); }
        }
        SEAM();
        if (RUN) phase_scan(a, lds);
        SEAM();
        if (RUN) { pg8::Gemm g{(const bf16_t*)(ws + WS_YG), (const bf16_t*)(ws + WS_WOUT1), M, 1024, 1024, 0, 0}; pg8::StaticOrder S; S.init(M, 1024, G, c);
          pg8::EpiRes E{a.out, a.out, mod + 2 * 1024, 6144}; pg8::gemm_phase(lds, g, S, E); }
    }
    SEAM();
    if (RUN) phase_norm_mod(a.out, mod + 3 * 1024, mod + 4 * 1024, H, 0);
    SEAM();
    if (RUN) { pg8::Gemm g{H, (const bf16_t*)(ws + WS_W1 + (size_t)l * 4096 * 1024 * 2), M, 4096, 1024, 0, 0}; pg8::StaticOrder S; S.init(M, 4096, G, c);
      pg8::EpiAct<2> E{(bf16_t*)(ws + WS_HID), 4096}; pg8::gemm_phase(lds, g, S, E); }
    SEAM();
    if (RUN) { pg8::Gemm g{(const bf16_t*)(ws + WS_HID), (const bf16_t*)(ws + WS_W2 + (size_t)l * 1024 * 4096 * 2), M, 1024, 4096, 0, 0}; pg8::StaticOrder S; S.init(M, 1024, G, c, 1);
      pg8::EpiRes E{a.out, a.out, mod + 5 * 1024, 6144}; pg8::gemm_phase(lds, g, S, E); }
    SEAM();
}
constexpr int NPHASES = 16;

__global__ void __launch_bounds__(NTHREADS, 2) fwd_megakernel(Args a) {
    extern __shared__ __attribute__((aligned(16))) unsigned char lds_raw[];
    LAS unsigned char* lds = (LAS unsigned char*)lds_raw;
    cg::grid_group grid = cg::this_grid();
    const int lo = a.lo, hi = a.hi;
    int ph = 0;
    volatile LAS unsigned* bst = (volatile LAS unsigned*)(lds + 131072 + 512);
    if (threadIdx.x < 2) bst[threadIdx.x] = 0u;
    __syncthreads();
    XcdBarrier xbar; xbar.bar = (unsigned*)a.ws; xbar.x = 0; xbar.st = nullptr;
    if (hi - lo > 1) xbar = xcd_barrier_post((unsigned*)a.ws, bst);
    if (RUN) phase_prep(a, lds);
    SEAM();
    layer<0>(a, lds, grid, xbar, ph, lo, hi);
    layer<1>(a, lds, grid, xbar, ph, lo, hi);
    if (RUN) phase_final_norm(a.out, a.in[28]);
}
#ifndef N_LAUNCHES
#define N_LAUNCHES 1
#endif

extern "C" void kernel_launch(void* const* d_in, const int* in_sizes, int n_in, void* d_out, int out_size, void* d_ws, size_t ws_size, hipStream_t stream) {
    static int grid = 0;
    if (grid == 0) {
        if (n_in != 29 || out_size != M * D || ws_size < WS_END) { fprintf(stderr, "kernel_launch: unexpected problem: n_in %d out %d ws %zu (need %zu)\n", n_in, out_size, ws_size, (size_t)WS_END); grid = -1; return; }
        int dev = 0, cus = 0, per_cu = 0;
        hipGetDevice(&dev);
        hipDeviceGetAttribute(&cus, hipDeviceAttributeMultiprocessorCount, dev);
        if (hipFuncSetAttribute((const void*)fwd_megakernel, hipFuncAttributeMaxDynamicSharedMemorySize, LDS_BYTES) != hipSuccess) { fprintf(stderr, "kernel_launch: hipFuncSetAttribute failed\n"); grid = -1; return; }
        if (hipOccupancyMaxActiveBlocksPerMultiprocessor(&per_cu, (const void*)fwd_megakernel, NTHREADS, LDS_BYTES) != hipSuccess || per_cu < 1) { fprintf(stderr, "kernel_launch: occupancy query says %d blocks/CU\n", per_cu); per_cu = 1; }
        (void)hipGetLastError();
        grid = cus;
    }
    if (grid < 0) return;
    Args a{};
    for (int i = 0; i < 29; ++i) a.in[i] = (const float*)d_in[i];
    a.out = (float*)d_out; a.ws = (unsigned char*)d_ws;
    if (N_LAUNCHES == 1) {
        if (hipMemsetAsync(d_ws, 0, 16384, stream) != hipSuccess) { fprintf(stderr, "kernel_launch: memset of the barrier words failed\n"); return; }
        a.lo = 0; a.hi = NPHASES;
        void* args[] = {&a};
        hipError_t e = hipLaunchCooperativeKernel((const void*)fwd_megakernel, dim3(grid), dim3(NTHREADS), args, LDS_BYTES, stream);
        if (e != hipSuccess) fprintf(stderr, "kernel_launch: cooperative launch failed: %s (grid %d)\n", hipGetErrorString(e), grid);
    } else {
        for (int p = 0; p < NPHASES; ++p) { a.lo = p; a.hi = p + 1;
            hipLaunchKernelGGL(fwd_megakernel, dim3(grid), dim3(NTHREADS), LDS_BYTES, stream, a); }
    }
}
```

```cpp
#include <hip/hip_runtime.h>
#include <hip/hip_cooperative_groups.h>
#include <cstdio>
#include <cstdint>
namespace cg = cooperative_groups;

#define LAS __attribute__((address_space(3)))
typedef unsigned short bf16_t;
typedef short bf16x8 __attribute__((ext_vector_type(8)));
typedef float f32x4 __attribute__((ext_vector_type(4)));
typedef float f32x2 __attribute__((ext_vector_type(2)));
typedef unsigned u32x4 __attribute__((ext_vector_type(4)));
typedef unsigned u32x2 __attribute__((ext_vector_type(2)));

constexpr int D = 1024, NB = 16, T = 4096, M = NB * T, FF = 4096, NMOD = 6;
constexpr int NTHREADS = 512, NWAVES = 8;

__device__ __forceinline__ int opaque_tid() { int t = threadIdx.x; asm volatile("" : "+v"(t)); return t; }
__device__ __forceinline__ unsigned cvt_pk_bf16(float lo, float hi) { unsigned r; asm volatile("v_cvt_pk_bf16_f32 %0, %1, %2" : "=v"(r) : "v"(lo), "v"(hi)); return r; }
__device__ __forceinline__ float bf_lo(unsigned u) { return __builtin_bit_cast(float, u << 16); }
__device__ __forceinline__ float bf_hi(unsigned u) { return __builtin_bit_cast(float, u & 0xffff0000u); }
__device__ __forceinline__ float sigmoidf_(float x) { return __builtin_amdgcn_rcpf(1.0f + __expf(-x)); }

namespace pg8 {
constexpr int BM = 256, BK = 64, HALF = 128, HTB = HALF * BK * 2, STAGE_BYTES = 8 * HTB, NXCD = 8, WGM = 8;
__host__ __device__ __forceinline__ int lds_byte(int r, int c) { const int st = (r >> 4) * 2 + (c >> 5), rr = r & 15, cc = c & 31, ob = rr * 64 + cc * 2; return st * 1024 + (ob ^ (((ob >> 9) & 1) << 5)); }
__host__ __device__ __forceinline__ void stage_rc(int b, int& R, int& C) { const int st = b / 1024, sb = b % 1024, swz = sb ^ (((sb >> 9) & 1) << 5); R = (st >> 1) * 16 + swz / 64; C = (st & 1) * 32 + (swz % 64) / 2; }
__host__ __device__ __forceinline__ int perm32(int rho) { const int n = rho >> 4, i = rho & 15; return 8 * (i >> 2) + 4 * n + (i & 3); }

struct Unit { int pm, pn; };
struct Gemm { const bf16_t* A; const bf16_t* Bt; int M, N, K; long asplit; int shift; };

struct StaticOrder {
    int nM, nN, nwg, G, c, rev;
    __device__ void init(int M_, int N_, int G_, int c_, int rev_ = 0) { nM = M_ / BM; nN = N_ / BM; nwg = nM * nN; G = G_; c = c_; rev = rev_; }
    __device__ bool next(int i, Unit& u) const {
        const long L = (long)i * G + c; if (L >= nwg) return false;
        int wgid = (int)L; { const int q = nwg / NXCD, r = nwg % NXCD, xcd = wgid % NXCD, off = wgid / NXCD; wgid = (xcd < r ? xcd * (q + 1) : r * (q + 1) + (xcd - r) * q) + off; }
        const int nig = WGM * nN, gid = wgid / nig, fm = gid * WGM, gsz = (nM - fm) < WGM ? (nM - fm) : WGM;
        u.pm = fm + ((wgid % nig) % gsz); u.pn = (wgid % nig) / gsz; if (rev) u.pm = nM - 1 - u.pm; return true;
    }
};

__device__ __forceinline__ f32x2 gelu_pk(f32x2 v) {
    const f32x2 av = __builtin_elementwise_abs(v), d = av * 0.2316418882f + 1.0f;
    f32x2 t; t.x = __builtin_amdgcn_rcpf(d.x); t.y = __builtin_amdgcn_rcpf(d.y);
    f32x2 q = t * 0.5307027145f + (-0.7265760135f); q = q * t + 0.7107068705f; q = q * t + (-0.142248368f); q = q * t + 0.127414796f; q = q * t;
    const f32x2 s = (v * v) * (-0.72134752044f);
    f32x2 e; e.x = __builtin_amdgcn_exp2f(s.x); e.y = __builtin_amdgcn_exp2f(s.y);
    const f32x2 m = v * (q * e), r = v - m;
    f32x2 o; o.x = v.x < 0.f ? m.x : r.x; o.y = v.y < 0.f ? m.y : r.y; return o;
}

template <int ACT  > struct EpiAct {
    static constexpr bool PERM = true;
    bf16_t* O; int ldc;
    __device__ __forceinline__ void operator()(const f32x4 (&acc)[2][2][4][2], const Unit& u, int wr, int wc, int fr, int fq) const {
        const int row0 = u.pm * BM + wr * 64 + fr; const int col0 = u.pn * BM + wc * 32 + 8 * fq;
#pragma unroll
        for (int ai = 0; ai < 2; ++ai)
#pragma unroll
            for (int m = 0; m < 4; ++m) { bf16_t* rowp = O + (size_t)(row0 + ai * HALF + m * 16) * ldc + col0;
#pragma unroll
                for (int bj = 0; bj < 2; ++bj) { f32x4 v0 = acc[ai][bj][m][0], v1 = acc[ai][bj][m][1];
                    if (ACT == 1) { f32x2 a = gelu_pk((f32x2){v0[0], v0[1]}), b = gelu_pk((f32x2){v0[2], v0[3]}), c = gelu_pk((f32x2){v1[0], v1[1]}), d = gelu_pk((f32x2){v1[2], v1[3]});
                        v0 = (f32x4){a.x, a.y, b.x, b.y}; v1 = (f32x4){c.x, c.y, d.x, d.y}; }
                    if (ACT == 2) {
#pragma unroll
                        for (int e = 0; e < 4; ++e) { float p = fmaxf(v0[e], 0.f), q = fmaxf(v1[e], 0.f); v0[e] = p * p; v1[e] = q * q; } }
                    u32x4 w; w.x = cvt_pk_bf16(v0[0], v0[1]); w.y = cvt_pk_bf16(v0[2], v0[3]); w.z = cvt_pk_bf16(v1[0], v1[1]); w.w = cvt_pk_bf16(v1[2], v1[3]);
                    *(u32x4*)(rowp + bj * HALF) = w; } }
    }
};
struct EpiRkvL {
    static constexpr bool PERM = true;
    bf16_t* R; size_t split_stride; bf16_t* L; int pn_off;
    __device__ __forceinline__ void operator()(const f32x4 (&acc)[2][2][4][2], const Unit& u0, int wr, int wc, int fr, int fq) const {
        Unit u = u0; u.pn += pn_off;
        const int row0 = u.pm * BM + wr * 64 + fr;
        bf16_t* base; int ldc, colt, mode;
        if (u.pn < 12) { base = R + (size_t)(u.pn >> 2) * split_stride; colt = (u.pn & 3) * BM; ldc = 1024; mode = 0; }
        else { base = L; colt = (u.pn - 12) * BM; ldc = 512; mode = (u.pn == 12) ? 1 : 2; }
        const int col0 = colt + wc * 32 + 8 * fq;
#pragma unroll
        for (int ai = 0; ai < 2; ++ai)
#pragma unroll
            for (int m = 0; m < 4; ++m) { bf16_t* rowp = base + (size_t)(row0 + ai * HALF + m * 16) * ldc + col0;
#pragma unroll
                for (int bj = 0; bj < 2; ++bj) { f32x4 v0 = acc[ai][bj][m][0], v1 = acc[ai][bj][m][1];
                    if (mode == 1 && bj == 0) {
#pragma unroll
                        for (int e = 0; e < 4; ++e) { v0[e] = tanhf(v0[e]); v1[e] = tanhf(v1[e]); } }
                    if (mode == 2) {
#pragma unroll
                        for (int e = 0; e < 4; ++e) { v0[e] = sigmoidf_(v0[e]); v1[e] = sigmoidf_(v1[e]); } }
                    u32x4 w; w.x = cvt_pk_bf16(v0[0], v0[1]); w.y = cvt_pk_bf16(v0[2], v0[3]); w.z = cvt_pk_bf16(v1[0], v1[1]); w.w = cvt_pk_bf16(v1[2], v1[3]);
                    *(u32x4*)(rowp + bj * HALF) = w; } }
    }
};
struct EpiL2 {
    static constexpr bool PERM = true;
    bf16_t* O0; bf16_t* O1; bf16_t* O2; const float* w0; const float* a0;
    __device__ __forceinline__ void operator()(const f32x4 (&acc)[2][2][4][2], const Unit& u, int wr, int wc, int fr, int fq) const {
        const int mode = u.pn >> 2;
        const int row0 = u.pm * BM + wr * 64 + fr; const int col0 = (u.pn & 3) * BM + wc * 32 + 8 * fq;
        bf16_t *o0 = O0, *o1 = O1, *o2 = O2; const float *bw = w0, *ba = a0;
        asm volatile("" : "+s"(o0), "+s"(o1), "+s"(o2), "+s"(bw), "+s"(ba));
        bf16_t* base = (mode == 0) ? o0 : ((mode == 1) ? o1 : o2);
        const float* bias = (mode == 0) ? bw : ba;
#pragma unroll
        for (int bj = 0; bj < 2; ++bj) {
            f32x4 b0 = {0.f, 0.f, 0.f, 0.f}, b1 = {0.f, 0.f, 0.f, 0.f};
            if (mode != 2) { b0 = *(const f32x4*)(bias + col0 + bj * HALF); b1 = *(const f32x4*)(bias + col0 + bj * HALF + 4); }
#pragma unroll
            for (int ai = 0; ai < 2; ++ai)
#pragma unroll
                for (int m = 0; m < 4; ++m) { bf16_t* rowp = base + (size_t)(row0 + ai * HALF + m * 16) * 1024 + col0;
                    f32x4 v0 = acc[ai][bj][m][0] + b0, v1 = acc[ai][bj][m][1] + b1;
                    if (mode != 2) {
                        const float sc = (mode == 0) ? -0.87503988f : 1.0f;
#pragma unroll
                        for (int e = 0; e < 4; ++e) { v0[e] = sc * __builtin_amdgcn_rcpf(1.0f + __expf(-v0[e])); v1[e] = sc * __builtin_amdgcn_rcpf(1.0f + __expf(-v1[e])); } }
                    u32x4 w; w.x = cvt_pk_bf16(v0[0], v0[1]); w.y = cvt_pk_bf16(v0[2], v0[3]); w.z = cvt_pk_bf16(v1[0], v1[1]); w.w = cvt_pk_bf16(v1[2], v1[3]);
                    *(u32x4*)(rowp + bj * HALF) = w;
                    if (m & 1) asm volatile("" ::: "memory"); }
        }
    }
};
struct EpiRes {
    static constexpr bool PERM = false;
    const float* base; float* out; const float* gate;
    int gstride;
    __device__ __forceinline__ void operator()(const f32x4 (&acc)[2][2][4][2], const Unit& u, int wr, int wc, int fr, int fq) const {
        const int col0 = u.pn * BM + wc * 32 + 4 * fq;
        const float* gp = gate + (size_t)(u.pm >> 4) * gstride + col0;
        f32x4 gv[2][2];
#pragma unroll
        for (int bj = 0; bj < 2; ++bj)
#pragma unroll
            for (int n = 0; n < 2; ++n) gv[bj][n] = *(const f32x4*)(gp + bj * HALF + n * 16);
#pragma unroll
        for (int ai = 0; ai < 2; ++ai)
#pragma unroll
            for (int m = 0; m < 4; ++m) { const size_t off = (size_t)(u.pm * BM + ai * HALF + wr * 64 + m * 16 + fr) * 1024 + col0;
#pragma unroll
                for (int bj = 0; bj < 2; ++bj)
#pragma unroll
                    for (int n = 0; n < 2; ++n) { const f32x4 bs = *(const f32x4*)(base + off + bj * HALF + n * 16);
                        *(f32x4*)(out + off + bj * HALF + n * 16) = bs + gv[bj][n] * acc[ai][bj][m][n]; } }
    }
};

template <class Epi>
__device__ __forceinline__ void gemm_phase(LAS unsigned char* lds, const Gemm g, const StaticOrder& S, const Epi& E) {
    const int tid = opaque_tid(), wid = __builtin_amdgcn_readfirstlane(tid >> 6), lane = tid & 63, wr = wid >> 2, wc = wid & 3, fr = lane & 15, fq = lane >> 4;
    int K_ = g.K; asm volatile("" : "+s"(K_));
    const int K = K_, nt = K / BK, lda = g.shift ? (K_ >> 1) : K_;
    const int ntA = g.shift ? (nt >> 1) : (1 << 30);
    const long adj = g.shift ? ((long)lda * 2 + (long)ntA * (BK * 2)) : 0;
    unsigned voffA[2], voffB[2];
#pragma unroll
    for (int i = 0; i < 2; ++i) { int R, C; stage_rc(tid * 16 + i * 8192, R, C); const int Rb = Epi::PERM ? ((R & ~31) + perm32(R & 31)) : R;
        voffA[i] = (unsigned)(R * lda + C) * 2u; voffB[i] = (unsigned)(Rb * K + C) * 2u; }
    const long kstep = (long)(BK * 2);
    const long hstepA = (long)HALF * lda * 2, hstepB = (long)HALF * K * 2, tstepB = 2 * hstepB;
    const unsigned ldsw = (unsigned)wid * 1024u;
    const int aoff = lds_byte(wr * 64 + fr, fq * 8), boff = lds_byte(wc * 32 + fr, fq * 8);
#define PG8_ABASE(u) ((const char*)g.A + ((long)((u).pn >> 2) * g.asplit + ((long)(u).pm * BM + (g.shift ? ((u).pm >> 4) + 1 : 0)) * (long)lda) * 2)
#define PG8_APTR(base, kt) ((base) + ((long)(kt) * kstep - (((kt) >= ntA) ? adj : 0)))
#define PG8_SA(b, h) (((b) * 2 + (h)) * HTB)
#define PG8_SB(b, h) ((4 + (b) * 2 + (h)) * HTB)
#define PG8_STAGE(bufoff, gbase, voff) do { _Pragma("unroll") for (int _i = 0; _i < 2; ++_i) \
        __builtin_amdgcn_global_load_lds((const unsigned*)((const char*)(gbase) + (voff)[_i]), (LAS unsigned*)(lds + (bufoff) + ldsw + _i * 8192), 16, 0, 0); } while (0)
#define PG8_LDA(dst, b, h) do { _Pragma("unroll") for (int m = 0; m < 4; ++m) _Pragma("unroll") for (int k = 0; k < 2; ++k) dst[m][k] = *(const LAS bf16x8*)(lds + PG8_SA(b, h) + aoff + m * 2048 + k * 1024); } while (0)
#define PG8_LDB(dst, b, h) do { _Pragma("unroll") for (int n = 0; n < 2; ++n) _Pragma("unroll") for (int k = 0; k < 2; ++k) dst[n][k] = *(const LAS bf16x8*)(lds + PG8_SB(b, h) + boff + n * 2048 + k * 1024); } while (0)
#define PG8_MMA(ai, bj, At, Bt) do { __builtin_amdgcn_s_setprio(1); _Pragma("unroll") for (int m = 0; m < 4; ++m) _Pragma("unroll") for (int n = 0; n < 2; ++n) _Pragma("unroll") for (int k = 0; k < 2; ++k) \
        acc[ai][bj][m][n] = __builtin_amdgcn_mfma_f32_16x16x32_bf16(Bt[n][k], At[m][k], acc[ai][bj][m][n], 0, 0, 0); __builtin_amdgcn_s_setprio(0); } while (0)
#define PG8_WAIT_V(n) asm volatile("s_waitcnt vmcnt(" #n ")" ::: "memory")
#define PG8_WAIT_L(n) asm volatile("s_waitcnt lgkmcnt(" #n ")" ::: "memory")
#define PG8_BAR __builtin_amdgcn_s_barrier()
#define PG8_SCHED __builtin_amdgcn_sched_barrier(0)
    Unit cur, nxt; int ui = 0;
    if (!S.next(0, cur)) return;
    f32x4 acc[2][2][4][2];
#pragma unroll
    for (int a = 0; a < 2; ++a)
#pragma unroll
        for (int b = 0; b < 2; ++b)
#pragma unroll
            for (int m = 0; m < 4; ++m)
#pragma unroll
                for (int n = 0; n < 2; ++n) acc[a][b][m][n] = (f32x4){0.f, 0.f, 0.f, 0.f};
    bf16x8 At[4][2], B0[2][2], B1[2][2];
    const char* cA = PG8_ABASE(cur); const char* cB = (const char*)g.Bt + (long)cur.pn * tstepB;
    PG8_STAGE(PG8_SB(0, 0), cB, voffB); PG8_STAGE(PG8_SB(0, 1), cB + hstepB, voffB); PG8_STAGE(PG8_SA(0, 0), cA, voffA); PG8_STAGE(PG8_SA(0, 1), cA + hstepA, voffA);
    if (wr == 1) PG8_BAR;
    PG8_WAIT_V(2); PG8_BAR;
    PG8_STAGE(PG8_SB(1, 0), cB + kstep, voffB); PG8_STAGE(PG8_SA(1, 0), cA + kstep, voffA); PG8_STAGE(PG8_SB(1, 1), cB + hstepB + kstep, voffB);
    PG8_WAIT_V(6); PG8_BAR;
    for (;;) {
        const bool has_next = S.next(ui + 1, nxt);
        const char* nA = has_next ? PG8_ABASE(nxt) : cA; const char* nB = has_next ? (const char*)g.Bt + (long)nxt.pn * tstepB : cB;
        for (int t = 0; t < nt; t += 2) {
            const bool last = (t == nt - 2);
            const char* a1 = PG8_APTR(cA, t + 1);
            const char* a2 = last ? nA : PG8_APTR(cA, t + 2); const char* b2 = last ? nB : cB + (long)(t + 2) * kstep;
            const char* a3 = a2 + kstep; const char* b3 = b2 + kstep;
            PG8_LDB(B0, 0, 0); PG8_LDB(B1, 0, 1); PG8_SCHED; PG8_LDA(At, 0, 0); PG8_STAGE(PG8_SA(1, 1), a1 + hstepA, voffA);
            PG8_WAIT_V(8); PG8_WAIT_L(0); PG8_BAR; PG8_MMA(0, 0, At, B0); PG8_MMA(0, 1, At, B1); PG8_BAR; PG8_SCHED;
            PG8_LDA(At, 0, 1); PG8_STAGE(PG8_SB(0, 0), b2, voffB); PG8_STAGE(PG8_SB(0, 1), b2 + hstepB, voffB); PG8_STAGE(PG8_SA(0, 0), a2, voffA);
            PG8_WAIT_V(8); PG8_WAIT_L(0); PG8_BAR; PG8_MMA(1, 0, At, B0); PG8_MMA(1, 1, At, B1); PG8_BAR; PG8_SCHED;
            PG8_LDB(B0, 1, 0); PG8_LDB(B1, 1, 1); PG8_SCHED; PG8_LDA(At, 1, 0); PG8_STAGE(PG8_SA(0, 1), a2 + hstepA, voffA);
            PG8_WAIT_V(8); PG8_WAIT_L(0); PG8_BAR; PG8_MMA(0, 0, At, B0); PG8_MMA(0, 1, At, B1); PG8_BAR; PG8_SCHED;
            PG8_LDA(At, 1, 1); PG8_STAGE(PG8_SB(1, 0), b3, voffB); PG8_STAGE(PG8_SB(1, 1), b3 + hstepB, voffB); PG8_STAGE(PG8_SA(1, 0), a3, voffA);
            PG8_WAIT_V(8); PG8_WAIT_L(0); PG8_BAR; PG8_MMA(1, 0, At, B0); PG8_MMA(1, 1, At, B1); PG8_BAR; PG8_SCHED;
        }
        if (wr == 0) PG8_BAR;
        E(acc, cur, wr, wc, fr, fq);
        if (!has_next) break;
#pragma unroll
        for (int a = 0; a < 2; ++a)
#pragma unroll
            for (int b = 0; b < 2; ++b)
#pragma unroll
                for (int m = 0; m < 4; ++m)
#pragma unroll
                    for (int n = 0; n < 2; ++n) acc[a][b][m][n] = (f32x4){0.f, 0.f, 0.f, 0.f};
        cur = nxt; cA = nA; cB = nB; ++ui;
        if (wr == 1) PG8_BAR;
    }
    PG8_WAIT_V(0);
    PG8_BAR;
#undef PG8_ABASE
#undef PG8_APTR
#undef PG8_SA
#undef PG8_SB
#undef PG8_STAGE
#undef PG8_LDA
#undef PG8_LDB
#undef PG8_MMA
#undef PG8_WAIT_V
#undef PG8_WAIT_L
#undef PG8_BAR
#undef PG8_SCHED
}
}

constexpr size_t MiB = 1u << 20;
constexpr size_t WS_MOD = 1 * MiB;
constexpr size_t WS_WIN0 = 2 * MiB;
constexpr size_t WS_WOUT0 = 6 * MiB;
constexpr size_t WS_W1 = 8 * MiB;
constexpr size_t WS_W2 = 24 * MiB;
constexpr size_t WS_WRKV = 40 * MiB;
constexpr size_t WS_WL1 = 46 * MiB;
constexpr size_t WS_WL2 = 48 * MiB;
constexpr size_t WS_WOUT1 = 51 * MiB;
constexpr size_t WS_WS = 53 * MiB;
constexpr size_t WS_H = 60 * MiB;
constexpr size_t WS_UV = 188 * MiB;
constexpr size_t WS_Z = 444 * MiB;
constexpr size_t WS_HID = 188 * MiB;
constexpr size_t WS_X3 = 54 * MiB;
constexpr size_t WS_H2 = 438 * MiB;
constexpr size_t WS_L = 952 * MiB;
constexpr size_t WS_R = 567 * MiB, WS_K = 695 * MiB, WS_V = 823 * MiB;
constexpr size_t WS_WE = 60 * MiB, WS_A = 188 * MiB, WS_G = 316 * MiB;
constexpr size_t WS_YG = 54 * MiB;
constexpr size_t WS_END = 1020 * MiB;
constexpr int LDS_BYTES = 147456;

struct Args {
    const float* in[29];
    float* out; unsigned char* ws;
    int lo, hi;
};

__device__ __forceinline__ float wave_sum(float v) {
#pragma unroll
    for (int o = 1; o < 64; o <<= 1) v += __shfl_xor(v, o);
    return v;
}
template <int CTRL> __device__ __forceinline__ float dppf(float v) { return __builtin_bit_cast(float, __builtin_amdgcn_update_dpp(0, __builtin_bit_cast(int, v), CTRL, 0xF, 0xF, true)); }
__device__ __forceinline__ float reduce16(float v) {
    v += dppf<0xB1>(v); v += dppf<0x4E>(v); v += dppf<0x141>(v); v += dppf<0x140>(v); return v;
}

#define XB_TMO      128
#define XB_XCNT(j)  (256  + 64 * (j))
#define XB_XSUB(j)  (1280 + 64 * (j))
#define XB_XGEN(j)  (2304 + 64 * (j))
#define XB_TOP      3328
#define XB_TOPGEN   3392
#define XCD_BAR_WORDS 3456
#define XB_SPIN_CAP (1u << 18)

__device__ __forceinline__ unsigned xb_ld(unsigned* p)              { return __hip_atomic_load(p, __ATOMIC_RELAXED, __HIP_MEMORY_SCOPE_AGENT); }
__device__ __forceinline__ unsigned xb_add(unsigned* p, unsigned v) { return __hip_atomic_fetch_add(p, v, __ATOMIC_RELAXED, __HIP_MEMORY_SCOPE_AGENT); }
__device__ __forceinline__ unsigned xb_xcc_id() { return (unsigned)__builtin_amdgcn_s_getreg((3 << 11) | 20) & 0xFu; }
#define XB_SPIN(cond, bar) do { unsigned _sp = 0; while (cond) { __builtin_amdgcn_s_sleep(1); \
    if ((++_sp & 255u) == 0u) { if (xb_ld(&(bar)[XB_TMO])) break; if (_sp > XB_SPIN_CAP) { atomicAdd(&(bar)[XB_TMO], 1u); break; } } } } while (0)

struct XcdBarrier {
    unsigned* bar; unsigned x;
    volatile LAS unsigned* st;
};

__device__ __forceinline__ XcdBarrier xcd_barrier_post(unsigned* bar, volatile LAS unsigned* st) {
    XcdBarrier b; b.bar = bar; b.x = xb_xcc_id(); b.st = st;
    if (threadIdx.x == 0) (void)xb_add(&bar[XB_XCNT(b.x)], 1u);
    return b;
}
__device__ __forceinline__ void xcd_barrier_complete(unsigned* bar, unsigned x, unsigned& nloc, unsigned& nx) {
    const unsigned G = gridDim.x * gridDim.y * gridDim.z;
    unsigned sum, cnt, mine, sp = 0u;
    for (;;) {
        sum = 0u; cnt = 0u; mine = 0u;
#pragma unroll
        for (unsigned j = 0; j < 16; ++j) { const unsigned c = xb_ld(&bar[XB_XCNT(j)]); sum += c; cnt += (c > 0u) ? 1u : 0u; mine = (j == x) ? c : mine; }
        if (sum == G) break;
        __builtin_amdgcn_s_sleep(1);
        if ((++sp & 255u) == 0u) { if (xb_ld(&bar[XB_TMO])) break; if (sp > XB_SPIN_CAP) { atomicAdd(&bar[XB_TMO], 1u); break; } }
    }
    nloc = mine > 0u ? mine : 1u; nx = cnt > 0u ? cnt : 1u;
}

__device__ __forceinline__ void xcd_barrier(const XcdBarrier& b) {
    asm volatile("s_waitcnt vmcnt(0)" ::: "memory");
    __syncthreads();
    if (threadIdx.x == 0) {
        unsigned* bar = b.bar;
        __builtin_amdgcn_s_waitcnt(0);
        unsigned nloc = b.st[0], nx = b.st[1];
        if (nloc == 0u) { xcd_barrier_complete(bar, b.x, nloc, nx); b.st[0] = nloc; b.st[1] = nx; }
        const unsigned old = xb_add(&bar[XB_XSUB(b.x)], 1u);
        const unsigned gen = old / nloc;
        if (old + 1u == (gen + 1u) * nloc) {
            __builtin_amdgcn_fence(__ATOMIC_RELEASE, "agent");
            asm volatile("s_waitcnt vmcnt(0)" ::: "memory");
            const unsigned og = xb_add(&bar[XB_TOP], 1u);
            const unsigned tg = og / nx;
            if (og + 1u == (tg + 1u) * nx) xb_add(&bar[XB_TOPGEN], 1u);
            else XB_SPIN(xb_ld(&bar[XB_TOPGEN]) == tg, bar);
            __builtin_amdgcn_fence(__ATOMIC_ACQUIRE, "agent");
            xb_add(&bar[XB_XGEN(b.x)], 1u);
            asm volatile("s_waitcnt vmcnt(0)" ::: "memory");
        } else {
            XB_SPIN(xb_ld(&bar[XB_XGEN(b.x)]) == gen, bar);
            __builtin_amdgcn_fence(__ATOMIC_ACQUIRE, "agent");
            asm volatile("s_waitcnt vmcnt(0)" ::: "memory");
        }
    }
    __syncthreads();
}


__device__ __forceinline__ void gsync(cg::grid_group& grid) {
    asm volatile("s_waitcnt vmcnt(0) lgkmcnt(0)" ::: "memory");
    grid.sync();
    if (threadIdx.x < 64) { __builtin_amdgcn_fence(__ATOMIC_ACQUIRE, "agent"); asm volatile("s_waitcnt vmcnt(0)" ::: "memory"); }
    __syncthreads();
}
__device__ __forceinline__ void transpose_item(const float* W, int lds_, int Ksrc, int Nsrc, bf16_t* WT, int ldd, int row_off, int col_off,
                                               const float* mu, int mode, LAS float* scr, int kb, int nb, int lane) {
    const int k0 = 64 * kb, n0 = 32 * nb;
#pragma unroll 8
    for (int i = 0; i < 32; ++i) { const int kk = 2 * i + (lane >> 5), nn = lane & 31, k = k0 + kk, n = n0 + nn;
        float v = (k < Ksrc && n < Nsrc) ? W[(size_t)k * lds_ + n] : 0.f;
        if (mode) { const float m = mu[k & 1023]; v *= (mode == 1) ? (1.f - m) : m; }
        scr[kk * 33 + nn] = v; }
    asm volatile("s_waitcnt lgkmcnt(0)" ::: "memory");
    const int c = lane & 7;
#pragma unroll
    for (int j = 0; j < 4; ++j) { const int n = (lane >> 3) + 8 * j; const LAS float* s = scr + (8 * c) * 33 + n;
        u32x4 o; o.x = cvt_pk_bf16(s[0 * 33], s[1 * 33]); o.y = cvt_pk_bf16(s[2 * 33], s[3 * 33]); o.z = cvt_pk_bf16(s[4 * 33], s[5 * 33]); o.w = cvt_pk_bf16(s[6 * 33], s[7 * 33]);
        *(u32x4*)(WT + (size_t)(row_off + n0 + n) * ldd + col_off + k0 + 8 * c) = o; }
    asm volatile("s_waitcnt lgkmcnt(0)" ::: "memory");
}

__device__ __forceinline__ void phase_prep(const Args& a, LAS unsigned char* lds) {
    const int tid = opaque_tid(), lane = tid & 63, wave = tid >> 6;
    unsigned char* ws = a.ws;
    {
        LAS float* sc = (LAS float*)lds;
        LAS float* red = (LAS float*)(lds + 65536);
        bool have = false;
        for (int it = blockIdx.x; it < 2 * 96; it += gridDim.x) {
            if (!have) { const float* c = a.in[1];
                for (int e = tid; e < 16 * 1024; e += NTHREADS) { const int b = e >> 10, k = e & 1023; const float x = c[e]; sc[k * 16 + b] = x / (1.f + __expf(-x)); }
                have = true; }
            __syncthreads();
            const int l = it / 96, n0 = (it % 96) * 64;
            const float* w = a.in[2] + (size_t)l * 1024 * 6144 + n0 + lane;
            float acc[16];
#pragma unroll
            for (int b = 0; b < 16; ++b) acc[b] = 0.f;
            const int kbeg = wave * 128;
#pragma unroll 8
            for (int k = kbeg; k < kbeg + 128; ++k) { const float wv = w[(size_t)k * 6144];
                const LAS f32x4* s4 = (const LAS f32x4*)(sc + k * 16);
#pragma unroll
                for (int q = 0; q < 4; ++q) { const f32x4 s = s4[q]; acc[4 * q] += s[0] * wv; acc[4 * q + 1] += s[1] * wv; acc[4 * q + 2] += s[2] * wv; acc[4 * q + 3] += s[3] * wv; } }
#pragma unroll
            for (int b = 0; b < 16; ++b) red[(wave * 16 + b) * 64 + lane] = acc[b];
            __syncthreads();
            float* mod = (float*)(ws + WS_MOD);
            for (int e = tid; e < 1024; e += NTHREADS) { const int b = e >> 6, n = e & 63; float s = 0.f;
#pragma unroll
                for (int wv = 0; wv < 8; ++wv) s += red[(wv * 16 + b) * 64 + n];
                mod[((size_t)l * 16 + b) * 6144 + n0 + n] = s + a.in[3][l * 6144 + n0 + n]; }
            __syncthreads();
        }
        __syncthreads();
    }
}
__device__ __forceinline__ void phase_weights(const Args& a, LAS unsigned char* lds) {
    const int tid = opaque_tid(), lane = tid & 63, wave = tid >> 6;
    unsigned char* ws = a.ws;
    {
        LAS float* scr = (LAS float*)(lds + wave * 16384);
        const int gw = blockIdx.x * NWAVES + wave, NGW = gridDim.x * NWAVES;
        const float* mu = a.in[12];
        constexpr int TOTAL = 16 * 64 + 16 * 32 + 2 * 16 * 128 + 2 * 64 * 32 + 3 * 16 * 32 + 2 * (16 * 4 + 16 * 4 + 16 * 8) + 24 * 32 + 16 * 32;
        for (int it = gw; it < TOTAL; it += NGW) {
            int r = it;
#define JOB(W, LDSRC, KS, NS, DST, LDD, RO, CO, MU, MODE, KB, NBK) if (r >= 0) { if (r < (KB) * (NBK)) { transpose_item((W), (LDSRC), (KS), (NS), (bf16_t*)(ws + (DST)), (LDD), (RO), (CO), (MU), (MODE), scr, r / (NBK), r % (NBK), lane); r = -1; } else r -= (KB) * (NBK); }
            JOB(a.in[6], 2048, 1024, 2048, WS_WIN0, 1024, 0, 0, mu, 0, 16, 64)
            JOB(a.in[11], 1024, 1024, 1024, WS_WOUT0, 1024, 0, 0, mu, 0, 16, 32)
            JOB(a.in[4], 4096, 1024, 4096, WS_W1, 1024, 0, 0, mu, 0, 16, 128)
            JOB(a.in[4] + (size_t)1024 * 4096, 4096, 1024, 4096, WS_W1 + (size_t)4096 * 1024 * 2, 1024, 0, 0, mu, 0, 16, 128)
            JOB(a.in[5], 1024, 4096, 1024, WS_W2, 4096, 0, 0, mu, 0, 64, 32)
            JOB(a.in[5] + (size_t)4096 * 1024, 1024, 4096, 1024, WS_W2 + (size_t)1024 * 4096 * 2, 4096, 0, 0, mu, 0, 64, 32)
            JOB(a.in[13] + 0, 3072, 1024, 1024, WS_WRKV, 1024, 0, 0, mu, 0, 16, 32)
            JOB(a.in[13] + 1024, 3072, 1024, 1024, WS_WRKV, 1024, 1024, 0, mu, 0, 16, 32)
            JOB(a.in[13] + 2048, 3072, 1024, 1024, WS_WRKV, 1024, 2048, 0, mu, 0, 16, 32)
            JOB(a.in[15], 64, 1024, 64, WS_WL1, 2048, 0, 0, mu + 1 * 1024, 1, 16, 4)
            JOB(a.in[15], 64, 1024, 64, WS_WL1, 2048, 0, 1024, mu + 1 * 1024, 2, 16, 4)
            JOB(a.in[18], 64, 1024, 64, WS_WL1, 2048, 128, 0, mu + 4 * 1024, 1, 16, 4)
            JOB(a.in[18], 64, 1024, 64, WS_WL1, 2048, 128, 1024, mu + 4 * 1024, 2, 16, 4)
            JOB(a.in[20], 160, 1024, 160, WS_WL1, 2048, 256, 0, mu + 5 * 1024, 1, 16, 8)
            JOB(a.in[20], 160, 1024, 160, WS_WL1, 2048, 256, 1024, mu + 5 * 1024, 2, 16, 8)
            JOB(a.in[16], 1024, 64, 1024, WS_WL2, 512, 0, 0, mu, 0, 2, 32)
            JOB(a.in[16], 1024, 0, 1024, WS_WL2, 512, 0, 128, mu, 0, 6, 32)
            JOB(a.in[19], 1024, 0, 1024, WS_WL2, 512, 1024, 0, mu, 0, 2, 32)
            JOB(a.in[19], 1024, 64, 1024, WS_WL2, 512, 1024, 128, mu, 0, 2, 32)
            JOB(a.in[19], 1024, 0, 1024, WS_WL2, 512, 1024, 256, mu, 0, 4, 32)
            JOB(a.in[21], 1024, 0, 1024, WS_WL2, 512, 2048, 0, mu, 0, 4, 32)
            JOB(a.in[21], 1024, 160, 1024, WS_WL2, 512, 2048, 256, mu, 0, 4, 32)
            JOB(a.in[27], 1024, 1024, 1024, WS_WOUT1, 1024, 0, 0, mu, 0, 16, 32)
#undef JOB
        }
        bf16_t* wsb = (bf16_t*)(ws + WS_WS);
        for (int e = blockIdx.x * NTHREADS + tid; e < 8 * 128 * 128 / 2; e += gridDim.x * NTHREADS) {
            const int i = e * 2, s = i & 127, t = (i >> 7) & 127;
            const float v0 = (s <= t) ? a.in[9][i] : 0.f, v1 = (s + 1 <= t) ? a.in[9][i + 1] : 0.f;
            ((unsigned*)wsb)[e] = cvt_pk_bf16(v0, v1);
        }
    }
}

__device__ __forceinline__ void phase_norm_mod(const float* x, const float* mod_shift, const float* mod_scale, bf16_t* H, int) {
    const int tid = opaque_tid(), lane = tid & 63, wave = tid >> 6;
    const int gw = blockIdx.x * NWAVES + wave, NGW = gridDim.x * NWAVES;
    constexpr int NR = 4;
    for (int m0 = gw; m0 < M; m0 += NR * NGW) {
        f32x4 v[NR][4];
#pragma unroll
        for (int r = 0; r < NR; ++r) { const int m = M - 1 - (m0 + r * NGW < M ? m0 + r * NGW : m0); const f32x4* xr = (const f32x4*)(x + (size_t)m * D) + lane;
#pragma unroll
            for (int j = 0; j < 4; ++j) v[r][j] = xr[64 * j]; }
#pragma unroll
        for (int r = 0; r < NR; ++r) { const int m = M - 1 - (m0 + r * NGW); if (m >= 0) {
            const int b = m >> 12; float s = 0.f;
#pragma unroll
            for (int j = 0; j < 4; ++j) s += (v[r][j].x * v[r][j].x + v[r][j].y * v[r][j].y) + (v[r][j].z * v[r][j].z + v[r][j].w * v[r][j].w);
            const float rstd = 1.0f / sqrtf(wave_sum(s) * (1.f / D) + 1e-6f);
            const f32x4* sh = (const f32x4*)(mod_shift + (size_t)b * 6144) + lane;
            const f32x4* sc = (const f32x4*)(mod_scale + (size_t)b * 6144) + lane;
            u32x2* o = (u32x2*)(H + (size_t)m * D) + lane;
#pragma unroll
            for (int j = 0; j < 4; ++j) { const f32x4 a = sh[64 * j], c = sc[64 * j]; const f32x4 h = v[r][j] * rstd * (c + 1.0f) + a;
                u32x2 w; w.x = cvt_pk_bf16(h.x, h.y); w.y = cvt_pk_bf16(h.z, h.w); o[64 * j] = w; } } }
    }
}
__device__ __forceinline__ void phase_final_norm(float* x, const float* g) {
    const int tid = opaque_tid(), lane = tid & 63, wave = tid >> 6;
    const int gw = blockIdx.x * NWAVES + wave, NGW = gridDim.x * NWAVES;
    constexpr int NR = 4;
    f32x4 gg[4];
#pragma unroll
    for (int j = 0; j < 4; ++j) gg[j] = ((const f32x4*)g)[lane + 64 * j];
    for (int m0 = gw; m0 < M; m0 += NR * NGW) {
        f32x4 v[NR][4];
#pragma unroll
        for (int r = 0; r < NR; ++r) { const int m = (m0 + r * NGW < M ? m0 + r * NGW : m0); const f32x4* xr = (const f32x4*)(x + (size_t)m * D) + lane;
#pragma unroll
            for (int j = 0; j < 4; ++j) v[r][j] = xr[64 * j]; }
#pragma unroll
        for (int r = 0; r < NR; ++r) { const int m = m0 + r * NGW; if (m < M) {
            float s = 0.f;
#pragma unroll
            for (int j = 0; j < 4; ++j) s += (v[r][j].x * v[r][j].x + v[r][j].y * v[r][j].y) + (v[r][j].z * v[r][j].z + v[r][j].w * v[r][j].w);
            const float rstd = 1.0f / sqrtf(wave_sum(s) * (1.f / D) + 1e-6f);
            f32x4* xr = (f32x4*)(x + (size_t)m * D) + lane;
#pragma unroll
            for (int j = 0; j < 4; ++j) xr[64 * j] = v[r][j] * rstd * gg[j]; } }
    }
}
__device__ __forceinline__ void load_row(const float* x, size_t m, int lane, f32x4 (&v)[4]) {
    const f32x4* xr = (const f32x4*)(x + m * D) + lane;
#pragma unroll
    for (int j = 0; j < 4; ++j) v[j] = xr[64 * j];
}
__device__ __forceinline__ void finish_row(f32x4 (&h)[4], const f32x4 (&sh)[4], const f32x4 (&sc1)[4]) {
    float s = 0.f;
#pragma unroll
    for (int j = 0; j < 4; ++j) s += (h[j].x * h[j].x + h[j].y * h[j].y) + (h[j].z * h[j].z + h[j].w * h[j].w);
    const float rstd = 1.0f / sqrtf(wave_sum(s) * (1.f / D) + 1e-6f);
#pragma unroll
    for (int j = 0; j < 4; ++j) h[j] = h[j] * rstd * sc1[j] + sh[j];
}
__device__ __forceinline__ void phase_norm_shift(const float* x, const float* mod_shift, const float* mod_scale, const float* mu, bf16_t* X3, bf16_t* H2) {
    const int tid = opaque_tid(), lane = tid & 63, wave = tid >> 6;
    const int gw = blockIdx.x * NWAVES + wave, NGW = gridDim.x * NWAVES;
    f32x4 mr[4], mk[4], mv[4];
#pragma unroll
    for (int j = 0; j < 4; ++j) { mr[j] = ((const f32x4*)(mu + 0 * 1024))[lane + 64 * j]; mk[j] = ((const f32x4*)(mu + 2 * 1024))[lane + 64 * j]; mv[j] = ((const f32x4*)(mu + 3 * 1024))[lane + 64 * j]; }
    for (int blk = gw; blk < M / 32; blk += NGW) {
        const size_t m0 = (size_t)blk * 32; const int b = (int)(m0 >> 12);
        f32x4 sh[4], sc1[4];
#pragma unroll
        for (int j = 0; j < 4; ++j) { sh[j] = ((const f32x4*)(mod_shift + (size_t)b * 6144))[lane + 64 * j]; sc1[j] = ((const f32x4*)(mod_scale + (size_t)b * 6144))[lane + 64 * j] + 1.0f; }
        f32x4 hp[4], h[4], n1[4], n2[4];
        const bool first = (m0 & 4095) == 0;
        load_row(x, first ? m0 : m0 - 1, lane, hp); load_row(x, m0, lane, h); load_row(x, m0 + 1, lane, n1);
        finish_row(hp, sh, sc1);
        if (first) {
#pragma unroll
            for (int j = 0; j < 4; ++j) hp[j] = (f32x4){0.f, 0.f, 0.f, 0.f}; }
        for (int i = 0; i < 32; ++i) {
            const size_t m = m0 + i;
            load_row(x, (i + 2 < 32) ? m + 2 : m, lane, n2);
            finish_row(h, sh, sc1);
            u32x2* o2 = (u32x2*)(H2 + (m + b + 1) * D) + lane;
            u32x2* or_ = (u32x2*)(X3 + m * D) + lane;
#pragma unroll
            for (int j = 0; j < 4; ++j) {
                const f32x4 d = hp[j] - h[j];
                const f32x4 xr = h[j] + d * mr[j], xk = h[j] + d * mk[j], xv = h[j] + d * mv[j];
                u32x2 w; w.x = cvt_pk_bf16(h[j].x, h[j].y); w.y = cvt_pk_bf16(h[j].z, h[j].w); o2[64 * j] = w;
                if (first && i == 0) o2[64 * j - D / 4] = (u32x2){0u, 0u};
                w.x = cvt_pk_bf16(xr.x, xr.y); w.y = cvt_pk_bf16(xr.z, xr.w); or_[64 * j] = w;
                w.x = cvt_pk_bf16(xk.x, xk.y); w.y = cvt_pk_bf16(xk.z, xk.w); or_[64 * j + (size_t)M * D / 4] = w;
                w.x = cvt_pk_bf16(xv.x, xv.y); w.y = cvt_pk_bf16(xv.z, xv.w); or_[64 * j + 2 * (size_t)M * D / 4] = w;
                hp[j] = h[j]; h[j] = n1[j]; n1[j] = n2[j];
            }
        }
    }
}

__device__ __forceinline__ void phase_sgu(const Args& a, LAS unsigned char* lds) {
    const int tid = opaque_tid(), lane = tid & 63, wave = tid >> 6, fr = lane & 15, fq = lane >> 4;
    const bf16_t* UV = (const bf16_t*)(a.ws + WS_UV); bf16_t* Z = (bf16_t*)(a.ws + WS_Z);
    const bf16_t* WSB = (const bf16_t*)(a.ws + WS_WS);
    const float* lng = a.in[7]; const float* lnb = a.in[8]; const float* bs = a.in[10];
    constexpr int RS = 272;
    LAS unsigned char* Wl = lds;
    LAS unsigned char* Vl = lds + 128 * RS;
    LAS f32x2* st = (LAS f32x2*)(lds + 2 * 128 * RS);
    const int wt = wave >> 2, wd = wave & 3;
    for (int tile_ = blockIdx.x; tile_ < M / 128; tile_ += gridDim.x) {
        const int tile = M / 128 - 1 - tile_;
        const size_t m0 = (size_t)tile * 128;
        for (int r = wave * 16; r < wave * 16 + 16; ++r) {
            const u32x4* p = (const u32x4*)(UV + (m0 + r) * 2048 + 1024) + lane;
            const u32x4 q0 = p[0], q1 = p[64];
            float f[16];
            f[0] = bf_lo(q0.x); f[1] = bf_hi(q0.x); f[2] = bf_lo(q0.y); f[3] = bf_hi(q0.y); f[4] = bf_lo(q0.z); f[5] = bf_hi(q0.z); f[6] = bf_lo(q0.w); f[7] = bf_hi(q0.w);
            f[8] = bf_lo(q1.x); f[9] = bf_hi(q1.x); f[10] = bf_lo(q1.y); f[11] = bf_hi(q1.y); f[12] = bf_lo(q1.z); f[13] = bf_hi(q1.z); f[14] = bf_lo(q1.w); f[15] = bf_hi(q1.w);
            float s = 0.f;
#pragma unroll
            for (int e = 0; e < 16; ++e) s += f[e];
            const float mean = wave_sum(s) * (1.f / 1024.f);
            float q = 0.f;
#pragma unroll
            for (int e = 0; e < 16; ++e) { const float d = f[e] - mean; q += d * d; }
            const float var = wave_sum(q) * (1.f / 1024.f);
            if (lane == 0) st[r] = (f32x2){mean, 1.0f / sqrtf(var + 1e-5f)};
        }
        __syncthreads();
        for (int g = 0; g < 8; ++g) {
            {
                const u32x4* src = (const u32x4*)(WSB + (size_t)g * 128 * 128);
#pragma unroll
                for (int i = 0; i < 4; ++i) { const int idx = tid + i * NTHREADS; const int t = idx >> 4, c = idx & 15;
                    *(LAS u32x4*)(Wl + t * RS + c * 16) = src[idx]; }
            }
            {
                const int sp = tid & 63, dq = tid >> 6, s0 = 2 * sp, d0 = dq * 16;
                const f32x2 st0 = st[s0], st1 = st[s0 + 1];
                const bf16_t* p0 = UV + (m0 + s0) * 2048 + 1024 + g * 128 + d0;
                const u32x4 a0 = *(const u32x4*)p0, a1 = *(const u32x4*)(p0 + 8), b0 = *(const u32x4*)(p0 + 2048), b1 = *(const u32x4*)(p0 + 2048 + 8);
                const unsigned ua[8] = {a0.x, a0.y, a0.z, a0.w, a1.x, a1.y, a1.z, a1.w}, ub[8] = {b0.x, b0.y, b0.z, b0.w, b1.x, b1.y, b1.z, b1.w};
                const float* gp = lng + g * 128 + d0; const float* bp = lnb + g * 128 + d0;
#pragma unroll
                for (int e = 0; e < 8; ++e) {
                    const float g0 = gp[2 * e], g1 = gp[2 * e + 1], c0 = bp[2 * e], c1 = bp[2 * e + 1];
                    const float x00 = (bf_lo(ua[e]) - st0.x) * st0.y * g0 + c0, x01 = (bf_hi(ua[e]) - st0.x) * st0.y * g1 + c1;
                    const float x10 = (bf_lo(ub[e]) - st1.x) * st1.y * g0 + c0, x11 = (bf_hi(ub[e]) - st1.x) * st1.y * g1 + c1;
                    *(LAS unsigned*)(Vl + (d0 + 2 * e) * RS + s0 * 2) = cvt_pk_bf16(x00, x10);
                    *(LAS unsigned*)(Vl + (d0 + 2 * e + 1) * RS + s0 * 2) = cvt_pk_bf16(x01, x11);
                }
            }
            __syncthreads();
            f32x4 acc[4][2];
#pragma unroll
            for (int mi = 0; mi < 4; ++mi)
#pragma unroll
                for (int ni = 0; ni < 2; ++ni) acc[mi][ni] = (f32x4){0.f, 0.f, 0.f, 0.f};
#pragma unroll
            for (int ks = 0; ks < 4; ++ks) {
                if (ks * 32 <= 64 * wt + 63) {
                    bf16x8 bfr[2];
#pragma unroll
                    for (int ni = 0; ni < 2; ++ni) bfr[ni] = *(const LAS bf16x8*)(Vl + (32 * wd + 16 * ni + fr) * RS + (ks * 32 + fq * 8) * 2);
#pragma unroll
                    for (int mi = 0; mi < 4; ++mi) {
                        if (ks * 32 <= 64 * wt + 16 * mi + 15) {
                            const bf16x8 afr = *(const LAS bf16x8*)(Wl + (64 * wt + 16 * mi + fr) * RS + (ks * 32 + fq * 8) * 2);
#pragma unroll
                            for (int ni = 0; ni < 2; ++ni) acc[mi][ni] = __builtin_amdgcn_mfma_f32_16x16x32_bf16(bfr[ni], afr, acc[mi][ni], 0, 0, 0);
                        }
                    }
                }
            }
#pragma unroll
            for (int mi = 0; mi < 4; ++mi) {
                const int t = 64 * wt + 16 * mi + fr; const float bias = bs[g * 128 + t];
#pragma unroll
                for (int ni = 0; ni < 2; ++ni) {
                    const int col = g * 128 + 32 * wd + 16 * ni + 4 * fq;
                    const u32x2 uu = *(const u32x2*)(UV + (m0 + t) * 2048 + col);
                    const f32x4 sv = acc[mi][ni];
                    u32x2 o; o.x = cvt_pk_bf16(bf_lo(uu.x) * (sv[0] + bias), bf_hi(uu.x) * (sv[1] + bias)); o.y = cvt_pk_bf16(bf_lo(uu.y) * (sv[2] + bias), bf_hi(uu.y) * (sv[3] + bias));
                    *(u32x2*)(Z + (m0 + t) * 1024 + col) = o;
                }
            }
            __syncthreads();
        }
    }
}

__device__ __forceinline__ float fma_(float a, float b, float c) { float d; asm("v_fma_f32 %0, %1, %2, %3" : "=v"(d) : "v"(a), "v"(b), "v"(c)); return d; }
__device__ __forceinline__ float mul_(float a, float b) { float d; asm("v_mul_f32 %0, %1, %2" : "=v"(d) : "v"(a), "v"(b)); return d; }
__device__ __forceinline__ float dot4_(const f32x4& s, const f32x4& o) { return fma_(s.w, o.w, fma_(s.z, o.z, fma_(s.y, o.y, mul_(s.x, o.x)))); }
__device__ __forceinline__ void upd4_(f32x4& s, const f32x4& w, const f32x4& b, const f32x4& k, float sa, float v) {
    s.x = fma_(v, k.x, fma_(sa, b.x, mul_(s.x, w.x))); s.y = fma_(v, k.y, fma_(sa, b.y, mul_(s.y, w.y)));
    s.z = fma_(v, k.z, fma_(sa, b.z, mul_(s.z, w.z))); s.w = fma_(v, k.w, fma_(sa, b.w, mul_(s.w, w.w)));
}
__device__ __forceinline__ f32x2 pkmul_(f32x2 a, f32x2 b) { f32x2 d; asm("v_pk_mul_f32 %0, %1, %2" : "=v"(d) : "v"(a), "v"(b)); return d; }
__device__ __forceinline__ f32x2 pkfma_(f32x2 a, f32x2 b, f32x2 c) { f32x2 d; asm("v_pk_fma_f32 %0, %1, %2, %3" : "=v"(d) : "v"(a), "v"(b), "v"(c)); return d; }
__device__ __forceinline__ f32x2 pkfma_lo_(f32x2 a, f32x2 b, f32x2 c) { f32x2 d; asm("v_pk_fma_f32 %0, %1, %2, %3 op_sel_hi:[0,1,1]" : "=v"(d) : "v"(a), "v"(b), "v"(c)); return d; }
__device__ __forceinline__ f32x2 pkfma_hi_(f32x2 a, f32x2 b, f32x2 c) { f32x2 d; asm("v_pk_fma_f32 %0, %1, %2, %3 op_sel:[1,0,0]" : "=v"(d) : "v"(a), "v"(b), "v"(c)); return d; }
__device__ __forceinline__ float add_(float a, float b) { float d; asm("v_add_f32 %0, %1, %2" : "=v"(d) : "v"(a), "v"(b)); return d; }
#define LO2(v) __builtin_shufflevector(v, v, 0, 1)
#define HI2(v) __builtin_shufflevector(v, v, 2, 3)
__device__ __forceinline__ void phase_scan(const Args& a, LAS unsigned char* lds) {
    const int tid = opaque_tid(), lane = tid & 63, wave = tid >> 6;
    constexpr int TC = 32;
    LAS float* op = (LAS float*)lds;
    LAS float* vb = (LAS float*)(lds + (TC + 1) * 1280);
    LAS float* yb = (LAS float*)(lds + (TC + 1) * 1280 + (TC + 1) * 256);
    const bf16_t* Rg = (const bf16_t*)(a.ws + WS_R); const bf16_t* Kg = (const bf16_t*)(a.ws + WS_K); const bf16_t* Vg = (const bf16_t*)(a.ws + WS_V);
    const bf16_t* Lg = (const bf16_t*)(a.ws + WS_L); const bf16_t* WL2 = (const bf16_t*)(a.ws + WS_WL2);
    constexpr int XS = 68;
    LAS float* xb = (LAS float*)(lds + (TC + 1) * 1280 + (TC + 1) * 256 + TC * 1024);
    const int fr = lane & 15, fq = lane >> 4, stile = wave >> 2, ntile = wave & 3;
    bf16_t* YG = (bf16_t*)(a.ws + WS_YG);
    const int ts = tid >> 4, jg = tid & 15;
    const int ig = lane >> 4;
    const int r0 = wave * 8 + ig * 2;
    for (int hd = blockIdx.x; hd < NB * 16; hd += gridDim.x) {
        const int b = hd >> 4, h = hd & 15;
        const int ch = h * 64 + jg * 4;
        const f32x4 kk4 = *(const f32x4*)(a.in[22] + ch), ka4 = *(const f32x4*)(a.in[23] + ch), rk4 = *(const f32x4*)(a.in[24] + ch);
        const f32x4 lg4 = *(const f32x4*)(a.in[25] + ch), lb4 = *(const f32x4*)(a.in[26] + ch);
        const size_t base = ((size_t)b * T) * D + ch;
        f32x2 S0a = {0.f, 0.f}, S0b = {0.f, 0.f}, S1a = {0.f, 0.f}, S1b = {0.f, 0.f};
        size_t off = base + (size_t)ts * D;
        u32x2 pr = *(const u32x2*)(Rg + off), pk = *(const u32x2*)(Kg + off), pv = *(const u32x2*)(Vg + off);
        const int chn = h * 64 + ntile * 16 + fr;
        bf16x8 bw[2], ba[2], bg[5];
#pragma unroll
        for (int ks = 0; ks < 2; ++ks) { bw[ks] = *(const bf16x8*)(WL2 + (size_t)chn * 512 + ks * 32 + fq * 8); ba[ks] = *(const bf16x8*)(WL2 + (size_t)(1024 + chn) * 512 + 128 + ks * 32 + fq * 8); }
#pragma unroll
        for (int ks = 0; ks < 5; ++ks) bg[ks] = *(const bf16x8*)(WL2 + (size_t)(2048 + chn) * 512 + 256 + ks * 32 + fq * 8);
        const float w0c = a.in[14][chn], a0c = a.in[17][chn];
        bf16x8 aw[2], aa[2], ag[5];
#define LORA_LOAD(cc) do { const bf16_t* lrow = Lg + ((size_t)b * T + (size_t)(cc) * TC + stile * 16 + fr) * 512 + fq * 8; \
            _Pragma("unroll") for (int ks = 0; ks < 2; ++ks) { aw[ks] = *(const bf16x8*)(lrow + ks * 32); aa[ks] = *(const bf16x8*)(lrow + 128 + ks * 32); } \
            _Pragma("unroll") for (int ks = 0; ks < 5; ++ks) ag[ks] = *(const bf16x8*)(lrow + 256 + ks * 32); } while (0)
#define LORA_RUN() do { f32x4 cw = {0.f, 0.f, 0.f, 0.f}, ca = {0.f, 0.f, 0.f, 0.f}, cg_ = {0.f, 0.f, 0.f, 0.f}; \
            _Pragma("unroll") for (int ks = 0; ks < 2; ++ks) { cw = __builtin_amdgcn_mfma_f32_16x16x32_bf16(aw[ks], bw[ks], cw, 0, 0, 0); ca = __builtin_amdgcn_mfma_f32_16x16x32_bf16(aa[ks], ba[ks], ca, 0, 0, 0); } \
            _Pragma("unroll") for (int ks = 0; ks < 5; ++ks) cg_ = __builtin_amdgcn_mfma_f32_16x16x32_bf16(ag[ks], bg[ks], cg_, 0, 0, 0); \
            _Pragma("unroll") for (int e = 0; e < 4; ++e) { const int xi = (stile * 16 + 4 * fq + e) * XS + ntile * 16 + fr; \
                xb[xi] = __builtin_amdgcn_exp2f(-0.87503988f * __builtin_amdgcn_rcpf(1.0f + __expf(-(w0c + cw[e])))); \
                xb[TC * XS + xi] = __builtin_amdgcn_rcpf(1.0f + __expf(-(a0c + ca[e]))); \
                xb[2 * TC * XS + xi] = cg_[e]; } } while (0)
        LORA_LOAD(0); LORA_RUN();
        __syncthreads();
        u32x2 ypend = {0u, 0u};
        for (int c = 0; c < T / TC; ++c) {
            const f32x4 r4 = {bf_lo(pr.x), bf_hi(pr.x), bf_lo(pr.y), bf_hi(pr.y)};
            const f32x4 k4 = {bf_lo(pk.x), bf_hi(pk.x), bf_lo(pk.y), bf_hi(pk.y)};
            const f32x4 v4 = {bf_lo(pv.x), bf_hi(pv.x), bf_lo(pv.y), bf_hi(pv.y)};
            const f32x4 w4 = *(const LAS f32x4*)(xb + ts * XS + jg * 4), a4 = *(const LAS f32x4*)(xb + TC * XS + ts * XS + jg * 4), g4 = *(const LAS f32x4*)(xb + 2 * TC * XS + ts * XS + jg * 4);
            const f32x4 kkx = k4 * kk4;
            const float ss = reduce16((kkx.x * kkx.x + kkx.y * kkx.y) + (kkx.z * kkx.z + kkx.w * kkx.w));
            const float inv = __builtin_amdgcn_rsqf(fmaxf(ss, 1e-24f));
            const f32x4 kk = kkx * inv;
            const f32x4 kf = k4 * ((a4 - 1.0f) * ka4 + 1.0f);
            const f32x4 am = -kk, bm = kk * a4;
            const f32x4 rkr = r4 * kf * rk4;
            const float ct = reduce16((rkr.x + rkr.y) + (rkr.z + rkr.w));
            {
                LAS f32x4* o = (LAS f32x4*)(op + (ts * 16 + jg) * 20);
                o[0] = w4; o[1] = am; o[2] = bm; o[3] = kf; o[4] = r4;
                *(LAS f32x4*)(vb + ts * 64 + jg * 4) = v4;
            }
            __syncthreads();
            if (c > 0) *(u32x2*)(YG + base + (size_t)((c - 1) * TC + ts) * D) = ypend;
            if (c + 1 < T / TC) { off = base + (size_t)((c + 1) * TC + ts) * D;
                pr = *(const u32x2*)(Rg + off); pk = *(const u32x2*)(Kg + off); pv = *(const u32x2*)(Vg + off);
                LORA_LOAD(c + 1); }
            {
                const LAS float* obase = op + (lane & 15) * 20;
                const LAS float* vbase = vb + r0;
                f32x4 ow = *(const LAS f32x4*)(obase), oa = *(const LAS f32x4*)(obase + 4), ob = *(const LAS f32x4*)(obase + 8), ok = *(const LAS f32x4*)(obase + 12), orr = *(const LAS f32x4*)(obase + 16);
                f32x2 vv = *(const LAS f32x2*)(vbase);
#pragma unroll 2
                for (int s = 0; s < TC; ++s) {
                    const LAS float* o = obase + (s + 1) * 320;
                    const f32x4 now = *(const LAS f32x4*)(o), noa = *(const LAS f32x4*)(o + 4), nob = *(const LAS f32x4*)(o + 8), nok = *(const LAS f32x4*)(o + 12), norr = *(const LAS f32x4*)(o + 16);
                    const f32x2 nvv = *(const LAS f32x2*)(vbase + (s + 1) * 64);
                    const f32x2 p0 = pkfma_(S0b, HI2(oa), pkmul_(S0a, LO2(oa))), p1 = pkfma_(S1b, HI2(oa), pkmul_(S1a, LO2(oa)));
                    float sa0 = add_(p0.x, p0.y), sa1 = add_(p1.x, p1.y);
                    sa0 = reduce16(sa0); asm volatile("" : "+v"(sa0)); sa1 = reduce16(sa1);
                    const f32x2 sap = {sa0, sa1};
                    S0a = pkfma_lo_(vv, LO2(ok), pkfma_lo_(sap, LO2(ob), pkmul_(S0a, LO2(ow))));
                    S0b = pkfma_lo_(vv, HI2(ok), pkfma_lo_(sap, HI2(ob), pkmul_(S0b, HI2(ow))));
                    S1a = pkfma_hi_(vv, LO2(ok), pkfma_hi_(sap, LO2(ob), pkmul_(S1a, LO2(ow))));
                    S1b = pkfma_hi_(vv, HI2(ok), pkfma_hi_(sap, HI2(ob), pkmul_(S1b, HI2(ow))));
                    const f32x2 q0 = pkfma_(S0b, HI2(orr), pkmul_(S0a, LO2(orr))), q1 = pkfma_(S1b, HI2(orr), pkmul_(S1a, LO2(orr)));
                    float y0 = add_(q0.x, q0.y), y1 = add_(q1.x, q1.y);
                    y0 += dppf<0xB1>(y0); y1 += dppf<0xB1>(y1); y0 += dppf<0x4E>(y0); y1 += dppf<0x4E>(y1);
                    *(LAS f32x2*)(yb + (s * 4 + ((lane >> 2) & 3)) * 64 + r0) = (f32x2){y0, y1};
                    ow = now; oa = noa; ob = nob; ok = nok; orr = norr; vv = nvv;
                }
            }
            __syncthreads();
            {
                const f32x4 y4 = (*(const LAS f32x4*)(yb + (ts * 4 + 0) * 64 + jg * 4) + *(const LAS f32x4*)(yb + (ts * 4 + 1) * 64 + jg * 4)) + (*(const LAS f32x4*)(yb + (ts * 4 + 2) * 64 + jg * 4) + *(const LAS f32x4*)(yb + (ts * 4 + 3) * 64 + jg * 4));
                const float mean = reduce16((y4.x + y4.y) + (y4.z + y4.w)) * (1.f / 64.f);
                const f32x4 d = y4 - mean;
                const float var = reduce16((d.x * d.x + d.y * d.y) + (d.z * d.z + d.w * d.w)) * (1.f / 64.f);
                const float rstd = __builtin_amdgcn_rsqf(var + 64e-5f);
                const f32x4 o = ((d * rstd) * lg4 + lb4 + v4 * ct) * g4;
                u32x2 w; w.x = cvt_pk_bf16(o.x, o.y); w.y = cvt_pk_bf16(o.z, o.w);
                ypend = w;
            }
            if (c + 1 < T / TC) LORA_RUN();
            __syncthreads();
        }
        *(u32x2*)(YG + base + (size_t)((T / TC - 1) * TC + ts) * D) = ypend;
#undef LORA_LOAD
#undef LORA_RUN
    }
}


#define SEAM() do { ++ph; if (lo < ph && ph < hi) { if (ph == 1) gsync(grid); else xcd_barrier(xbar); } } while (0)
#define RUN (lo <= ph && ph < hi)
template <int l> __device__ __forceinline__ void layer(const Args& a, LAS unsigned char* lds, cg::grid_group& grid, const XcdBarrier& xbar, int& ph, const int lo, const int hi) {
    unsigned char* ws = a.ws;
    const float* MOD = (const float*)(ws + WS_MOD);
    bf16_t* H = (bf16_t*)(ws + WS_H);
    const int G = gridDim.x, c = blockIdx.x;
    const float* mod = MOD + (size_t)l * 16 * 6144;
    const float* xin = (l == 0) ? a.in[0] : a.out;
    if (RUN) {
        if (l == 1) phase_norm_shift(xin, mod + 0 * 1024, mod + 1 * 1024, a.in[12], (bf16_t*)(ws + WS_X3), (bf16_t*)(ws + WS_H2));
        else if ((threadIdx.x >> 6) < 4) { phase_norm_mod(xin, mod + 0 * 1024, mod + 1 * 1024, H, 0); phase_weights(a, lds); }
        else { phase_weights(a, lds); phase_norm_mod(xin, mod + 0 * 1024, mod + 1 * 1024, H, 0); }
    }
    SEAM();
    if (l == 0) {
        if (RUN) { pg8::Gemm g{H, (const bf16_t*)(ws + WS_WIN0), M, 2048, 1024, 0, 0}; pg8::StaticOrder S; S.init(M, 2048, G, c);
          pg8::EpiAct<1> E{(bf16_t*)(ws + WS_UV), 2048}; pg8::gemm_phase(lds, g, S, E); }
        SEAM();
        if (RUN) phase_sgu(a, lds);
        SEAM();
        if (RUN) { pg8::Gemm g{(const bf16_t*)(ws + WS_Z), (const bf16_t*)(ws + WS_WOUT0), M, 1024, 1024, 0, 0}; pg8::StaticOrder S; S.init(M, 1024, G, c);
          pg8::EpiRes E{a.in[0], a.out, mod + 2 * 1024, 6144}; pg8::gemm_phase(lds, g, S, E); }
    } else {
        if (RUN) {
          { pg8::Gemm g{(const bf16_t*)(ws + WS_H2), (const bf16_t*)(ws + WS_WL1), M, 512, 2048, 0, 1}; pg8::StaticOrder S; S.init(M, 512, G, c, 1);
            pg8::EpiRkvL E{(bf16_t*)(ws + WS_R), (size_t)(WS_K - WS_R) / 2, (bf16_t*)(ws + WS_L), 12}; pg8::gemm_phase(lds, g, S, E); }
          { pg8::Gemm g{(const bf16_t*)(ws + WS_X3), (const bf16_t*)(ws + WS_WRKV), M, 3072, 1024, (long)M * D, 0}; pg8::StaticOrder S; S.init(M, 3072, G, c, 1);
            pg8::EpiRkvL E{(bf16_t*)(ws + WS_R), (size_t)(WS_K - WS_R) / 2, (bf16_t*)(ws + WS_L), 0}; pg8::gemm_phase(lds, g, S, E); }
        }
        SEAM();
        if (RUN) phase_scan(a, lds);
        SEAM();
        if (RUN) { pg8::Gemm g{(const bf16_t*)(ws + WS_YG), (const bf16_t*)(ws + WS_WOUT1), M, 1024, 1024, 0, 0}; pg8::StaticOrder S; S.init(M, 1024, G, c);
          pg8::EpiRes E{a.out, a.out, mod + 2 * 1024, 6144}; pg8::gemm_phase(lds, g, S, E); }
    }
    SEAM();
    if (RUN) phase_norm_mod(a.out, mod + 3 * 1024, mod + 4 * 1024, H, 0);
    SEAM();
    if (RUN) { pg8::Gemm g{H, (const bf16_t*)(ws + WS_W1 + (size_t)l * 4096 * 1024 * 2), M, 4096, 1024, 0, 0}; pg8::StaticOrder S; S.init(M, 4096, G, c);
      pg8::EpiAct<2> E{(bf16_t*)(ws + WS_HID), 4096}; pg8::gemm_phase(lds, g, S, E); }
    SEAM();
    if (RUN) { pg8::Gemm g{(const bf16_t*)(ws + WS_HID), (const bf16_t*)(ws + WS_W2 + (size_t)l * 1024 * 4096 * 2), M, 1024, 4096, 0, 0}; pg8::StaticOrder S; S.init(M, 1024, G, c, 1);
      pg8::EpiRes E{a.out, a.out, mod + 5 * 1024, 6144}; pg8::gemm_phase(lds, g, S, E); }
    SEAM();
}
constexpr int NPHASES = 16;

__global__ void __launch_bounds__(NTHREADS, 2) fwd_megakernel(Args a) {
    extern __shared__ __attribute__((aligned(16))) unsigned char lds_raw[];
    LAS unsigned char* lds = (LAS unsigned char*)lds_raw;
    cg::grid_group grid = cg::this_grid();
    const int lo = a.lo, hi = a.hi;
    int ph = 0;
    volatile LAS unsigned* bst = (volatile LAS unsigned*)(lds + 131072 + 512);
    if (threadIdx.x < 2) bst[threadIdx.x] = 0u;
    __syncthreads();
    XcdBarrier xbar; xbar.bar = (unsigned*)a.ws; xbar.x = 0; xbar.st = nullptr;
    if (hi - lo > 1) xbar = xcd_barrier_post((unsigned*)a.ws, bst);
    if (RUN) phase_prep(a, lds);
    SEAM();
    layer<0>(a, lds, grid, xbar, ph, lo, hi);
    layer<1>(a, lds, grid, xbar, ph, lo, hi);
    if (RUN) phase_final_norm(a.out, a.in[28]);
}
#ifndef N_LAUNCHES
#define N_LAUNCHES 1
#endif

extern "C" void kernel_launch(void* const* d_in, const int* in_sizes, int n_in, void* d_out, int out_size, void* d_ws, size_t ws_size, hipStream_t stream) {
    static int grid = 0;
    if (grid == 0) {
        if (n_in != 29 || out_size != M * D || ws_size < WS_END) { fprintf(stderr, "kernel_launch: unexpected problem: n_in %d out %d ws %zu (need %zu)\n", n_in, out_size, ws_size, (size_t)WS_END); grid = -1; return; }
        int dev = 0, cus = 0, per_cu = 0;
        hipGetDevice(&dev);
        hipDeviceGetAttribute(&cus, hipDeviceAttributeMultiprocessorCount, dev);
        if (hipFuncSetAttribute((const void*)fwd_megakernel, hipFuncAttributeMaxDynamicSharedMemorySize, LDS_BYTES) != hipSuccess) { fprintf(stderr, "kernel_launch: hipFuncSetAttribute failed\n"); grid = -1; return; }
        if (hipOccupancyMaxActiveBlocksPerMultiprocessor(&per_cu, (const void*)fwd_megakernel, NTHREADS, LDS_BYTES) != hipSuccess || per_cu < 1) { fprintf(stderr, "kernel_launch: occupancy query says %d blocks/CU\n", per_cu); per_cu = 1; }
        (void)hipGetLastError();
        grid = cus;
    }
    if (grid < 0) return;
    Args a{};
    for (int i = 0; i < 29; ++i) a.in[i] = (const float*)d_in[i];
    a.out = (float*)d_out; a.ws = (unsigned char*)d_ws;
    if (N_LAUNCHES == 1) {
        if (hipMemsetAsync(d_ws, 0, 16384, stream) != hipSuccess) { fprintf(stderr, "kernel_launch: memset of the barrier words failed\n"); return; }
        a.lo = 0; a.hi = NPHASES;
        void* args[] = {&a};
        hipError_t e = hipLaunchCooperativeKernel((const void*)fwd_megakernel, dim3(grid), dim3(NTHREADS), args, LDS_BYTES, stream);
        if (e != hipSuccess) fprintf(stderr, "kernel_launch: cooperative launch failed: %s (grid %d)\n", hipGetErrorString(e), grid);
    } else {
        for (int p = 0; p < NPHASES; ++p) { a.lo = p; a.hi = p + 1;
            hipLaunchKernelGGL(fwd_megakernel, dim3(grid), dim3(NTHREADS), LDS_BYTES, stream, a); }
    }
}
```

```cpp
#include <hip/hip_runtime.h>
#include <hip/hip_cooperative_groups.h>
#include <cstdio>
#include <cstdint>
namespace cg = cooperative_groups;

#define LAS __attribute__((address_space(3)))
typedef unsigned short bf16_t;
typedef short bf16x8 __attribute__((ext_vector_type(8)));
typedef float f32x4 __attribute__((ext_vector_type(4)));
typedef float f32x2 __attribute__((ext_vector_type(2)));
typedef unsigned u32x4 __attribute__((ext_vector_type(4)));
typedef unsigned u32x2 __attribute__((ext_vector_type(2)));

constexpr int D = 1024, NB = 16, T = 4096, M = NB * T, FF = 4096, NMOD = 6;
constexpr int NTHREADS = 512, NWAVES = 8;

__device__ __forceinline__ int opaque_tid() { int t = threadIdx.x; asm volatile("" : "+v"(t)); return t; }
__device__ __forceinline__ unsigned cvt_pk_bf16(float lo, float hi) { unsigned r; asm volatile("v_cvt_pk_bf16_f32 %0, %1, %2" : "=v"(r) : "v"(lo), "v"(hi)); return r; }
__device__ __forceinline__ float bf_lo(unsigned u) { return __builtin_bit_cast(float, u << 16); }
__device__ __forceinline__ float bf_hi(unsigned u) { return __builtin_bit_cast(float, u & 0xffff0000u); }
__device__ __forceinline__ float sigmoidf_(float x) { return __builtin_amdgcn_rcpf(1.0f + __expf(-x)); }

namespace pg8 {
constexpr int BM = 256, BK = 64, HALF = 128, HTB = HALF * BK * 2, STAGE_BYTES = 8 * HTB, NXCD = 8, WGM = 8;
__host__ __device__ __forceinline__ int lds_byte(int r, int c) { const int st = (r >> 4) * 2 + (c >> 5), rr = r & 15, cc = c & 31, ob = rr * 64 + cc * 2; return st * 1024 + (ob ^ (((ob >> 9) & 1) << 5)); }
__host__ __device__ __forceinline__ void stage_rc(int b, int& R, int& C) { const int st = b / 1024, sb = b % 1024, swz = sb ^ (((sb >> 9) & 1) << 5); R = (st >> 1) * 16 + swz / 64; C = (st & 1) * 32 + (swz % 64) / 2; }
__host__ __device__ __forceinline__ int perm32(int rho) { const int n = rho >> 4, i = rho & 15; return 8 * (i >> 2) + 4 * n + (i & 3); }

struct Unit { int pm, pn; };
struct Gemm { const bf16_t* A; const bf16_t* Bt; int M, N, K; long asplit; int shift; };

struct StaticOrder {
    int nM, nN, nwg, G, c, rev;
    __device__ void init(int M_, int N_, int G_, int c_, int rev_ = 0) { nM = M_ / BM; nN = N_ / BM; nwg = nM * nN; G = G_; c = c_; rev = rev_; }
    __device__ bool next(int i, Unit& u) const {
        const long L = (long)i * G + c; if (L >= nwg) return false;
        int wgid = (int)L; { const int q = nwg / NXCD, r = nwg % NXCD, xcd = wgid % NXCD, off = wgid / NXCD; wgid = (xcd < r ? xcd * (q + 1) : r * (q + 1) + (xcd - r) * q) + off; }
        const int nig = WGM * nN, gid = wgid / nig, fm = gid * WGM, gsz = (nM - fm) < WGM ? (nM - fm) : WGM;
        u.pm = fm + ((wgid % nig) % gsz); u.pn = (wgid % nig) / gsz; if (rev) u.pm = nM - 1 - u.pm; return true;
    }
};

__device__ __forceinline__ f32x2 gelu_pk(f32x2 v) {
    const f32x2 av = __builtin_elementwise_abs(v), d = av * 0.2316418882f + 1.0f;
    f32x2 t; t.x = __builtin_amdgcn_rcpf(d.x); t.y = __builtin_amdgcn_rcpf(d.y);
    f32x2 q = t * 0.5307027145f + (-0.7265760135f); q = q * t + 0.7107068705f; q = q * t + (-0.142248368f); q = q * t + 0.127414796f; q = q * t;
    const f32x2 s = (v * v) * (-0.72134752044f);
    f32x2 e; e.x = __builtin_amdgcn_exp2f(s.x); e.y = __builtin_amdgcn_exp2f(s.y);
    const f32x2 m = v * (q * e), r = v - m;
    f32x2 o; o.x = v.x < 0.f ? m.x : r.x; o.y = v.y < 0.f ? m.y : r.y; return o;
}

template <int ACT  > struct EpiAct {
    static constexpr bool PERM = true;
    bf16_t* O; int ldc;
    __device__ __forceinline__ void operator()(const f32x4 (&acc)[2][2][4][2], const Unit& u, int wr, int wc, int fr, int fq) const {
        const int row0 = u.pm * BM + wr * 64 + fr; const int col0 = u.pn * BM + wc * 32 + 8 * fq;
#pragma unroll
        for (int ai = 0; ai < 2; ++ai)
#pragma unroll
            for (int m = 0; m < 4; ++m) { bf16_t* rowp = O + (size_t)(row0 + ai * HALF + m * 16) * ldc + col0;
#pragma unroll
                for (int bj = 0; bj < 2; ++bj) { f32x4 v0 = acc[ai][bj][m][0], v1 = acc[ai][bj][m][1];
                    if (ACT == 1) { f32x2 a = gelu_pk((f32x2){v0[0], v0[1]}), b = gelu_pk((f32x2){v0[2], v0[3]}), c = gelu_pk((f32x2){v1[0], v1[1]}), d = gelu_pk((f32x2){v1[2], v1[3]});
                        v0 = (f32x4){a.x, a.y, b.x, b.y}; v1 = (f32x4){c.x, c.y, d.x, d.y}; }
                    if (ACT == 2) {
#pragma unroll
                        for (int e = 0; e < 4; ++e) { float p = fmaxf(v0[e], 0.f), q = fmaxf(v1[e], 0.f); v0[e] = p * p; v1[e] = q * q; } }
                    u32x4 w; w.x = cvt_pk_bf16(v0[0], v0[1]); w.y = cvt_pk_bf16(v0[2], v0[3]); w.z = cvt_pk_bf16(v1[0], v1[1]); w.w = cvt_pk_bf16(v1[2], v1[3]);
                    *(u32x4*)(rowp + bj * HALF) = w; } }
    }
};
struct EpiRkvL {
    static constexpr bool PERM = true;
    bf16_t* R; size_t split_stride; bf16_t* L; int pn_off;
    __device__ __forceinline__ void operator()(const f32x4 (&acc)[2][2][4][2], const Unit& u0, int wr, int wc, int fr, int fq) const {
        Unit u = u0; u.pn += pn_off;
        const int row0 = u.pm * BM + wr * 64 + fr;
        bf16_t* base; int ldc, colt, mode;
        if (u.pn < 12) { base = R + (size_t)(u.pn >> 2) * split_stride; colt = (u.pn & 3) * BM; ldc = 1024; mode = 0; }
        else { base = L; colt = (u.pn - 12) * BM; ldc = 512; mode = (u.pn == 12) ? 1 : 2; }
        const int col0 = colt + wc * 32 + 8 * fq;
#pragma unroll
        for (int ai = 0; ai < 2; ++ai)
#pragma unroll
            for (int m = 0; m < 4; ++m) { bf16_t* rowp = base + (size_t)(row0 + ai * HALF + m * 16) * ldc + col0;
#pragma unroll
                for (int bj = 0; bj < 2; ++bj) { f32x4 v0 = acc[ai][bj][m][0], v1 = acc[ai][bj][m][1];
                    if (mode == 1 && bj == 0) {
#pragma unroll
                        for (int e = 0; e < 4; ++e) { v0[e] = tanhf(v0[e]); v1[e] = tanhf(v1[e]); } }
                    if (mode == 2) {
#pragma unroll
                        for (int e = 0; e < 4; ++e) { v0[e] = sigmoidf_(v0[e]); v1[e] = sigmoidf_(v1[e]); } }
                    u32x4 w; w.x = cvt_pk_bf16(v0[0], v0[1]); w.y = cvt_pk_bf16(v0[2], v0[3]); w.z = cvt_pk_bf16(v1[0], v1[1]); w.w = cvt_pk_bf16(v1[2], v1[3]);
                    *(u32x4*)(rowp + bj * HALF) = w; } }
    }
};
struct EpiL2 {
    static constexpr bool PERM = true;
    bf16_t* O0; bf16_t* O1; bf16_t* O2; const float* w0; const float* a0;
    __device__ __forceinline__ void operator()(const f32x4 (&acc)[2][2][4][2], const Unit& u, int wr, int wc, int fr, int fq) const {
        const int mode = u.pn >> 2;
        const int row0 = u.pm * BM + wr * 64 + fr; const int col0 = (u.pn & 3) * BM + wc * 32 + 8 * fq;
        bf16_t *o0 = O0, *o1 = O1, *o2 = O2; const float *bw = w0, *ba = a0;
        asm volatile("" : "+s"(o0), "+s"(o1), "+s"(o2), "+s"(bw), "+s"(ba));
        bf16_t* base = (mode == 0) ? o0 : ((mode == 1) ? o1 : o2);
        const float* bias = (mode == 0) ? bw : ba;
#pragma unroll
        for (int bj = 0; bj < 2; ++bj) {
            f32x4 b0 = {0.f, 0.f, 0.f, 0.f}, b1 = {0.f, 0.f, 0.f, 0.f};
            if (mode != 2) { b0 = *(const f32x4*)(bias + col0 + bj * HALF); b1 = *(const f32x4*)(bias + col0 + bj * HALF + 4); }
#pragma unroll
            for (int ai = 0; ai < 2; ++ai)
#pragma unroll
                for (int m = 0; m < 4; ++m) { bf16_t* rowp = base + (size_t)(row0 + ai * HALF + m * 16) * 1024 + col0;
                    f32x4 v0 = acc[ai][bj][m][0] + b0, v1 = acc[ai][bj][m][1] + b1;
                    if (mode != 2) {
                        const float sc = (mode == 0) ? -0.87503988f : 1.0f;
#pragma unroll
                        for (int e = 0; e < 4; ++e) { v0[e] = sc * __builtin_amdgcn_rcpf(1.0f + __expf(-v0[e])); v1[e] = sc * __builtin_amdgcn_rcpf(1.0f + __expf(-v1[e])); } }
                    u32x4 w; w.x = cvt_pk_bf16(v0[0], v0[1]); w.y = cvt_pk_bf16(v0[2], v0[3]); w.z = cvt_pk_bf16(v1[0], v1[1]); w.w = cvt_pk_bf16(v1[2], v1[3]);
                    *(u32x4*)(rowp + bj * HALF) = w;
                    if (m & 1) asm volatile("" ::: "memory"); }
        }
    }
};
struct EpiRes {
    static constexpr bool PERM = false;
    const float* base; float* out; const float* gate;
    int gstride;
    __device__ __forceinline__ void operator()(const f32x4 (&acc)[2][2][4][2], const Unit& u, int wr, int wc, int fr, int fq) const {
        const int col0 = u.pn * BM + wc * 32 + 4 * fq;
        const float* gp = gate + (size_t)(u.pm >> 4) * gstride + col0;
        f32x4 gv[2][2];
#pragma unroll
        for (int bj = 0; bj < 2; ++bj)
#pragma unroll
            for (int n = 0; n < 2; ++n) gv[bj][n] = *(const f32x4*)(gp + bj * HALF + n * 16);
#pragma unroll
        for (int ai = 0; ai < 2; ++ai)
#pragma unroll
            for (int m = 0; m < 4; ++m) { const size_t off = (size_t)(u.pm * BM + ai * HALF + wr * 64 + m * 16 + fr) * 1024 + col0;
#pragma unroll
                for (int bj = 0; bj < 2; ++bj)
#pragma unroll
                    for (int n = 0; n < 2; ++n) { const f32x4 bs = *(const f32x4*)(base + off + bj * HALF + n * 16);
                        *(f32x4*)(out + off + bj * HALF + n * 16) = bs + gv[bj][n] * acc[ai][bj][m][n]; } }
    }
};

template <class Epi>
__device__ __forceinline__ void gemm_phase(LAS unsigned char* lds, const Gemm g, const StaticOrder& S, const Epi& E) {
    const int tid = opaque_tid(), wid = __builtin_amdgcn_readfirstlane(tid >> 6), lane = tid & 63, wr = wid >> 2, wc = wid & 3, fr = lane & 15, fq = lane >> 4;
    int K_ = g.K; asm volatile("" : "+s"(K_));
    const int K = K_, nt = K / BK, lda = g.shift ? (K_ >> 1) : K_;
    const int ntA = g.shift ? (nt >> 1) : (1 << 30);
    const long adj = g.shift ? ((long)lda * 2 + (long)ntA * (BK * 2)) : 0;
    unsigned voffA[2], voffB[2];
#pragma unroll
    for (int i = 0; i < 2; ++i) { int R, C; stage_rc(tid * 16 + i * 8192, R, C); const int Rb = Epi::PERM ? ((R & ~31) + perm32(R & 31)) : R;
        voffA[i] = (unsigned)(R * lda + C) * 2u; voffB[i] = (unsigned)(Rb * K + C) * 2u; }
    const long kstep = (long)(BK * 2);
    const long hstepA = (long)HALF * lda * 2, hstepB = (long)HALF * K * 2, tstepB = 2 * hstepB;
    const unsigned ldsw = (unsigned)wid * 1024u;
    const int aoff = lds_byte(wr * 64 + fr, fq * 8), boff = lds_byte(wc * 32 + fr, fq * 8);
#define PG8_ABASE(u) ((const char*)g.A + ((long)((u).pn >> 2) * g.asplit + ((long)(u).pm * BM + (g.shift ? ((u).pm >> 4) + 1 : 0)) * (long)lda) * 2)
#define PG8_APTR(base, kt) ((base) + ((long)(kt) * kstep - (((kt) >= ntA) ? adj : 0)))
#define PG8_SA(b, h) (((b) * 2 + (h)) * HTB)
#define PG8_SB(b, h) ((4 + (b) * 2 + (h)) * HTB)
#define PG8_STAGE(bufoff, gbase, voff) do { _Pragma("unroll") for (int _i = 0; _i < 2; ++_i) \
        __builtin_amdgcn_global_load_lds((const unsigned*)((const char*)(gbase) + (voff)[_i]), (LAS unsigned*)(lds + (bufoff) + ldsw + _i * 8192), 16, 0, 0); } while (0)
#define PG8_LDA(dst, b, h) do { _Pragma("unroll") for (int m = 0; m < 4; ++m) _Pragma("unroll") for (int k = 0; k < 2; ++k) dst[m][k] = *(const LAS bf16x8*)(lds + PG8_SA(b, h) + aoff + m * 2048 + k * 1024); } while (0)
#define PG8_LDB(dst, b, h) do { _Pragma("unroll") for (int n = 0; n < 2; ++n) _Pragma("unroll") for (int k = 0; k < 2; ++k) dst[n][k] = *(const LAS bf16x8*)(lds + PG8_SB(b, h) + boff + n * 2048 + k * 1024); } while (0)
#define PG8_MMA(ai, bj, At, Bt) do { __builtin_amdgcn_s_setprio(1); _Pragma("unroll") for (int m = 0; m < 4; ++m) _Pragma("unroll") for (int n = 0; n < 2; ++n) _Pragma("unroll") for (int k = 0; k < 2; ++k) \
        acc[ai][bj][m][n] = __builtin_amdgcn_mfma_f32_16x16x32_bf16(Bt[n][k], At[m][k], acc[ai][bj][m][n], 0, 0, 0); __builtin_amdgcn_s_setprio(0); } while (0)
#define PG8_WAIT_V(n) asm volatile("s_waitcnt vmcnt(" #n ")" ::: "memory")
#define PG8_WAIT_L(n) asm volatile("s_waitcnt lgkmcnt(" #n ")" ::: "memory")
#define PG8_BAR __builtin_amdgcn_s_barrier()
#define PG8_SCHED __builtin_amdgcn_sched_barrier(0)
    Unit cur, nxt; int ui = 0;
    if (!S.next(0, cur)) return;
    f32x4 acc[2][2][4][2];
#pragma unroll
    for (int a = 0; a < 2; ++a)
#pragma unroll
        for (int b = 0; b < 2; ++b)
#pragma unroll
            for (int m = 0; m < 4; ++m)
#pragma unroll
                for (int n = 0; n < 2; ++n) acc[a][b][m][n] = (f32x4){0.f, 0.f, 0.f, 0.f};
    bf16x8 At[4][2], B0[2][2], B1[2][2];
    const char* cA = PG8_ABASE(cur); const char* cB = (const char*)g.Bt + (long)cur.pn * tstepB;
    PG8_STAGE(PG8_SB(0, 0), cB, voffB); PG8_STAGE(PG8_SB(0, 1), cB + hstepB, voffB); PG8_STAGE(PG8_SA(0, 0), cA, voffA); PG8_STAGE(PG8_SA(0, 1), cA + hstepA, voffA);
    if (wr == 1) PG8_BAR;
    PG8_WAIT_V(2); PG8_BAR;
    PG8_STAGE(PG8_SB(1, 0), cB + kstep, voffB); PG8_STAGE(PG8_SA(1, 0), cA + kstep, voffA); PG8_STAGE(PG8_SB(1, 1), cB + hstepB + kstep, voffB);
    PG8_WAIT_V(6); PG8_BAR;
    for (;;) {
        const bool has_next = S.next(ui + 1, nxt);
        const char* nA = has_next ? PG8_ABASE(nxt) : cA; const char* nB = has_next ? (const char*)g.Bt + (long)nxt.pn * tstepB : cB;
        for (int t = 0; t < nt; t += 2) {
            const bool last = (t == nt - 2);
            const char* a1 = PG8_APTR(cA, t + 1);
            const char* a2 = last ? nA : PG8_APTR(cA, t + 2); const char* b2 = last ? nB : cB + (long)(t + 2) * kstep;
            const char* a3 = a2 + kstep; const char* b3 = b2 + kstep;
            PG8_LDB(B0, 0, 0); PG8_LDB(B1, 0, 1); PG8_SCHED; PG8_LDA(At, 0, 0); PG8_STAGE(PG8_SA(1, 1), a1 + hstepA, voffA);
            PG8_WAIT_V(8); PG8_WAIT_L(0); PG8_BAR; PG8_MMA(0, 0, At, B0); PG8_MMA(0, 1, At, B1); PG8_BAR; PG8_SCHED;
            PG8_LDA(At, 0, 1); PG8_STAGE(PG8_SB(0, 0), b2, voffB); PG8_STAGE(PG8_SB(0, 1), b2 + hstepB, voffB); PG8_STAGE(PG8_SA(0, 0), a2, voffA);
            PG8_WAIT_V(8); PG8_WAIT_L(0); PG8_BAR; PG8_MMA(1, 0, At, B0); PG8_MMA(1, 1, At, B1); PG8_BAR; PG8_SCHED;
            PG8_LDB(B0, 1, 0); PG8_LDB(B1, 1, 1); PG8_SCHED; PG8_LDA(At, 1, 0); PG8_STAGE(PG8_SA(0, 1), a2 + hstepA, voffA);
            PG8_WAIT_V(8); PG8_WAIT_L(0); PG8_BAR; PG8_MMA(0, 0, At, B0); PG8_MMA(0, 1, At, B1); PG8_BAR; PG8_SCHED;
            PG8_LDA(At, 1, 1); PG8_STAGE(PG8_SB(1, 0), b3, voffB); PG8_STAGE(PG8_SB(1, 1), b3 + hstepB, voffB); PG8_STAGE(PG8_SA(1, 0), a3, voffA);
            PG8_WAIT_V(8); PG8_WAIT_L(0); PG8_BAR; PG8_MMA(1, 0, At, B0); PG8_MMA(1, 1, At, B1); PG8_BAR; PG8_SCHED;
        }
        if (wr == 0) PG8_BAR;
        E(acc, cur, wr, wc, fr, fq);
        if (!has_next) break;
#pragma unroll
        for (int a = 0; a < 2; ++a)
#pragma unroll
            for (int b = 0; b < 2; ++b)
#pragma unroll
                for (int m = 0; m < 4; ++m)
#pragma unroll
                    for (int n = 0; n < 2; ++n) acc[a][b][m][n] = (f32x4){0.f, 0.f, 0.f, 0.f};
        cur = nxt; cA = nA; cB = nB; ++ui;
        if (wr == 1) PG8_BAR;
    }
    PG8_WAIT_V(0);
    PG8_BAR;
#undef PG8_ABASE
#undef PG8_APTR
#undef PG8_SA
#undef PG8_SB
#undef PG8_STAGE
#undef PG8_LDA
#undef PG8_LDB
#undef PG8_MMA
#undef PG8_WAIT_V
#undef PG8_WAIT_L
#undef PG8_BAR
#undef PG8_SCHED
}
}

constexpr size_t MiB = 1u << 20;
constexpr size_t WS_MOD = 1 * MiB;
constexpr size_t WS_WIN0 = 2 * MiB;
constexpr size_t WS_WOUT0 = 6 * MiB;
constexpr size_t WS_W1 = 8 * MiB;
constexpr size_t WS_W2 = 24 * MiB;
constexpr size_t WS_WRKV = 40 * MiB;
constexpr size_t WS_WL1 = 46 * MiB;
constexpr size_t WS_WL2 = 48 * MiB;
constexpr size_t WS_WOUT1 = 51 * MiB;
constexpr size_t WS_WS = 53 * MiB;
constexpr size_t WS_H = 60 * MiB;
constexpr size_t WS_UV = 188 * MiB;
constexpr size_t WS_Z = 444 * MiB;
constexpr size_t WS_HID = 188 * MiB;
constexpr size_t WS_X3 = 54 * MiB;
constexpr size_t WS_H2 = 438 * MiB;
constexpr size_t WS_L = 952 * MiB;
constexpr size_t WS_R = 567 * MiB, WS_K = 695 * MiB, WS_V = 823 * MiB;
constexpr size_t WS_WE = 60 * MiB, WS_A = 188 * MiB, WS_G = 316 * MiB;
constexpr size_t WS_YG = 54 * MiB;
constexpr size_t WS_END = 1020 * MiB;
constexpr int LDS_BYTES = 147456;

struct Args {
    const float* in[29];
    float* out; unsigned char* ws;
    int lo, hi;
};

__device__ __forceinline__ float wave_sum(float v) {
#pragma unroll
    for (int o = 1; o < 64; o <<= 1) v += __shfl_xor(v, o);
    return v;
}
template <int CTRL> __device__ __forceinline__ float dppf(float v) { return __builtin_bit_cast(float, __builtin_amdgcn_update_dpp(0, __builtin_bit_cast(int, v), CTRL, 0xF, 0xF, true)); }
__device__ __forceinline__ float reduce16(float v) {
    v += dppf<0xB1>(v); v += dppf<0x4E>(v); v += dppf<0x141>(v); v += dppf<0x140>(v); return v;
}

#define XB_TMO      128
#define XB_XCNT(j)  (256  + 64 * (j))
#define XB_XSUB(j)  (1280 + 64 * (j))
#define XB_XGEN(j)  (2304 + 64 * (j))
#define XB_TOP      3328
#define XB_TOPGEN   3392
#define XCD_BAR_WORDS 3456
#define XB_SPIN_CAP (1u << 18)

__device__ __forceinline__ unsigned xb_ld(unsigned* p)              { return __hip_atomic_load(p, __ATOMIC_RELAXED, __HIP_MEMORY_SCOPE_AGENT); }
__device__ __forceinline__ unsigned xb_add(unsigned* p, unsigned v) { return __hip_atomic_fetch_add(p, v, __ATOMIC_RELAXED, __HIP_MEMORY_SCOPE_AGENT); }
__device__ __forceinline__ unsigned xb_xcc_id() { return (unsigned)__builtin_amdgcn_s_getreg((3 << 11) | 20) & 0xFu; }
#define XB_SPIN(cond, bar) do { unsigned _sp = 0; while (cond) { __builtin_amdgcn_s_sleep(1); \
    if ((++_sp & 255u) == 0u) { if (xb_ld(&(bar)[XB_TMO])) break; if (_sp > XB_SPIN_CAP) { atomicAdd(&(bar)[XB_TMO], 1u); break; } } } } while (0)

struct XcdBarrier {
    unsigned* bar; unsigned x;
    volatile LAS unsigned* st;
};

__device__ __forceinline__ XcdBarrier xcd_barrier_post(unsigned* bar, volatile LAS unsigned* st) {
    XcdBarrier b; b.bar = bar; b.x = xb_xcc_id(); b.st = st;
    if (threadIdx.x == 0) (void)xb_add(&bar[XB_XCNT(b.x)], 1u);
    return b;
}
__device__ __forceinline__ void xcd_barrier_complete(unsigned* bar, unsigned x, unsigned& nloc, unsigned& nx) {
    const unsigned G = gridDim.x * gridDim.y * gridDim.z;
    unsigned sum, cnt, mine, sp = 0u;
    for (;;) {
        sum = 0u; cnt = 0u; mine = 0u;
#pragma unroll
        for (unsigned j = 0; j < 16; ++j) { const unsigned c = xb_ld(&bar[XB_XCNT(j)]); sum += c; cnt += (c > 0u) ? 1u : 0u; mine = (j == x) ? c : mine; }
        if (sum == G) break;
        __builtin_amdgcn_s_sleep(1);
        if ((++sp & 255u) == 0u) { if (xb_ld(&bar[XB_TMO])) break; if (sp > XB_SPIN_CAP) { atomicAdd(&bar[XB_TMO], 1u); break; } }
    }
    nloc = mine > 0u ? mine : 1u; nx = cnt > 0u ? cnt : 1u;
}

__device__ __forceinline__ void xcd_barrier(const XcdBarrier& b) {
    asm volatile("s_waitcnt vmcnt(0)" ::: "memory");
    __syncthreads();
    if (threadIdx.x == 0) {
        unsigned* bar = b.bar;
        __builtin_amdgcn_s_waitcnt(0);
        unsigned nloc = b.st[0], nx = b.st[1];
        if (nloc == 0u) { xcd_barrier_complete(bar, b.x, nloc, nx); b.st[0] = nloc; b.st[1] = nx; }
        const unsigned old = xb_add(&bar[XB_XSUB(b.x)], 1u);
        const unsigned gen = old / nloc;
        if (old + 1u == (gen + 1u) * nloc) {
            __builtin_amdgcn_fence(__ATOMIC_RELEASE, "agent");
            asm volatile("s_waitcnt vmcnt(0)" ::: "memory");
            const unsigned og = xb_add(&bar[XB_TOP], 1u);
            const unsigned tg = og / nx;
            if (og + 1u == (tg + 1u) * nx) xb_add(&bar[XB_TOPGEN], 1u);
            else XB_SPIN(xb_ld(&bar[XB_TOPGEN]) == tg, bar);
            __builtin_amdgcn_fence(__ATOMIC_ACQUIRE, "agent");
            xb_add(&bar[XB_XGEN(b.x)], 1u);
            asm volatile("s_waitcnt vmcnt(0)" ::: "memory");
        } else {
            XB_SPIN(xb_ld(&bar[XB_XGEN(b.x)]) == gen, bar);
            __builtin_amdgcn_fence(__ATOMIC_ACQUIRE, "agent");
            asm volatile("s_waitcnt vmcnt(0)" ::: "memory");
        }
    }
    __syncthreads();
}


__device__ __forceinline__ void gsync(cg::grid_group& grid) {
    asm volatile("s_waitcnt vmcnt(0) lgkmcnt(0)" ::: "memory");
    grid.sync();
    if (threadIdx.x < 64) { __builtin_amdgcn_fence(__ATOMIC_ACQUIRE, "agent"); asm volatile("s_waitcnt vmcnt(0)" ::: "memory"); }
    __syncthreads();
}
__device__ __forceinline__ void transpose_item(const float* W, int lds_, int Ksrc, int Nsrc, bf16_t* WT, int ldd, int row_off, int col_off,
                                               const float* mu, int mode, LAS float* scr, int kb, int nb, int lane) {
    const int k0 = 64 * kb, n0 = 32 * nb;
#pragma unroll 8
    for (int i = 0; i < 32; ++i) { const int kk = 2 * i + (lane >> 5), nn = lane & 31, k = k0 + kk, n = n0 + nn;
        float v = (k < Ksrc && n < Nsrc) ? W[(size_t)k * lds_ + n] : 0.f;
        if (mode) { const float m = mu[k & 1023]; v *= (mode == 1) ? (1.f - m) : m; }
        scr[kk * 33 + nn] = v; }
    asm volatile("s_waitcnt lgkmcnt(0)" ::: "memory");
    const int c = lane & 7;
#pragma unroll
    for (int j = 0; j < 4; ++j) { const int n = (lane >> 3) + 8 * j; const LAS float* s = scr + (8 * c) * 33 + n;
        u32x4 o; o.x = cvt_pk_bf16(s[0 * 33], s[1 * 33]); o.y = cvt_pk_bf16(s[2 * 33], s[3 * 33]); o.z = cvt_pk_bf16(s[4 * 33], s[5 * 33]); o.w = cvt_pk_bf16(s[6 * 33], s[7 * 33]);
        *(u32x4*)(WT + (size_t)(row_off + n0 + n) * ldd + col_off + k0 + 8 * c) = o; }
    asm volatile("s_waitcnt lgkmcnt(0)" ::: "memory");
}

__device__ __forceinline__ void phase_prep(const Args& a, LAS unsigned char* lds) {
    const int tid = opaque_tid(), lane = tid & 63, wave = tid >> 6;
    unsigned char* ws = a.ws;
    {
        LAS float* sc = (LAS float*)lds;
        LAS float* red = (LAS float*)(lds + 65536);
        bool have = false;
        for (int it = blockIdx.x; it < 2 * 96; it += gridDim.x) {
            if (!have) { const float* c = a.in[1];
                for (int e = tid; e < 16 * 1024; e += NTHREADS) { const int b = e >> 10, k = e & 1023; const float x = c[e]; sc[k * 16 + b] = x / (1.f + __expf(-x)); }
                have = true; }
            __syncthreads();
            const int l = it / 96, n0 = (it % 96) * 64;
            const float* w = a.in[2] + (size_t)l * 1024 * 6144 + n0 + lane;
            float acc[16];
#pragma unroll
            for (int b = 0; b < 16; ++b) acc[b] = 0.f;
            const int kbeg = wave * 128;
#pragma unroll 8
            for (int k = kbeg; k < kbeg + 128; ++k) { const float wv = w[(size_t)k * 6144];
                const LAS f32x4* s4 = (const LAS f32x4*)(sc + k * 16);
#pragma unroll
                for (int q = 0; q < 4; ++q) { const f32x4 s = s4[q]; acc[4 * q] += s[0] * wv; acc[4 * q + 1] += s[1] * wv; acc[4 * q + 2] += s[2] * wv; acc[4 * q + 3] += s[3] * wv; } }
#pragma unroll
            for (int b = 0; b < 16; ++b) red[(wave * 16 + b) * 64 + lane] = acc[b];
            __syncthreads();
            float* mod = (float*)(ws + WS_MOD);
            for (int e = tid; e < 1024; e += NTHREADS) { const int b = e >> 6, n = e & 63; float s = 0.f;
#pragma unroll
                for (int wv = 0; wv < 8; ++wv) s += red[(wv * 16 + b) * 64 + n];
                mod[((size_t)l * 16 + b) * 6144 + n0 + n] = s + a.in[3][l * 6144 + n0 + n]; }
            __syncthreads();
        }
        __syncthreads();
    }
}
__device__ __forceinline__ void phase_weights(const Args& a, LAS unsigned char* lds) {
    const int tid = opaque_tid(), lane = tid & 63, wave = tid >> 6;
    unsigned char* ws = a.ws;
    {
        LAS float* scr = (LAS float*)(lds + wave * 16384);
        const int gw = blockIdx.x * NWAVES + wave, NGW = gridDim.x * NWAVES;
        const float* mu = a.in[12];
        constexpr int TOTAL = 16 * 64 + 16 * 32 + 2 * 16 * 128 + 2 * 64 * 32 + 3 * 16 * 32 + 2 * (16 * 4 + 16 * 4 + 16 * 8) + 24 * 32 + 16 * 32;
        for (int it = gw; it < TOTAL; it += NGW) {
            int r = it;
#define JOB(W, LDSRC, KS, NS, DST, LDD, RO, CO, MU, MODE, KB, NBK) if (r >= 0) { if (r < (KB) * (NBK)) { transpose_item((W), (LDSRC), (KS), (NS), (bf16_t*)(ws + (DST)), (LDD), (RO), (CO), (MU), (MODE), scr, r / (NBK), r % (NBK), lane); r = -1; } else r -= (KB) * (NBK); }
            JOB(a.in[6], 2048, 1024, 2048, WS_WIN0, 1024, 0, 0, mu, 0, 16, 64)
            JOB(a.in[11], 1024, 1024, 1024, WS_WOUT0, 1024, 0, 0, mu, 0, 16, 32)
            JOB(a.in[4], 4096, 1024, 4096, WS_W1, 1024, 0, 0, mu, 0, 16, 128)
            JOB(a.in[4] + (size_t)1024 * 4096, 4096, 1024, 4096, WS_W1 + (size_t)4096 * 1024 * 2, 1024, 0, 0, mu, 0, 16, 128)
            JOB(a.in[5], 1024, 4096, 1024, WS_W2, 4096, 0, 0, mu, 0, 64, 32)
            JOB(a.in[5] + (size_t)4096 * 1024, 1024, 4096, 1024, WS_W2 + (size_t)1024 * 4096 * 2, 4096, 0, 0, mu, 0, 64, 32)
            JOB(a.in[13] + 0, 3072, 1024, 1024, WS_WRKV, 1024, 0, 0, mu, 0, 16, 32)
            JOB(a.in[13] + 1024, 3072, 1024, 1024, WS_WRKV, 1024, 1024, 0, mu, 0, 16, 32)
            JOB(a.in[13] + 2048, 3072, 1024, 1024, WS_WRKV, 1024, 2048, 0, mu, 0, 16, 32)
            JOB(a.in[15], 64, 1024, 64, WS_WL1, 2048, 0, 0, mu + 1 * 1024, 1, 16, 4)
            JOB(a.in[15], 64, 1024, 64, WS_WL1, 2048, 0, 1024, mu + 1 * 1024, 2, 16, 4)
            JOB(a.in[18], 64, 1024, 64, WS_WL1, 2048, 128, 0, mu + 4 * 1024, 1, 16, 4)
            JOB(a.in[18], 64, 1024, 64, WS_WL1, 2048, 128, 1024, mu + 4 * 1024, 2, 16, 4)
            JOB(a.in[20], 160, 1024, 160, WS_WL1, 2048, 256, 0, mu + 5 * 1024, 1, 16, 8)
            JOB(a.in[20], 160, 1024, 160, WS_WL1, 2048, 256, 1024, mu + 5 * 1024, 2, 16, 8)
            JOB(a.in[16], 1024, 64, 1024, WS_WL2, 512, 0, 0, mu, 0, 2, 32)
            JOB(a.in[16], 1024, 0, 1024, WS_WL2, 512, 0, 128, mu, 0, 6, 32)
            JOB(a.in[19], 1024, 0, 1024, WS_WL2, 512, 1024, 0, mu, 0, 2, 32)
            JOB(a.in[19], 1024, 64, 1024, WS_WL2, 512, 1024, 128, mu, 0, 2, 32)
            JOB(a.in[19], 1024, 0, 1024, WS_WL2, 512, 1024, 256, mu, 0, 4, 32)
            JOB(a.in[21], 1024, 0, 1024, WS_WL2, 512, 2048, 0, mu, 0, 4, 32)
            JOB(a.in[21], 1024, 160, 1024, WS_WL2, 512, 2048, 256, mu, 0, 4, 32)
            JOB(a.in[27], 1024, 1024, 1024, WS_WOUT1, 1024, 0, 0, mu, 0, 16, 32)
#undef JOB
        }
        bf16_t* wsb = (bf16_t*)(ws + WS_WS);
        for (int e = blockIdx.x * NTHREADS + tid; e < 8 * 128 * 128 / 2; e += gridDim.x * NTHREADS) {
            const int i = e * 2, s = i & 127, t = (i >> 7) & 127;
            const float v0 = (s <= t) ? a.in[9][i] : 0.f, v1 = (s + 1 <= t) ? a.in[9][i + 1] : 0.f;
            ((unsigned*)wsb)[e] = cvt_pk_bf16(v0, v1);
        }
    }
}

__device__ __forceinline__ void phase_norm_mod(const float* x, const float* mod_shift, const float* mod_scale, bf16_t* H, int) {
    const int tid = opaque_tid(), lane = tid & 63, wave = tid >> 6;
    const int gw = blockIdx.x * NWAVES + wave, NGW = gridDim.x * NWAVES;
    constexpr int NR = 4;
    for (int m0 = gw; m0 < M; m0 += NR * NGW) {
        f32x4 v[NR][4];
#pragma unroll
        for (int r = 0; r < NR; ++r) { const int m = M - 1 - (m0 + r * NGW < M ? m0 + r * NGW : m0); const f32x4* xr = (const f32x4*)(x + (size_t)m * D) + lane;
#pragma unroll
            for (int j = 0; j < 4; ++j) v[r][j] = xr[64 * j]; }
#pragma unroll
        for (int r = 0; r < NR; ++r) { const int m = M - 1 - (m0 + r * NGW); if (m >= 0) {
            const int b = m >> 12; float s = 0.f;
#pragma unroll
            for (int j = 0; j < 4; ++j) s += (v[r][j].x * v[r][j].x + v[r][j].y * v[r][j].y) + (v[r][j].z * v[r][j].z + v[r][j].w * v[r][j].w);
            const float rstd = 1.0f / sqrtf(wave_sum(s) * (1.f / D) + 1e-6f);
            const f32x4* sh = (const f32x4*)(mod_shift + (size_t)b * 6144) + lane;
            const f32x4* sc = (const f32x4*)(mod_scale + (size_t)b * 6144) + lane;
            u32x2* o = (u32x2*)(H + (size_t)m * D) + lane;
#pragma unroll
            for (int j = 0; j < 4; ++j) { const f32x4 a = sh[64 * j], c = sc[64 * j]; const f32x4 h = v[r][j] * rstd * (c + 1.0f) + a;
                u32x2 w; w.x = cvt_pk_bf16(h.x, h.y); w.y = cvt_pk_bf16(h.z, h.w); o[64 * j] = w; } } }
    }
}
__device__ __forceinline__ void phase_final_norm(float* x, const float* g) {
    const int tid = opaque_tid(), lane = tid & 63, wave = tid >> 6;
    const int gw = blockIdx.x * NWAVES + wave, NGW = gridDim.x * NWAVES;
    constexpr int NR = 4;
    f32x4 gg[4];
#pragma unroll
    for (int j = 0; j < 4; ++j) gg[j] = ((const f32x4*)g)[lane + 64 * j];
    for (int m0 = gw; m0 < M; m0 += NR * NGW) {
        f32x4 v[NR][4];
#pragma unroll
        for (int r = 0; r < NR; ++r) { const int m = (m0 + r * NGW < M ? m0 + r * NGW : m0); const f32x4* xr = (const f32x4*)(x + (size_t)m * D) + lane;
#pragma unroll
            for (int j = 0; j < 4; ++j) v[r][j] = xr[64 * j]; }
#pragma unroll
        for (int r = 0; r < NR; ++r) { const int m = m0 + r * NGW; if (m < M) {
            float s = 0.f;
#pragma unroll
            for (int j = 0; j < 4; ++j) s += (v[r][j].x * v[r][j].x + v[r][j].y * v[r][j].y) + (v[r][j].z * v[r][j].z + v[r][j].w * v[r][j].w);
            const float rstd = 1.0f / sqrtf(wave_sum(s) * (1.f / D) + 1e-6f);
            f32x4* xr = (f32x4*)(x + (size_t)m * D) + lane;
#pragma unroll
            for (int j = 0; j < 4; ++j) xr[64 * j] = v[r][j] * rstd * gg[j]; } }
    }
}
__device__ __forceinline__ void load_row(const float* x, size_t m, int lane, f32x4 (&v)[4]) {
    const f32x4* xr = (const f32x4*)(x + m * D) + lane;
#pragma unroll
    for (int j = 0; j < 4; ++j) v[j] = xr[64 * j];
}
__device__ __forceinline__ void finish_row(f32x4 (&h)[4], const f32x4 (&sh)[4], const f32x4 (&sc1)[4]) {
    float s = 0.f;
#pragma unroll
    for (int j = 0; j < 4; ++j) s += (h[j].x * h[j].x + h[j].y * h[j].y) + (h[j].z * h[j].z + h[j].w * h[j].w);
    const float rstd = 1.0f / sqrtf(wave_sum(s) * (1.f / D) + 1e-6f);
#pragma unroll
    for (int j = 0; j < 4; ++j) h[j] = h[j] * rstd * sc1[j] + sh[j];
}
__device__ __forceinline__ void phase_norm_shift(const float* x, const float* mod_shift, const float* mod_scale, const float* mu, bf16_t* X3, bf16_t* H2) {
    const int tid = opaque_tid(), lane = tid & 63, wave = tid >> 6;
    const int gw = blockIdx.x * NWAVES + wave, NGW = gridDim.x * NWAVES;
    f32x4 mr[4], mk[4], mv[4];
#pragma unroll
    for (int j = 0; j < 4; ++j) { mr[j] = ((const f32x4*)(mu + 0 * 1024))[lane + 64 * j]; mk[j] = ((const f32x4*)(mu + 2 * 1024))[lane + 64 * j]; mv[j] = ((const f32x4*)(mu + 3 * 1024))[lane + 64 * j]; }
    for (int blk = gw; blk < M / 32; blk += NGW) {
        const size_t m0 = (size_t)blk * 32; const int b = (int)(m0 >> 12);
        f32x4 sh[4], sc1[4];
#pragma unroll
        for (int j = 0; j < 4; ++j) { sh[j] = ((const f32x4*)(mod_shift + (size_t)b * 6144))[lane + 64 * j]; sc1[j] = ((const f32x4*)(mod_scale + (size_t)b * 6144))[lane + 64 * j] + 1.0f; }
        f32x4 hp[4], h[4], n1[4], n2[4];
        const bool first = (m0 & 4095) == 0;
        load_row(x, first ? m0 : m0 - 1, lane, hp); load_row(x, m0, lane, h); load_row(x, m0 + 1, lane, n1);
        finish_row(hp, sh, sc1);
        if (first) {
#pragma unroll
            for (int j = 0; j < 4; ++j) hp[j] = (f32x4){0.f, 0.f, 0.f, 0.f}; }
        for (int i = 0; i < 32; ++i) {
            const size_t m = m0 + i;
            load_row(x, (i + 2 < 32) ? m + 2 : m, lane, n2);
            finish_row(h, sh, sc1);
            u32x2* o2 = (u32x2*)(H2 + (m + b + 1) * D) + lane;
            u32x2* or_ = (u32x2*)(X3 + m * D) + lane;
#pragma unroll
            for (int j = 0; j < 4; ++j) {
                const f32x4 d = hp[j] - h[j];
                const f32x4 xr = h[j] + d * mr[j], xk = h[j] + d * mk[j], xv = h[j] + d * mv[j];
                u32x2 w; w.x = cvt_pk_bf16(h[j].x, h[j].y); w.y = cvt_pk_bf16(h[j].z, h[j].w); o2[64 * j] = w;
                if (first && i == 0) o2[64 * j - D / 4] = (u32x2){0u, 0u};
                w.x = cvt_pk_bf16(xr.x, xr.y); w.y = cvt_pk_bf16(xr.z, xr.w); or_[64 * j] = w;
                w.x = cvt_pk_bf16(xk.x, xk.y); w.y = cvt_pk_bf16(xk.z, xk.w); or_[64 * j + (size_t)M * D / 4] = w;
                w.x = cvt_pk_bf16(xv.x, xv.y); w.y = cvt_pk_bf16(xv.z, xv.w); or_[64 * j + 2 * (size_t)M * D / 4] = w;
                hp[j] = h[j]; h[j] = n1[j]; n1[j] = n2[j];
            }
        }
    }
}

__device__ __forceinline__ void phase_sgu(const Args& a, LAS unsigned char* lds) {
    const int tid = opaque_tid(), lane = tid & 63, wave = tid >> 6, fr = lane & 15, fq = lane >> 4;
    const bf16_t* UV = (const bf16_t*)(a.ws + WS_UV); bf16_t* Z = (bf16_t*)(a.ws + WS_Z);
    const bf16_t* WSB = (const bf16_t*)(a.ws + WS_WS);
    const float* lng = a.in[7]; const float* lnb = a.in[8]; const float* bs = a.in[10];
    constexpr int RS = 272;
    LAS unsigned char* Wl = lds;
    LAS unsigned char* Vl = lds + 128 * RS;
    LAS f32x2* st = (LAS f32x2*)(lds + 2 * 128 * RS);
    const int wt = wave >> 2, wd = wave & 3;
    for (int tile_ = blockIdx.x; tile_ < M / 128; tile_ += gridDim.x) {
        const int tile = M / 128 - 1 - tile_;
        const size_t m0 = (size_t)tile * 128;
        for (int r = wave * 16; r < wave * 16 + 16; ++r) {
            const u32x4* p = (const u32x4*)(UV + (m0 + r) * 2048 + 1024) + lane;
            const u32x4 q0 = p[0], q1 = p[64];
            float f[16];
            f[0] = bf_lo(q0.x); f[1] = bf_hi(q0.x); f[2] = bf_lo(q0.y); f[3] = bf_hi(q0.y); f[4] = bf_lo(q0.z); f[5] = bf_hi(q0.z); f[6] = bf_lo(q0.w); f[7] = bf_hi(q0.w);
            f[8] = bf_lo(q1.x); f[9] = bf_hi(q1.x); f[10] = bf_lo(q1.y); f[11] = bf_hi(q1.y); f[12] = bf_lo(q1.z); f[13] = bf_hi(q1.z); f[14] = bf_lo(q1.w); f[15] = bf_hi(q1.w);
            float s = 0.f;
#pragma unroll
            for (int e = 0; e < 16; ++e) s += f[e];
            const float mean = wave_sum(s) * (1.f / 1024.f);
            float q = 0.f;
#pragma unroll
            for (int e = 0; e < 16; ++e) { const float d = f[e] - mean; q += d * d; }
            const float var = wave_sum(q) * (1.f / 1024.f);
            if (lane == 0) st[r] = (f32x2){mean, 1.0f / sqrtf(var + 1e-5f)};
        }
        __syncthreads();
        for (int g = 0; g < 8; ++g) {
            {
                const u32x4* src = (const u32x4*)(WSB + (size_t)g * 128 * 128);
#pragma unroll
                for (int i = 0; i < 4; ++i) { const int idx = tid + i * NTHREADS; const int t = idx >> 4, c = idx & 15;
                    *(LAS u32x4*)(Wl + t * RS + c * 16) = src[idx]; }
            }
            {
                const int sp = tid & 63, dq = tid >> 6, s0 = 2 * sp, d0 = dq * 16;
                const f32x2 st0 = st[s0], st1 = st[s0 + 1];
                const bf16_t* p0 = UV + (m0 + s0) * 2048 + 1024 + g * 128 + d0;
                const u32x4 a0 = *(const u32x4*)p0, a1 = *(const u32x4*)(p0 + 8), b0 = *(const u32x4*)(p0 + 2048), b1 = *(const u32x4*)(p0 + 2048 + 8);
                const unsigned ua[8] = {a0.x, a0.y, a0.z, a0.w, a1.x, a1.y, a1.z, a1.w}, ub[8] = {b0.x, b0.y, b0.z, b0.w, b1.x, b1.y, b1.z, b1.w};
                const float* gp = lng + g * 128 + d0; const float* bp = lnb + g * 128 + d0;
#pragma unroll
                for (int e = 0; e < 8; ++e) {
                    const float g0 = gp[2 * e], g1 = gp[2 * e + 1], c0 = bp[2 * e], c1 = bp[2 * e + 1];
                    const float x00 = (bf_lo(ua[e]) - st0.x) * st0.y * g0 + c0, x01 = (bf_hi(ua[e]) - st0.x) * st0.y * g1 + c1;
                    const float x10 = (bf_lo(ub[e]) - st1.x) * st1.y * g0 + c0, x11 = (bf_hi(ub[e]) - st1.x) * st1.y * g1 + c1;
                    *(LAS unsigned*)(Vl + (d0 + 2 * e) * RS + s0 * 2) = cvt_pk_bf16(x00, x10);
                    *(LAS unsigned*)(Vl + (d0 + 2 * e + 1) * RS + s0 * 2) = cvt_pk_bf16(x01, x11);
                }
            }
            __syncthreads();
            f32x4 acc[4][2];
#pragma unroll
            for (int mi = 0; mi < 4; ++mi)
#pragma unroll
                for (int ni = 0; ni < 2; ++ni) acc[mi][ni] = (f32x4){0.f, 0.f, 0.f, 0.f};
#pragma unroll
            for (int ks = 0; ks < 4; ++ks) {
                if (ks * 32 <= 64 * wt + 63) {
                    bf16x8 bfr[2];
#pragma unroll
                    for (int ni = 0; ni < 2; ++ni) bfr[ni] = *(const LAS bf16x8*)(Vl + (32 * wd + 16 * ni + fr) * RS + (ks * 32 + fq * 8) * 2);
#pragma unroll
                    for (int mi = 0; mi < 4; ++mi) {
                        if (ks * 32 <= 64 * wt + 16 * mi + 15) {
                            const bf16x8 afr = *(const LAS bf16x8*)(Wl + (64 * wt + 16 * mi + fr) * RS + (ks * 32 + fq * 8) * 2);
#pragma unroll
                            for (int ni = 0; ni < 2; ++ni) acc[mi][ni] = __builtin_amdgcn_mfma_f32_16x16x32_bf16(bfr[ni], afr, acc[mi][ni], 0, 0, 0);
                        }
                    }
                }
            }
#pragma unroll
            for (int mi = 0; mi < 4; ++mi) {
                const int t = 64 * wt + 16 * mi + fr; const float bias = bs[g * 128 + t];
#pragma unroll
                for (int ni = 0; ni < 2; ++ni) {
                    const int col = g * 128 + 32 * wd + 16 * ni + 4 * fq;
                    const u32x2 uu = *(const u32x2*)(UV + (m0 + t) * 2048 + col);
                    const f32x4 sv = acc[mi][ni];
                    u32x2 o; o.x = cvt_pk_bf16(bf_lo(uu.x) * (sv[0] + bias), bf_hi(uu.x) * (sv[1] + bias)); o.y = cvt_pk_bf16(bf_lo(uu.y) * (sv[2] + bias), bf_hi(uu.y) * (sv[3] + bias));
                    *(u32x2*)(Z + (m0 + t) * 1024 + col) = o;
                }
            }
            __syncthreads();
        }
    }
}

__device__ __forceinline__ float fma_(float a, float b, float c) { float d; asm("v_fma_f32 %0, %1, %2, %3" : "=v"(d) : "v"(a), "v"(b), "v"(c)); return d; }
__device__ __forceinline__ float mul_(float a, float b) { float d; asm("v_mul_f32 %0, %1, %2" : "=v"(d) : "v"(a), "v"(b)); return d; }
__device__ __forceinline__ float dot4_(const f32x4& s, const f32x4& o) { return fma_(s.w, o.w, fma_(s.z, o.z, fma_(s.y, o.y, mul_(s.x, o.x)))); }
__device__ __forceinline__ void upd4_(f32x4& s, const f32x4& w, const f32x4& b, const f32x4& k, float sa, float v) {
    s.x = fma_(v, k.x, fma_(sa, b.x, mul_(s.x, w.x))); s.y = fma_(v, k.y, fma_(sa, b.y, mul_(s.y, w.y)));
    s.z = fma_(v, k.z, fma_(sa, b.z, mul_(s.z, w.z))); s.w = fma_(v, k.w, fma_(sa, b.w, mul_(s.w, w.w)));
}
__device__ __forceinline__ f32x2 pkmul_(f32x2 a, f32x2 b) { f32x2 d; asm("v_pk_mul_f32 %0, %1, %2" : "=v"(d) : "v"(a), "v"(b)); return d; }
__device__ __forceinline__ f32x2 pkfma_(f32x2 a, f32x2 b, f32x2 c) { f32x2 d; asm("v_pk_fma_f32 %0, %1, %2, %3" : "=v"(d) : "v"(a), "v"(b), "v"(c)); return d; }
__device__ __forceinline__ f32x2 pkfma_lo_(f32x2 a, f32x2 b, f32x2 c) { f32x2 d; asm("v_pk_fma_f32 %0, %1, %2, %3 op_sel_hi:[0,1,1]" : "=v"(d) : "v"(a), "v"(b), "v"(c)); return d; }
__device__ __forceinline__ f32x2 pkfma_hi_(f32x2 a, f32x2 b, f32x2 c) { f32x2 d; asm("v_pk_fma_f32 %0, %1, %2, %3 op_sel:[1,0,0]" : "=v"(d) : "v"(a), "v"(b), "v"(c)); return d; }
__device__ __forceinline__ float add_(float a, float b) { float d; asm("v_add_f32 %0, %1, %2" : "=v"(d) : "v"(a), "v"(b)); return d; }
#define LO2(v) __builtin_shufflevector(v, v, 0, 1)
#define HI2(v) __builtin_shufflevector(v, v, 2, 3)
__device__ __forceinline__ void phase_scan(const Args& a, LAS unsigned char* lds) {
    const int tid = opaque_tid(), lane = tid & 63, wave = tid >> 6;
    constexpr int TC = 32;
    LAS float* op = (LAS float*)lds;
    LAS float* vb = (LAS float*)(lds + (TC + 1) * 1280);
    LAS float* yb = (LAS float*)(lds + (TC + 1) * 1280 + (TC + 1) * 256);
    const bf16_t* Rg = (const bf16_t*)(a.ws + WS_R); const bf16_t* Kg = (const bf16_t*)(a.ws + WS_K); const bf16_t* Vg = (const bf16_t*)(a.ws + WS_V);
    const bf16_t* Lg = (const bf16_t*)(a.ws + WS_L); const bf16_t* WL2 = (const bf16_t*)(a.ws + WS_WL2);
    constexpr int XS = 68;
    LAS float* xb = (LAS float*)(lds + (TC + 1) * 1280 + (TC + 1) * 256 + TC * 1024);
    const int fr = lane & 15, fq = lane >> 4, stile = wave >> 2, ntile = wave & 3;
    bf16_t* YG = (bf16_t*)(a.ws + WS_YG);
    const int ts = tid >> 4, jg = tid & 15;
    const int ig = lane >> 4;
    const int r0 = wave * 8 + ig * 2;
    for (int hd = blockIdx.x; hd < NB * 16; hd += gridDim.x) {
        const int b = hd >> 4, h = hd & 15;
        const int ch = h * 64 + jg * 4;
        const f32x4 kk4 = *(const f32x4*)(a.in[22] + ch), ka4 = *(const f32x4*)(a.in[23] + ch), rk4 = *(const f32x4*)(a.in[24] + ch);
        const f32x4 lg4 = *(const f32x4*)(a.in[25] + ch), lb4 = *(const f32x4*)(a.in[26] + ch);
        const size_t base = ((size_t)b * T) * D + ch;
        f32x2 S0a = {0.f, 0.f}, S0b = {0.f, 0.f}, S1a = {0.f, 0.f}, S1b = {0.f, 0.f};
        size_t off = base + (size_t)ts * D;
        u32x2 pr = *(const u32x2*)(Rg + off), pk = *(const u32x2*)(Kg + off), pv = *(const u32x2*)(Vg + off);
        const int chn = h * 64 + ntile * 16 + fr;
        bf16x8 bw[2], ba[2], bg[5];
#pragma unroll
        for (int ks = 0; ks < 2; ++ks) { bw[ks] = *(const bf16x8*)(WL2 + (size_t)chn * 512 + ks * 32 + fq * 8); ba[ks] = *(const bf16x8*)(WL2 + (size_t)(1024 + chn) * 512 + 128 + ks * 32 + fq * 8); }
#pragma unroll
        for (int ks = 0; ks < 5; ++ks) bg[ks] = *(const bf16x8*)(WL2 + (size_t)(2048 + chn) * 512 + 256 + ks * 32 + fq * 8);
        const float w0c = a.in[14][chn], a0c = a.in[17][chn];
        bf16x8 aw[2], aa[2], ag[5];
#define LORA_LOAD(cc) do { const bf16_t* lrow = Lg + ((size_t)b * T + (size_t)(cc) * TC + stile * 16 + fr) * 512 + fq * 8; \
            _Pragma("unroll") for (int ks = 0; ks < 2; ++ks) { aw[ks] = *(const bf16x8*)(lrow + ks * 32); aa[ks] = *(const bf16x8*)(lrow + 128 + ks * 32); } \
            _Pragma("unroll") for (int ks = 0; ks < 5; ++ks) ag[ks] = *(const bf16x8*)(lrow + 256 + ks * 32); } while (0)
#define LORA_RUN() do { f32x4 cw = {0.f, 0.f, 0.f, 0.f}, ca = {0.f, 0.f, 0.f, 0.f}, cg_ = {0.f, 0.f, 0.f, 0.f}; \
            _Pragma("unroll") for (int ks = 0; ks < 2; ++ks) { cw = __builtin_amdgcn_mfma_f32_16x16x32_bf16(aw[ks], bw[ks], cw, 0, 0, 0); ca = __builtin_amdgcn_mfma_f32_16x16x32_bf16(aa[ks], ba[ks], ca, 0, 0, 0); } \
            _Pragma("unroll") for (int ks = 0; ks < 5; ++ks) cg_ = __builtin_amdgcn_mfma_f32_16x16x32_bf16(ag[ks], bg[ks], cg_, 0, 0, 0); \
            _Pragma("unroll") for (int e = 0; e < 4; ++e) { const int xi = (stile * 16 + 4 * fq + e) * XS + ntile * 16 + fr; \
                xb[xi] = __builtin_amdgcn_exp2f(-0.87503988f * __builtin_amdgcn_rcpf(1.0f + __expf(-(w0c + cw[e])))); \
                xb[TC * XS + xi] = __builtin_amdgcn_rcpf(1.0f + __expf(-(a0c + ca[e]))); \
                xb[2 * TC * XS + xi] = cg_[e]; } } while (0)
        LORA_LOAD(0); LORA_RUN();
        __syncthreads();
        u32x2 ypend = {0u, 0u};
        for (int c = 0; c < T / TC; ++c) {
            const f32x4 r4 = {bf_lo(pr.x), bf_hi(pr.x), bf_lo(pr.y), bf_hi(pr.y)};
            const f32x4 k4 = {bf_lo(pk.x), bf_hi(pk.x), bf_lo(pk.y), bf_hi(pk.y)};
            const f32x4 v4 = {bf_lo(pv.x), bf_hi(pv.x), bf_lo(pv.y), bf_hi(pv.y)};
            const f32x4 w4 = *(const LAS f32x4*)(xb + ts * XS + jg * 4), a4 = *(const LAS f32x4*)(xb + TC * XS + ts * XS + jg * 4), g4 = *(const LAS f32x4*)(xb + 2 * TC * XS + ts * XS + jg * 4);
            const f32x4 kkx = k4 * kk4;
            const float ss = reduce16((kkx.x * kkx.x + kkx.y * kkx.y) + (kkx.z * kkx.z + kkx.w * kkx.w));
            const float inv = __builtin_amdgcn_rsqf(fmaxf(ss, 1e-24f));
            const f32x4 kk = kkx * inv;
            const f32x4 kf = k4 * ((a4 - 1.0f) * ka4 + 1.0f);
            const f32x4 am = -kk, bm = kk * a4;
            const f32x4 rkr = r4 * kf * rk4;
            const float ct = reduce16((rkr.x + rkr.y) + (rkr.z + rkr.w));
            {
                LAS f32x4* o = (LAS f32x4*)(op + (ts * 16 + jg) * 20);
                o[0] = w4; o[1] = am; o[2] = bm; o[3] = kf; o[4] = r4;
                *(LAS f32x4*)(vb + ts * 64 + jg * 4) = v4;
            }
            __syncthreads();
            if (c > 0) *(u32x2*)(YG + base + (size_t)((c - 1) * TC + ts) * D) = ypend;
            if (c + 1 < T / TC) { off = base + (size_t)((c + 1) * TC + ts) * D;
                pr = *(const u32x2*)(Rg + off); pk = *(const u32x2*)(Kg + off); pv = *(const u32x2*)(Vg + off);
                LORA_LOAD(c + 1); }
            {
                const LAS float* obase = op + (lane & 15) * 20;
                const LAS float* vbase = vb + r0;
                f32x4 ow = *(const LAS f32x4*)(obase), oa = *(const LAS f32x4*)(obase + 4), ob = *(const LAS f32x4*)(obase + 8), ok = *(const LAS f32x4*)(obase + 12), orr = *(const LAS f32x4*)(obase + 16);
                f32x2 vv = *(const LAS f32x2*)(vbase);
#pragma unroll 2
                for (int s = 0; s < TC; ++s) {
                    const LAS float* o = obase + (s + 1) * 320;
                    const f32x4 now = *(const LAS f32x4*)(o), noa = *(const LAS f32x4*)(o + 4), nob = *(const LAS f32x4*)(o + 8), nok = *(const LAS f32x4*)(o + 12), norr = *(const LAS f32x4*)(o + 16);
                    const f32x2 nvv = *(const LAS f32x2*)(vbase + (s + 1) * 64);
                    const f32x2 p0 = pkfma_(S0b, HI2(oa), pkmul_(S0a, LO2(oa))), p1 = pkfma_(S1b, HI2(oa), pkmul_(S1a, LO2(oa)));
                    float sa0 = add_(p0.x, p0.y), sa1 = add_(p1.x, p1.y);
                    sa0 = reduce16(sa0); asm volatile("" : "+v"(sa0)); sa1 = reduce16(sa1);
                    const f32x2 sap = {sa0, sa1};
                    S0a = pkfma_lo_(vv, LO2(ok), pkfma_lo_(sap, LO2(ob), pkmul_(S0a, LO2(ow))));
                    S0b = pkfma_lo_(vv, HI2(ok), pkfma_lo_(sap, HI2(ob), pkmul_(S0b, HI2(ow))));
                    S1a = pkfma_hi_(vv, LO2(ok), pkfma_hi_(sap, LO2(ob), pkmul_(S1a, LO2(ow))));
                    S1b = pkfma_hi_(vv, HI2(ok), pkfma_hi_(sap, HI2(ob), pkmul_(S1b, HI2(ow))));
                    const f32x2 q0 = pkfma_(S0b, HI2(orr), pkmul_(S0a, LO2(orr))), q1 = pkfma_(S1b, HI2(orr), pkmul_(S1a, LO2(orr)));
                    float y0 = add_(q0.x, q0.y), y1 = add_(q1.x, q1.y);
                    y0 += dppf<0xB1>(y0); y1 += dppf<0xB1>(y1); y0 += dppf<0x4E>(y0); y1 += dppf<0x4E>(y1);
                    *(LAS f32x2*)(yb + ((s * 32 + (r0 >> 1)) * 4 + ((lane >> 2) & 3)) * 2) = (f32x2){y0, y1};
                    ow = now; oa = noa; ob = nob; ok = nok; orr = norr; vv = nvv;
                }
            }
            __syncthreads();
            {
                const LAS f32x4* yq = (const LAS f32x4*)(yb + (ts * 32 + 2 * jg) * 8);
                const f32x4 A0 = yq[0], A1 = yq[1], B0 = yq[2], B1 = yq[3];
                const f32x4 y4 = {(A0.x + A0.z) + (A1.x + A1.z), (A0.y + A0.w) + (A1.y + A1.w), (B0.x + B0.z) + (B1.x + B1.z), (B0.y + B0.w) + (B1.y + B1.w)};
                const float mean = reduce16((y4.x + y4.y) + (y4.z + y4.w)) * (1.f / 64.f);
                const f32x4 d = y4 - mean;
                const float var = reduce16((d.x * d.x + d.y * d.y) + (d.z * d.z + d.w * d.w)) * (1.f / 64.f);
                const float rstd = __builtin_amdgcn_rsqf(var + 64e-5f);
                const f32x4 o = ((d * rstd) * lg4 + lb4 + v4 * ct) * g4;
                u32x2 w; w.x = cvt_pk_bf16(o.x, o.y); w.y = cvt_pk_bf16(o.z, o.w);
                ypend = w;
            }
            if (c + 1 < T / TC) LORA_RUN();
            __syncthreads();
        }
        *(u32x2*)(YG + base + (size_t)((T / TC - 1) * TC + ts) * D) = ypend;
#undef LORA_LOAD
#undef LORA_RUN
    }
}


#define SEAM() do { ++ph; if (lo < ph && ph < hi) { if (ph == 1) gsync(grid); else xcd_barrier(xbar); } } while (0)
#define RUN (lo <= ph && ph < hi)
template <int l> __device__ __forceinline__ void layer(const Args& a, LAS unsigned char* lds, cg::grid_group& grid, const XcdBarrier& xbar, int& ph, const int lo, const int hi) {
    unsigned char* ws = a.ws;
    const float* MOD = (const float*)(ws + WS_MOD);
    bf16_t* H = (bf16_t*)(ws + WS_H);
    const int G = gridDim.x, c = blockIdx.x;
    const float* mod = MOD + (size_t)l * 16 * 6144;
    const float* xin = (l == 0) ? a.in[0] : a.out;
    if (RUN) {
        if (l == 1) phase_norm_shift(xin, mod + 0 * 1024, mod + 1 * 1024, a.in[12], (bf16_t*)(ws + WS_X3), (bf16_t*)(ws + WS_H2));
        else if ((threadIdx.x >> 6) < 4) { phase_norm_mod(xin, mod + 0 * 1024, mod + 1 * 1024, H, 0); phase_weights(a, lds); }
        else { phase_weights(a, lds); phase_norm_mod(xin, mod + 0 * 1024, mod + 1 * 1024, H, 0); }
    }
    SEAM();
    if (l == 0) {
        if (RUN) { pg8::Gemm g{H, (const bf16_t*)(ws + WS_WIN0), M, 2048, 1024, 0, 0}; pg8::StaticOrder S; S.init(M, 2048, G, c);
          pg8::EpiAct<1> E{(bf16_t*)(ws + WS_UV), 2048}; pg8::gemm_phase(lds, g, S, E); }
        SEAM();
        if (RUN) phase_sgu(a, lds);
        SEAM();
        if (RUN) { pg8::Gemm g{(const bf16_t*)(ws + WS_Z), (const bf16_t*)(ws + WS_WOUT0), M, 1024, 1024, 0, 0}; pg8::StaticOrder S; S.init(M, 1024, G, c);
          pg8::EpiRes E{a.in[0], a.out, mod + 2 * 1024, 6144}; pg8::gemm_phase(lds, g, S, E); }
    } else {
        if (RUN) {
          { pg8::Gemm g{(const bf16_t*)(ws + WS_H2), (const bf16_t*)(ws + WS_WL1), M, 512, 2048, 0, 1}; pg8::StaticOrder S; S.init(M, 512, G, c, 1);
            pg8::EpiRkvL E{(bf16_t*)(ws + WS_R), (size_t)(WS_K - WS_R) / 2, (bf16_t*)(ws + WS_L), 12}; pg8::gemm_phase(lds, g, S, E); }
          { pg8::Gemm g{(const bf16_t*)(ws + WS_X3), (const bf16_t*)(ws + WS_WRKV), M, 3072, 1024, (long)M * D, 0}; pg8::StaticOrder S; S.init(M, 3072, G, c, 1);
            pg8::EpiRkvL E{(bf16_t*)(ws + WS_R), (size_t)(WS_K - WS_R) / 2, (bf16_t*)(ws + WS_L), 0}; pg8::gemm_phase(lds, g, S, E); }
        }
        SEAM();
        if (RUN) phase_scan(a, lds);
        SEAM();
        if (RUN) { pg8::Gemm g{(const bf16_t*)(ws + WS_YG), (const bf16_t*)(ws + WS_WOUT1), M, 1024, 1024, 0, 0}; pg8::StaticOrder S; S.init(M, 1024, G, c);
          pg8::EpiRes E{a.out, a.out, mod + 2 * 1024, 6144}; pg8::gemm_phase(lds, g, S, E); }
    }
    SEAM();
    if (RUN) phase_norm_mod(a.out, mod + 3 * 1024, mod + 4 * 1024, H, 0);
    SEAM();
    if (RUN) { pg8::Gemm g{H, (const bf16_t*)(ws + WS_W1 + (size_t)l * 4096 * 1024 * 2), M, 4096, 1024, 0, 0}; pg8::StaticOrder S; S.init(M, 4096, G, c);
      pg8::EpiAct<2> E{(bf16_t*)(ws + WS_HID), 4096}; pg8::gemm_phase(lds, g, S, E); }
    SEAM();
    if (RUN) { pg8::Gemm g{(const bf16_t*)(ws + WS_HID), (const bf16_t*)(ws + WS_W2 + (size_t)l * 1024 * 4096 * 2), M, 1024, 4096, 0, 0}; pg8::StaticOrder S; S.init(M, 1024, G, c, 1);
      pg8::EpiRes E{a.out, a.out, mod + 5 * 1024, 6144}; pg8::gemm_phase(lds, g, S, E); }
    SEAM();
}
constexpr int NPHASES = 16;

__global__ void __launch_bounds__(NTHREADS, 2) fwd_megakernel(Args a) {
    extern __shared__ __attribute__((aligned(16))) unsigned char lds_raw[];
    LAS unsigned char* lds = (LAS unsigned char*)lds_raw;
    cg::grid_group grid = cg::this_grid();
    const int lo = a.lo, hi = a.hi;
    int ph = 0;
    volatile LAS unsigned* bst = (volatile LAS unsigned*)(lds + 131072 + 512);
    if (threadIdx.x < 2) bst[threadIdx.x] = 0u;
    __syncthreads();
    XcdBarrier xbar; xbar.bar = (unsigned*)a.ws; xbar.x = 0; xbar.st = nullptr;
    if (hi - lo > 1) xbar = xcd_barrier_post((unsigned*)a.ws, bst);
    if (RUN) phase_prep(a, lds);
    SEAM();
    layer<0>(a, lds, grid, xbar, ph, lo, hi);
    layer<1>(a, lds, grid, xbar, ph, lo, hi);
    if (RUN) phase_final_norm(a.out, a.in[28]);
}
#ifndef N_LAUNCHES
#define N_LAUNCHES 1
#endif

extern "C" void kernel_launch(void* const* d_in, const int* in_sizes, int n_in, void* d_out, int out_size, void* d_ws, size_t ws_size, hipStream_t stream) {
    static int grid = 0;
    if (grid == 0) {
        if (n_in != 29 || out_size != M * D || ws_size < WS_END) { fprintf(stderr, "kernel_launch: unexpected problem: n_in %d out %d ws %zu (need %zu)\n", n_in, out_size, ws_size, (size_t)WS_END); grid = -1; return; }
        int dev = 0, cus = 0, per_cu = 0;
        hipGetDevice(&dev);
        hipDeviceGetAttribute(&cus, hipDeviceAttributeMultiprocessorCount, dev);
        if (hipFuncSetAttribute((const void*)fwd_megakernel, hipFuncAttributeMaxDynamicSharedMemorySize, LDS_BYTES) != hipSuccess) { fprintf(stderr, "kernel_launch: hipFuncSetAttribute failed\n"); grid = -1; return; }
        if (hipOccupancyMaxActiveBlocksPerMultiprocessor(&per_cu, (const void*)fwd_megakernel, NTHREADS, LDS_BYTES) != hipSuccess || per_cu < 1) { fprintf(stderr, "kernel_launch: occupancy query says %d blocks/CU\n", per_cu); per_cu = 1; }
        (void)hipGetLastError();
        grid = cus;
    }
    if (grid < 0) return;
    Args a{};
    for (int i = 0; i < 29; ++i) a.in[i] = (const float*)d_in[i];
    a.out = (float*)d_out; a.ws = (unsigned char*)d_ws;
    if (N_LAUNCHES == 1) {
        if (hipMemsetAsync(d_ws, 0, 16384, stream) != hipSuccess) { fprintf(stderr, "kernel_launch: memset of the barrier words failed\n"); return; }
        a.lo = 0; a.hi = NPHASES;
        void* args[] = {&a};
        hipError_t e = hipLaunchCooperativeKernel((const void*)fwd_megakernel, dim3(grid), dim3(NTHREADS), args, LDS_BYTES, stream);
        if (e != hipSuccess) fprintf(stderr, "kernel_launch: cooperative launch failed: %s (grid %d)\n", hipGetErrorString(e), grid);
    } else {
        for (int p = 0; p < NPHASES; ++p) { a.lo = p; a.hi = p + 1;
            hipLaunchKernelGGL(fwd_megakernel, dim3(grid), dim3(NTHREADS), LDS_BYTES, stream, a); }
    }
}
```

```cpp
#include <hip/hip_runtime.h>
#include <hip/hip_cooperative_groups.h>
#include <cstdio>
#include <cstdint>
namespace cg = cooperative_groups;

#define LAS __attribute__((address_space(3)))
typedef unsigned short bf16_t;
typedef short bf16x8 __attribute__((ext_vector_type(8)));
typedef float f32x4 __attribute__((ext_vector_type(4)));
typedef float f32x2 __attribute__((ext_vector_type(2)));
typedef unsigned u32x4 __attribute__((ext_vector_type(4)));
typedef unsigned u32x2 __attribute__((ext_vector_type(2)));

constexpr int D = 1024, NB = 16, T = 4096, M = NB * T, FF = 4096, NMOD = 6;
constexpr int NTHREADS = 512, NWAVES = 8;

__device__ __forceinline__ int opaque_tid() { int t = threadIdx.x; asm volatile("" : "+v"(t)); return t; }
__device__ __forceinline__ unsigned cvt_pk_bf16(float lo, float hi) { unsigned r; asm volatile("v_cvt_pk_bf16_f32 %0, %1, %2" : "=v"(r) : "v"(lo), "v"(hi)); return r; }
__device__ __forceinline__ float bf_lo(unsigned u) { return __builtin_bit_cast(float, u << 16); }
__device__ __forceinline__ float bf_hi(unsigned u) { return __builtin_bit_cast(float, u & 0xffff0000u); }
__device__ __forceinline__ float sigmoidf_(float x) { return __builtin_amdgcn_rcpf(1.0f + __expf(-x)); }

namespace pg8 {
constexpr int BM = 256, BK = 64, HALF = 128, HTB = HALF * BK * 2, STAGE_BYTES = 8 * HTB, NXCD = 8, WGM = 8;
__host__ __device__ __forceinline__ int lds_byte(int r, int c) { const int st = (r >> 4) * 2 + (c >> 5), rr = r & 15, cc = c & 31, ob = rr * 64 + cc * 2; return st * 1024 + (ob ^ (((ob >> 9) & 1) << 5)); }
__host__ __device__ __forceinline__ void stage_rc(int b, int& R, int& C) { const int st = b / 1024, sb = b % 1024, swz = sb ^ (((sb >> 9) & 1) << 5); R = (st >> 1) * 16 + swz / 64; C = (st & 1) * 32 + (swz % 64) / 2; }
__host__ __device__ __forceinline__ int perm32(int rho) { const int n = rho >> 4, i = rho & 15; return 8 * (i >> 2) + 4 * n + (i & 3); }

struct Unit { int pm, pn; };
struct Gemm { const bf16_t* A; const bf16_t* Bt; int M, N, K; long asplit; int shift; };

struct StaticOrder {
    int nM, nN, nwg, G, c, rev;
    __device__ void init(int M_, int N_, int G_, int c_, int rev_ = 0) { nM = M_ / BM; nN = N_ / BM; nwg = nM * nN; G = G_; c = c_; rev = rev_; }
    __device__ bool next(int i, Unit& u) const {
        const long L = (long)i * G + c; if (L >= nwg) return false;
        int wgid = (int)L; { const int q = nwg / NXCD, r = nwg % NXCD, xcd = wgid % NXCD, off = wgid / NXCD; wgid = (xcd < r ? xcd * (q + 1) : r * (q + 1) + (xcd - r) * q) + off; }
        const int nig = WGM * nN, gid = wgid / nig, fm = gid * WGM, gsz = (nM - fm) < WGM ? (nM - fm) : WGM;
        u.pm = fm + ((wgid % nig) % gsz); u.pn = (wgid % nig) / gsz; if (rev) u.pm = nM - 1 - u.pm; return true;
    }
};

__device__ __forceinline__ f32x2 gelu_pk(f32x2 v) {
    const f32x2 av = __builtin_elementwise_abs(v), d = av * 0.2316418882f + 1.0f;
    f32x2 t; t.x = __builtin_amdgcn_rcpf(d.x); t.y = __builtin_amdgcn_rcpf(d.y);
    f32x2 q = t * 0.5307027145f + (-0.7265760135f); q = q * t + 0.7107068705f; q = q * t + (-0.142248368f); q = q * t + 0.127414796f; q = q * t;
    const f32x2 s = (v * v) * (-0.72134752044f);
    f32x2 e; e.x = __builtin_amdgcn_exp2f(s.x); e.y = __builtin_amdgcn_exp2f(s.y);
    const f32x2 m = v * (q * e), r = v - m;
    f32x2 o; o.x = v.x < 0.f ? m.x : r.x; o.y = v.y < 0.f ? m.y : r.y; return o;
}

template <int ACT  > struct EpiAct {
    static constexpr bool PERM = true;
    bf16_t* O; int ldc;
    __device__ __forceinline__ void operator()(const f32x4 (&acc)[2][2][4][2], const Unit& u, int wr, int wc, int fr, int fq) const {
        const int row0 = u.pm * BM + wr * 64 + fr; const int col0 = u.pn * BM + wc * 32 + 8 * fq;
#pragma unroll
        for (int ai = 0; ai < 2; ++ai)
#pragma unroll
            for (int m = 0; m < 4; ++m) { bf16_t* rowp = O + (size_t)(row0 + ai * HALF + m * 16) * ldc + col0;
#pragma unroll
                for (int bj = 0; bj < 2; ++bj) { f32x4 v0 = acc[ai][bj][m][0], v1 = acc[ai][bj][m][1];
                    if (ACT == 1) { f32x2 a = gelu_pk((f32x2){v0[0], v0[1]}), b = gelu_pk((f32x2){v0[2], v0[3]}), c = gelu_pk((f32x2){v1[0], v1[1]}), d = gelu_pk((f32x2){v1[2], v1[3]});
                        v0 = (f32x4){a.x, a.y, b.x, b.y}; v1 = (f32x4){c.x, c.y, d.x, d.y}; }
                    if (ACT == 2) {
#pragma unroll
                        for (int e = 0; e < 4; ++e) { float p = fmaxf(v0[e], 0.f), q = fmaxf(v1[e], 0.f); v0[e] = p * p; v1[e] = q * q; } }
                    u32x4 w; w.x = cvt_pk_bf16(v0[0], v0[1]); w.y = cvt_pk_bf16(v0[2], v0[3]); w.z = cvt_pk_bf16(v1[0], v1[1]); w.w = cvt_pk_bf16(v1[2], v1[3]);
                    *(u32x4*)(rowp + bj * HALF) = w; } }
    }
};
struct EpiRkvL {
    static constexpr bool PERM = true;
    bf16_t* R; size_t split_stride; bf16_t* L; int pn_off;
    __device__ __forceinline__ void operator()(const f32x4 (&acc)[2][2][4][2], const Unit& u0, int wr, int wc, int fr, int fq) const {
        Unit u = u0; u.pn += pn_off;
        const int row0 = u.pm * BM + wr * 64 + fr;
        bf16_t* base; int ldc, colt, mode;
        if (u.pn < 12) { base = R + (size_t)(u.pn >> 2) * split_stride; colt = (u.pn & 3) * BM; ldc = 1024; mode = 0; }
        else { base = L; colt = (u.pn - 12) * BM; ldc = 512; mode = (u.pn == 12) ? 1 : 2; }
        const int col0 = colt + wc * 32 + 8 * fq;
#pragma unroll
        for (int ai = 0; ai < 2; ++ai)
#pragma unroll
            for (int m = 0; m < 4; ++m) { bf16_t* rowp = base + (size_t)(row0 + ai * HALF + m * 16) * ldc + col0;
#pragma unroll
                for (int bj = 0; bj < 2; ++bj) { f32x4 v0 = acc[ai][bj][m][0], v1 = acc[ai][bj][m][1];
                    if (mode == 1 && bj == 0) {
#pragma unroll
                        for (int e = 0; e < 4; ++e) { v0[e] = tanhf(v0[e]); v1[e] = tanhf(v1[e]); } }
                    if (mode == 2) {
#pragma unroll
                        for (int e = 0; e < 4; ++e) { v0[e] = sigmoidf_(v0[e]); v1[e] = sigmoidf_(v1[e]); } }
                    u32x4 w; w.x = cvt_pk_bf16(v0[0], v0[1]); w.y = cvt_pk_bf16(v0[2], v0[3]); w.z = cvt_pk_bf16(v1[0], v1[1]); w.w = cvt_pk_bf16(v1[2], v1[3]);
                    *(u32x4*)(rowp + bj * HALF) = w; } }
    }
};
struct EpiL2 {
    static constexpr bool PERM = true;
    bf16_t* O0; bf16_t* O1; bf16_t* O2; const float* w0; const float* a0;
    __device__ __forceinline__ void operator()(const f32x4 (&acc)[2][2][4][2], const Unit& u, int wr, int wc, int fr, int fq) const {
        const int mode = u.pn >> 2;
        const int row0 = u.pm * BM + wr * 64 + fr; const int col0 = (u.pn & 3) * BM + wc * 32 + 8 * fq;
        bf16_t *o0 = O0, *o1 = O1, *o2 = O2; const float *bw = w0, *ba = a0;
        asm volatile("" : "+s"(o0), "+s"(o1), "+s"(o2), "+s"(bw), "+s"(ba));
        bf16_t* base = (mode == 0) ? o0 : ((mode == 1) ? o1 : o2);
        const float* bias = (mode == 0) ? bw : ba;
#pragma unroll
        for (int bj = 0; bj < 2; ++bj) {
            f32x4 b0 = {0.f, 0.f, 0.f, 0.f}, b1 = {0.f, 0.f, 0.f, 0.f};
            if (mode != 2) { b0 = *(const f32x4*)(bias + col0 + bj * HALF); b1 = *(const f32x4*)(bias + col0 + bj * HALF + 4); }
#pragma unroll
            for (int ai = 0; ai < 2; ++ai)
#pragma unroll
                for (int m = 0; m < 4; ++m) { bf16_t* rowp = base + (size_t)(row0 + ai * HALF + m * 16) * 1024 + col0;
                    f32x4 v0 = acc[ai][bj][m][0] + b0, v1 = acc[ai][bj][m][1] + b1;
                    if (mode != 2) {
                        const float sc = (mode == 0) ? -0.87503988f : 1.0f;
#pragma unroll
                        for (int e = 0; e < 4; ++e) { v0[e] = sc * __builtin_amdgcn_rcpf(1.0f + __expf(-v0[e])); v1[e] = sc * __builtin_amdgcn_rcpf(1.0f + __expf(-v1[e])); } }
                    u32x4 w; w.x = cvt_pk_bf16(v0[0], v0[1]); w.y = cvt_pk_bf16(v0[2], v0[3]); w.z = cvt_pk_bf16(v1[0], v1[1]); w.w = cvt_pk_bf16(v1[2], v1[3]);
                    *(u32x4*)(rowp + bj * HALF) = w;
                    if (m & 1) asm volatile("" ::: "memory"); }
        }
    }
};
struct EpiRes {
    static constexpr bool PERM = false;
    const float* base; float* out; const float* gate;
    int gstride;
    __device__ __forceinline__ void operator()(const f32x4 (&acc)[2][2][4][2], const Unit& u, int wr, int wc, int fr, int fq) const {
        const int col0 = u.pn * BM + wc * 32 + 4 * fq;
        const float* gp = gate + (size_t)(u.pm >> 4) * gstride + col0;
        f32x4 gv[2][2];
#pragma unroll
        for (int bj = 0; bj < 2; ++bj)
#pragma unroll
            for (int n = 0; n < 2; ++n) gv[bj][n] = *(const f32x4*)(gp + bj * HALF + n * 16);
#pragma unroll
        for (int ai = 0; ai < 2; ++ai)
#pragma unroll
            for (int m = 0; m < 4; ++m) { const size_t off = (size_t)(u.pm * BM + ai * HALF + wr * 64 + m * 16 + fr) * 1024 + col0;
#pragma unroll
                for (int bj = 0; bj < 2; ++bj)
#pragma unroll
                    for (int n = 0; n < 2; ++n) { const f32x4 bs = *(const f32x4*)(base + off + bj * HALF + n * 16);
                        *(f32x4*)(out + off + bj * HALF + n * 16) = bs + gv[bj][n] * acc[ai][bj][m][n]; } }
    }
};

template <class Epi>
__device__ __forceinline__ void gemm_phase(LAS unsigned char* lds, const Gemm g, const StaticOrder& S, const Epi& E) {
    const int tid = opaque_tid(), wid = __builtin_amdgcn_readfirstlane(tid >> 6), lane = tid & 63, wr = wid >> 2, wc = wid & 3, fr = lane & 15, fq = lane >> 4;
    int K_ = g.K; asm volatile("" : "+s"(K_));
    const int K = K_, nt = K / BK, lda = g.shift ? (K_ >> 1) : K_;
    const int ntA = g.shift ? (nt >> 1) : (1 << 30);
    const long adj = g.shift ? ((long)lda * 2 + (long)ntA * (BK * 2)) : 0;
    unsigned voffA[2], voffB[2];
#pragma unroll
    for (int i = 0; i < 2; ++i) { int R, C; stage_rc(tid * 16 + i * 8192, R, C); const int Rb = Epi::PERM ? ((R & ~31) + perm32(R & 31)) : R;
        voffA[i] = (unsigned)(R * lda + C) * 2u; voffB[i] = (unsigned)(Rb * K + C) * 2u; }
    const long kstep = (long)(BK * 2);
    const long hstepA = (long)HALF * lda * 2, hstepB = (long)HALF * K * 2, tstepB = 2 * hstepB;
    const unsigned ldsw = (unsigned)wid * 1024u;
    const int aoff = lds_byte(wr * 64 + fr, fq * 8), boff = lds_byte(wc * 32 + fr, fq * 8);
#define PG8_ABASE(u) ((const char*)g.A + ((long)((u).pn >> 2) * g.asplit + ((long)(u).pm * BM + (g.shift ? ((u).pm >> 4) + 1 : 0)) * (long)lda) * 2)
#define PG8_APTR(base, kt) ((base) + ((long)(kt) * kstep - (((kt) >= ntA) ? adj : 0)))
#define PG8_SA(b, h) (((b) * 2 + (h)) * HTB)
#define PG8_SB(b, h) ((4 + (b) * 2 + (h)) * HTB)
#define PG8_STAGE(bufoff, gbase, voff) do { _Pragma("unroll") for (int _i = 0; _i < 2; ++_i) \
        __builtin_amdgcn_global_load_lds((const unsigned*)((const char*)(gbase) + (voff)[_i]), (LAS unsigned*)(lds + (bufoff) + ldsw + _i * 8192), 16, 0, 0); } while (0)
#define PG8_LDA(dst, b, h) do { _Pragma("unroll") for (int m = 0; m < 4; ++m) _Pragma("unroll") for (int k = 0; k < 2; ++k) dst[m][k] = *(const LAS bf16x8*)(lds + PG8_SA(b, h) + aoff + m * 2048 + k * 1024); } while (0)
#define PG8_LDB(dst, b, h) do { _Pragma("unroll") for (int n = 0; n < 2; ++n) _Pragma("unroll") for (int k = 0; k < 2; ++k) dst[n][k] = *(const LAS bf16x8*)(lds + PG8_SB(b, h) + boff + n * 2048 + k * 1024); } while (0)
#define PG8_MMA(ai, bj, At, Bt) do { __builtin_amdgcn_s_setprio(1); _Pragma("unroll") for (int m = 0; m < 4; ++m) _Pragma("unroll") for (int n = 0; n < 2; ++n) _Pragma("unroll") for (int k = 0; k < 2; ++k) \
        acc[ai][bj][m][n] = __builtin_amdgcn_mfma_f32_16x16x32_bf16(Bt[n][k], At[m][k], acc[ai][bj][m][n], 0, 0, 0); __builtin_amdgcn_s_setprio(0); } while (0)
#define PG8_WAIT_V(n) asm volatile("s_waitcnt vmcnt(" #n ")" ::: "memory")
#define PG8_WAIT_L(n) asm volatile("s_waitcnt lgkmcnt(" #n ")" ::: "memory")
#define PG8_BAR __builtin_amdgcn_s_barrier()
#define PG8_SCHED __builtin_amdgcn_sched_barrier(0)
    Unit cur, nxt; int ui = 0;
    if (!S.next(0, cur)) return;
    f32x4 acc[2][2][4][2];
#pragma unroll
    for (int a = 0; a < 2; ++a)
#pragma unroll
        for (int b = 0; b < 2; ++b)
#pragma unroll
            for (int m = 0; m < 4; ++m)
#pragma unroll
                for (int n = 0; n < 2; ++n) acc[a][b][m][n] = (f32x4){0.f, 0.f, 0.f, 0.f};
    bf16x8 At[4][2], B0[2][2], B1[2][2];
    const char* cA = PG8_ABASE(cur); const char* cB = (const char*)g.Bt + (long)cur.pn * tstepB;
    PG8_STAGE(PG8_SB(0, 0), cB, voffB); PG8_STAGE(PG8_SB(0, 1), cB + hstepB, voffB); PG8_STAGE(PG8_SA(0, 0), cA, voffA); PG8_STAGE(PG8_SA(0, 1), cA + hstepA, voffA);
    if (wr == 1) PG8_BAR;
    PG8_WAIT_V(2); PG8_BAR;
    PG8_STAGE(PG8_SB(1, 0), cB + kstep, voffB); PG8_STAGE(PG8_SA(1, 0), cA + kstep, voffA); PG8_STAGE(PG8_SB(1, 1), cB + hstepB + kstep, voffB);
    PG8_WAIT_V(6); PG8_BAR;
    for (;;) {
        const bool has_next = S.next(ui + 1, nxt);
        const char* nA = has_next ? PG8_ABASE(nxt) : cA; const char* nB = has_next ? (const char*)g.Bt + (long)nxt.pn * tstepB : cB;
        for (int t = 0; t < nt; t += 2) {
            const bool last = (t == nt - 2);
            const char* a1 = PG8_APTR(cA, t + 1);
            const char* a2 = last ? nA : PG8_APTR(cA, t + 2); const char* b2 = last ? nB : cB + (long)(t + 2) * kstep;
            const char* a3 = a2 + kstep; const char* b3 = b2 + kstep;
            PG8_LDB(B0, 0, 0); PG8_LDB(B1, 0, 1); PG8_SCHED; PG8_LDA(At, 0, 0); PG8_STAGE(PG8_SA(1, 1), a1 + hstepA, voffA);
            PG8_WAIT_V(8); PG8_WAIT_L(0); PG8_BAR; PG8_MMA(0, 0, At, B0); PG8_MMA(0, 1, At, B1); PG8_BAR; PG8_SCHED;
            PG8_LDA(At, 0, 1); PG8_STAGE(PG8_SB(0, 0), b2, voffB); PG8_STAGE(PG8_SB(0, 1), b2 + hstepB, voffB); PG8_STAGE(PG8_SA(0, 0), a2, voffA);
            PG8_WAIT_V(8); PG8_WAIT_L(0); PG8_BAR; PG8_MMA(1, 0, At, B0); PG8_MMA(1, 1, At, B1); PG8_BAR; PG8_SCHED;
            PG8_LDB(B0, 1, 0); PG8_LDB(B1, 1, 1); PG8_SCHED; PG8_LDA(At, 1, 0); PG8_STAGE(PG8_SA(0, 1), a2 + hstepA, voffA);
            PG8_WAIT_V(8); PG8_WAIT_L(0); PG8_BAR; PG8_MMA(0, 0, At, B0); PG8_MMA(0, 1, At, B1); PG8_BAR; PG8_SCHED;
            PG8_LDA(At, 1, 1); PG8_STAGE(PG8_SB(1, 0), b3, voffB); PG8_STAGE(PG8_SB(1, 1), b3 + hstepB, voffB); PG8_STAGE(PG8_SA(1, 0), a3, voffA);
            PG8_WAIT_V(8); PG8_WAIT_L(0); PG8_BAR; PG8_MMA(1, 0, At, B0); PG8_MMA(1, 1, At, B1); PG8_BAR; PG8_SCHED;
        }
        if (wr == 0) PG8_BAR;
        E(acc, cur, wr, wc, fr, fq);
        if (!has_next) break;
#pragma unroll
        for (int a = 0; a < 2; ++a)
#pragma unroll
            for (int b = 0; b < 2; ++b)
#pragma unroll
                for (int m = 0; m < 4; ++m)
#pragma unroll
                    for (int n = 0; n < 2; ++n) acc[a][b][m][n] = (f32x4){0.f, 0.f, 0.f, 0.f};
        cur = nxt; cA = nA; cB = nB; ++ui;
        if (wr == 1) PG8_BAR;
    }
    PG8_WAIT_V(0);
    PG8_BAR;
#undef PG8_ABASE
#undef PG8_APTR
#undef PG8_SA
#undef PG8_SB
#undef PG8_STAGE
#undef PG8_LDA
#undef PG8_LDB
#undef PG8_MMA
#undef PG8_WAIT_V
#undef PG8_WAIT_L
#undef PG8_BAR
#undef PG8_SCHED
}
}

constexpr size_t MiB = 1u << 20;
constexpr size_t WS_MOD = 1 * MiB;
constexpr size_t WS_WIN0 = 2 * MiB;
constexpr size_t WS_WOUT0 = 6 * MiB;
constexpr size_t WS_W1 = 8 * MiB;
constexpr size_t WS_W2 = 24 * MiB;
constexpr size_t WS_WRKV = 40 * MiB;
constexpr size_t WS_WL1 = 46 * MiB;
constexpr size_t WS_WL2 = 48 * MiB;
constexpr size_t WS_WOUT1 = 51 * MiB;
constexpr size_t WS_WS = 53 * MiB;
constexpr size_t WS_H = 60 * MiB;
constexpr size_t WS_UV = 188 * MiB;
constexpr size_t WS_Z = 444 * MiB;
constexpr size_t WS_HID = 188 * MiB;
constexpr size_t WS_X3 = 54 * MiB;
constexpr size_t WS_H2 = 438 * MiB;
constexpr size_t WS_L = 952 * MiB;
constexpr size_t WS_R = 567 * MiB, WS_K = 695 * MiB, WS_V = 823 * MiB;
constexpr size_t WS_WE = 60 * MiB, WS_A = 188 * MiB, WS_G = 316 * MiB;
constexpr size_t WS_YG = 54 * MiB;
constexpr size_t WS_END = 1020 * MiB;
constexpr int LDS_BYTES = 147456;

struct Args {
    const float* in[29];
    float* out; unsigned char* ws;
    int lo, hi;
};

__device__ __forceinline__ float wave_sum(float v) {
#pragma unroll
    for (int o = 1; o < 64; o <<= 1) v += __shfl_xor(v, o);
    return v;
}
template <int CTRL> __device__ __forceinline__ float dppf(float v) { return __builtin_bit_cast(float, __builtin_amdgcn_update_dpp(0, __builtin_bit_cast(int, v), CTRL, 0xF, 0xF, true)); }
__device__ __forceinline__ float reduce16(float v) {
    v += dppf<0xB1>(v); v += dppf<0x4E>(v); v += dppf<0x141>(v); v += dppf<0x140>(v); return v;
}

#define XB_TMO      128
#define XB_XCNT(j)  (256  + 64 * (j))
#define XB_XSUB(j)  (1280 + 64 * (j))
#define XB_XGEN(j)  (2304 + 64 * (j))
#define XB_TOP      3328
#define XB_TOPGEN   3392
#define XCD_BAR_WORDS 3456
#define XB_SPIN_CAP (1u << 18)

__device__ __forceinline__ unsigned xb_ld(unsigned* p)              { return __hip_atomic_load(p, __ATOMIC_RELAXED, __HIP_MEMORY_SCOPE_AGENT); }
__device__ __forceinline__ unsigned xb_add(unsigned* p, unsigned v) { return __hip_atomic_fetch_add(p, v, __ATOMIC_RELAXED, __HIP_MEMORY_SCOPE_AGENT); }
__device__ __forceinline__ unsigned xb_xcc_id() { return (unsigned)__builtin_amdgcn_s_getreg((3 << 11) | 20) & 0xFu; }
#define XB_SPIN(cond, bar) do { unsigned _sp = 0; while (cond) { __builtin_amdgcn_s_sleep(1); \
    if ((++_sp & 255u) == 0u) { if (xb_ld(&(bar)[XB_TMO])) break; if (_sp > XB_SPIN_CAP) { atomicAdd(&(bar)[XB_TMO], 1u); break; } } } } while (0)

struct XcdBarrier {
    unsigned* bar; unsigned x;
    volatile LAS unsigned* st;
};

__device__ __forceinline__ XcdBarrier xcd_barrier_post(unsigned* bar, volatile LAS unsigned* st) {
    XcdBarrier b; b.bar = bar; b.x = xb_xcc_id(); b.st = st;
    if (threadIdx.x == 0) (void)xb_add(&bar[XB_XCNT(b.x)], 1u);
    return b;
}
__device__ __forceinline__ void xcd_barrier_complete(unsigned* bar, unsigned x, unsigned& nloc, unsigned& nx) {
    const unsigned G = gridDim.x * gridDim.y * gridDim.z;
    unsigned sum, cnt, mine, sp = 0u;
    for (;;) {
        sum = 0u; cnt = 0u; mine = 0u;
#pragma unroll
        for (unsigned j = 0; j < 16; ++j) { const unsigned c = xb_ld(&bar[XB_XCNT(j)]); sum += c; cnt += (c > 0u) ? 1u : 0u; mine = (j == x) ? c : mine; }
        if (sum == G) break;
        __builtin_amdgcn_s_sleep(1);
        if ((++sp & 255u) == 0u) { if (xb_ld(&bar[XB_TMO])) break; if (sp > XB_SPIN_CAP) { atomicAdd(&bar[XB_TMO], 1u); break; } }
    }
    nloc = mine > 0u ? mine : 1u; nx = cnt > 0u ? cnt : 1u;
}

__device__ __forceinline__ void xcd_barrier(const XcdBarrier& b) {
    asm volatile("s_waitcnt vmcnt(0)" ::: "memory");
    __syncthreads();
    if (threadIdx.x == 0) {
        unsigned* bar = b.bar;
        __builtin_amdgcn_s_waitcnt(0);
        unsigned nloc = b.st[0], nx = b.st[1];
        if (nloc == 0u) { xcd_barrier_complete(bar, b.x, nloc, nx); b.st[0] = nloc; b.st[1] = nx; }
        const unsigned old = xb_add(&bar[XB_XSUB(b.x)], 1u);
        const unsigned gen = old / nloc;
        if (old + 1u == (gen + 1u) * nloc) {
            __builtin_amdgcn_fence(__ATOMIC_RELEASE, "agent");
            asm volatile("s_waitcnt vmcnt(0)" ::: "memory");
            const unsigned og = xb_add(&bar[XB_TOP], 1u);
            const unsigned tg = og / nx;
            if (og + 1u == (tg + 1u) * nx) xb_add(&bar[XB_TOPGEN], 1u);
            else XB_SPIN(xb_ld(&bar[XB_TOPGEN]) == tg, bar);
            __builtin_amdgcn_fence(__ATOMIC_ACQUIRE, "agent");
            xb_add(&bar[XB_XGEN(b.x)], 1u);
            asm volatile("s_waitcnt vmcnt(0)" ::: "memory");
        } else {
            XB_SPIN(xb_ld(&bar[XB_XGEN(b.x)]) == gen, bar);
            __builtin_amdgcn_fence(__ATOMIC_ACQUIRE, "agent");
            asm volatile("s_waitcnt vmcnt(0)" ::: "memory");
        }
    }
    __syncthreads();
}


__device__ __forceinline__ void gsync(cg::grid_group& grid) {
    asm volatile("s_waitcnt vmcnt(0) lgkmcnt(0)" ::: "memory");
    grid.sync();
    if (threadIdx.x < 64) { __builtin_amdgcn_fence(__ATOMIC_ACQUIRE, "agent"); asm volatile("s_waitcnt vmcnt(0)" ::: "memory"); }
    __syncthreads();
}
__device__ __forceinline__ void transpose_item(const float* W, int lds_, int Ksrc, int Nsrc, bf16_t* WT, int ldd, int row_off, int col_off,
                                               const float* mu, int mode, LAS float* scr, int kb, int nb, int lane) {
    const int k0 = 64 * kb, n0 = 32 * nb;
#pragma unroll 8
    for (int i = 0; i < 32; ++i) { const int kk = 2 * i + (lane >> 5), nn = lane & 31, k = k0 + kk, n = n0 + nn;
        float v = (k < Ksrc && n < Nsrc) ? W[(size_t)k * lds_ + n] : 0.f;
        if (mode) { const float m = mu[k & 1023]; v *= (mode == 1) ? (1.f - m) : m; }
        scr[kk * 33 + nn] = v; }
    asm volatile("s_waitcnt lgkmcnt(0)" ::: "memory");
    const int c = lane & 7;
#pragma unroll
    for (int j = 0; j < 4; ++j) { const int n = (lane >> 3) + 8 * j; const LAS float* s = scr + (8 * c) * 33 + n;
        u32x4 o; o.x = cvt_pk_bf16(s[0 * 33], s[1 * 33]); o.y = cvt_pk_bf16(s[2 * 33], s[3 * 33]); o.z = cvt_pk_bf16(s[4 * 33], s[5 * 33]); o.w = cvt_pk_bf16(s[6 * 33], s[7 * 33]);
        *(u32x4*)(WT + (size_t)(row_off + n0 + n) * ldd + col_off + k0 + 8 * c) = o; }
    asm volatile("s_waitcnt lgkmcnt(0)" ::: "memory");
}

__device__ __forceinline__ void phase_prep(const Args& a, LAS unsigned char* lds) {
    const int tid = opaque_tid(), lane = tid & 63, wave = tid >> 6;
    unsigned char* ws = a.ws;
    {
        LAS float* sc = (LAS float*)lds;
        LAS float* red = (LAS float*)(lds + 65536);
        bool have = false;
        for (int it = blockIdx.x; it < 2 * 96; it += gridDim.x) {
            if (!have) { const float* c = a.in[1];
                for (int e = tid; e < 16 * 1024; e += NTHREADS) { const int b = e >> 10, k = e & 1023; const float x = c[e]; sc[k * 16 + b] = x / (1.f + __expf(-x)); }
                have = true; }
            __syncthreads();
            const int l = it / 96, n0 = (it % 96) * 64;
            const float* w = a.in[2] + (size_t)l * 1024 * 6144 + n0 + lane;
            float acc[16];
#pragma unroll
            for (int b = 0; b < 16; ++b) acc[b] = 0.f;
            const int kbeg = wave * 128;
#pragma unroll 8
            for (int k = kbeg; k < kbeg + 128; ++k) { const float wv = w[(size_t)k * 6144];
                const LAS f32x4* s4 = (const LAS f32x4*)(sc + k * 16);
#pragma unroll
                for (int q = 0; q < 4; ++q) { const f32x4 s = s4[q]; acc[4 * q] += s[0] * wv; acc[4 * q + 1] += s[1] * wv; acc[4 * q + 2] += s[2] * wv; acc[4 * q + 3] += s[3] * wv; } }
#pragma unroll
            for (int b = 0; b < 16; ++b) red[(wave * 16 + b) * 64 + lane] = acc[b];
            __syncthreads();
            float* mod = (float*)(ws + WS_MOD);
            for (int e = tid; e < 1024; e += NTHREADS) { const int b = e >> 6, n = e & 63; float s = 0.f;
#pragma unroll
                for (int wv = 0; wv < 8; ++wv) s += red[(wv * 16 + b) * 64 + n];
                mod[((size_t)l * 16 + b) * 6144 + n0 + n] = s + a.in[3][l * 6144 + n0 + n]; }
            __syncthreads();
        }
        __syncthreads();
    }
}
__device__ __forceinline__ void phase_weights(const Args& a, LAS unsigned char* lds) {
    const int tid = opaque_tid(), lane = tid & 63, wave = tid >> 6;
    unsigned char* ws = a.ws;
    {
        LAS float* scr = (LAS float*)(lds + wave * 16384);
        const int gw = blockIdx.x * NWAVES + wave, NGW = gridDim.x * NWAVES;
        const float* mu = a.in[12];
        constexpr int TOTAL = 16 * 64 + 16 * 32 + 2 * 16 * 128 + 2 * 64 * 32 + 3 * 16 * 32 + 2 * (16 * 4 + 16 * 4 + 16 * 8) + 24 * 32 + 16 * 32;
        for (int it = gw; it < TOTAL; it += NGW) {
            int r = it;
#define JOB(W, LDSRC, KS, NS, DST, LDD, RO, CO, MU, MODE, KB, NBK) if (r >= 0) { if (r < (KB) * (NBK)) { transpose_item((W), (LDSRC), (KS), (NS), (bf16_t*)(ws + (DST)), (LDD), (RO), (CO), (MU), (MODE), scr, r / (NBK), r % (NBK), lane); r = -1; } else r -= (KB) * (NBK); }
            JOB(a.in[6], 2048, 1024, 2048, WS_WIN0, 1024, 0, 0, mu, 0, 16, 64)
            JOB(a.in[11], 1024, 1024, 1024, WS_WOUT0, 1024, 0, 0, mu, 0, 16, 32)
            JOB(a.in[4], 4096, 1024, 4096, WS_W1, 1024, 0, 0, mu, 0, 16, 128)
            JOB(a.in[4] + (size_t)1024 * 4096, 4096, 1024, 4096, WS_W1 + (size_t)4096 * 1024 * 2, 1024, 0, 0, mu, 0, 16, 128)
            JOB(a.in[5], 1024, 4096, 1024, WS_W2, 4096, 0, 0, mu, 0, 64, 32)
            JOB(a.in[5] + (size_t)4096 * 1024, 1024, 4096, 1024, WS_W2 + (size_t)1024 * 4096 * 2, 4096, 0, 0, mu, 0, 64, 32)
            JOB(a.in[13] + 0, 3072, 1024, 1024, WS_WRKV, 1024, 0, 0, mu, 0, 16, 32)
            JOB(a.in[13] + 1024, 3072, 1024, 1024, WS_WRKV, 1024, 1024, 0, mu, 0, 16, 32)
            JOB(a.in[13] + 2048, 3072, 1024, 1024, WS_WRKV, 1024, 2048, 0, mu, 0, 16, 32)
            JOB(a.in[15], 64, 1024, 64, WS_WL1, 2048, 0, 0, mu + 1 * 1024, 1, 16, 4)
            JOB(a.in[15], 64, 1024, 64, WS_WL1, 2048, 0, 1024, mu + 1 * 1024, 2, 16, 4)
            JOB(a.in[18], 64, 1024, 64, WS_WL1, 2048, 128, 0, mu + 4 * 1024, 1, 16, 4)
            JOB(a.in[18], 64, 1024, 64, WS_WL1, 2048, 128, 1024, mu + 4 * 1024, 2, 16, 4)
            JOB(a.in[20], 160, 1024, 160, WS_WL1, 2048, 256, 0, mu + 5 * 1024, 1, 16, 8)
            JOB(a.in[20], 160, 1024, 160, WS_WL1, 2048, 256, 1024, mu + 5 * 1024, 2, 16, 8)
            JOB(a.in[16], 1024, 64, 1024, WS_WL2, 512, 0, 0, mu, 0, 2, 32)
            JOB(a.in[16], 1024, 0, 1024, WS_WL2, 512, 0, 128, mu, 0, 6, 32)
            JOB(a.in[19], 1024, 0, 1024, WS_WL2, 512, 1024, 0, mu, 0, 2, 32)
            JOB(a.in[19], 1024, 64, 1024, WS_WL2, 512, 1024, 128, mu, 0, 2, 32)
            JOB(a.in[19], 1024, 0, 1024, WS_WL2, 512, 1024, 256, mu, 0, 4, 32)
            JOB(a.in[21], 1024, 0, 1024, WS_WL2, 512, 2048, 0, mu, 0, 4, 32)
            JOB(a.in[21], 1024, 160, 1024, WS_WL2, 512, 2048, 256, mu, 0, 4, 32)
            JOB(a.in[27], 1024, 1024, 1024, WS_WOUT1, 1024, 0, 0, mu, 0, 16, 32)
#undef JOB
        }
        bf16_t* wsb = (bf16_t*)(ws + WS_WS);
        for (int e = blockIdx.x * NTHREADS + tid; e < 8 * 128 * 128 / 2; e += gridDim.x * NTHREADS) {
            const int i = e * 2, s = i & 127, t = (i >> 7) & 127;
            const float v0 = (s <= t) ? a.in[9][i] : 0.f, v1 = (s + 1 <= t) ? a.in[9][i + 1] : 0.f;
            ((unsigned*)wsb)[e] = cvt_pk_bf16(v0, v1);
        }
    }
}

__device__ __forceinline__ void phase_norm_mod(const float* x, const float* mod_shift, const float* mod_scale, bf16_t* H, int) {
    const int tid = opaque_tid(), lane = tid & 63, wave = tid >> 6;
    const int gw = blockIdx.x * NWAVES + wave, NGW = gridDim.x * NWAVES;
    constexpr int NR = 4;
    for (int m0 = gw; m0 < M; m0 += NR * NGW) {
        f32x4 v[NR][4];
#pragma unroll
        for (int r = 0; r < NR; ++r) { const int m = M - 1 - (m0 + r * NGW < M ? m0 + r * NGW : m0); const f32x4* xr = (const f32x4*)(x + (size_t)m * D) + lane;
#pragma unroll
            for (int j = 0; j < 4; ++j) v[r][j] = xr[64 * j]; }
#pragma unroll
        for (int r = 0; r < NR; ++r) { const int m = M - 1 - (m0 + r * NGW); if (m >= 0) {
            const int b = m >> 12; float s = 0.f;
#pragma unroll
            for (int j = 0; j < 4; ++j) s += (v[r][j].x * v[r][j].x + v[r][j].y * v[r][j].y) + (v[r][j].z * v[r][j].z + v[r][j].w * v[r][j].w);
            const float rstd = 1.0f / sqrtf(wave_sum(s) * (1.f / D) + 1e-6f);
            const f32x4* sh = (const f32x4*)(mod_shift + (size_t)b * 6144) + lane;
            const f32x4* sc = (const f32x4*)(mod_scale + (size_t)b * 6144) + lane;
            u32x2* o = (u32x2*)(H + (size_t)m * D) + lane;
#pragma unroll
            for (int j = 0; j < 4; ++j) { const f32x4 a = sh[64 * j], c = sc[64 * j]; const f32x4 h = v[r][j] * rstd * (c + 1.0f) + a;
                u32x2 w; w.x = cvt_pk_bf16(h.x, h.y); w.y = cvt_pk_bf16(h.z, h.w); o[64 * j] = w; } } }
    }
}
__device__ __forceinline__ void phase_final_norm(float* x, const float* g) {
    const int tid = opaque_tid(), lane = tid & 63, wave = tid >> 6;
    const int gw = blockIdx.x * NWAVES + wave, NGW = gridDim.x * NWAVES;
    constexpr int NR = 4;
    f32x4 gg[4];
#pragma unroll
    for (int j = 0; j < 4; ++j) gg[j] = ((const f32x4*)g)[lane + 64 * j];
    for (int m0 = gw; m0 < M; m0 += NR * NGW) {
        f32x4 v[NR][4];
#pragma unroll
        for (int r = 0; r < NR; ++r) { const int m = (m0 + r * NGW < M ? m0 + r * NGW : m0); const f32x4* xr = (const f32x4*)(x + (size_t)m * D) + lane;
#pragma unroll
            for (int j = 0; j < 4; ++j) v[r][j] = xr[64 * j]; }
#pragma unroll
        for (int r = 0; r < NR; ++r) { const int m = m0 + r * NGW; if (m < M) {
            float s = 0.f;
#pragma unroll
            for (int j = 0; j < 4; ++j) s += (v[r][j].x * v[r][j].x + v[r][j].y * v[r][j].y) + (v[r][j].z * v[r][j].z + v[r][j].w * v[r][j].w);
            const float rstd = 1.0f / sqrtf(wave_sum(s) * (1.f / D) + 1e-6f);
            f32x4* xr = (f32x4*)(x + (size_t)m * D) + lane;
#pragma unroll
            for (int j = 0; j < 4; ++j) xr[64 * j] = v[r][j] * rstd * gg[j]; } }
    }
}
__device__ __forceinline__ void load_row(const float* x, size_t m, int lane, f32x4 (&v)[4]) {
    const f32x4* xr = (const f32x4*)(x + m * D) + lane;
#pragma unroll
    for (int j = 0; j < 4; ++j) v[j] = xr[64 * j];
}
__device__ __forceinline__ void finish_row(f32x4 (&h)[4], const f32x4 (&sh)[4], const f32x4 (&sc1)[4]) {
    float s = 0.f;
#pragma unroll
    for (int j = 0; j < 4; ++j) s += (h[j].x * h[j].x + h[j].y * h[j].y) + (h[j].z * h[j].z + h[j].w * h[j].w);
    const float rstd = 1.0f / sqrtf(wave_sum(s) * (1.f / D) + 1e-6f);
#pragma unroll
    for (int j = 0; j < 4; ++j) h[j] = h[j] * rstd * sc1[j] + sh[j];
}
__device__ __forceinline__ void phase_norm_shift(const float* x, const float* mod_shift, const float* mod_scale, const float* mu, bf16_t* X3, bf16_t* H2) {
    const int tid = opaque_tid(), lane = tid & 63, wave = tid >> 6;
    const int gw = blockIdx.x * NWAVES + wave, NGW = gridDim.x * NWAVES;
    f32x4 mr[4], mk[4], mv[4];
#pragma unroll
    for (int j = 0; j < 4; ++j) { mr[j] = ((const f32x4*)(mu + 0 * 1024))[lane + 64 * j]; mk[j] = ((const f32x4*)(mu + 2 * 1024))[lane + 64 * j]; mv[j] = ((const f32x4*)(mu + 3 * 1024))[lane + 64 * j]; }
    for (int blk = gw; blk < M / 32; blk += NGW) {
        const size_t m0 = (size_t)blk * 32; const int b = (int)(m0 >> 12);
        f32x4 sh[4], sc1[4];
#pragma unroll
        for (int j = 0; j < 4; ++j) { sh[j] = ((const f32x4*)(mod_shift + (size_t)b * 6144))[lane + 64 * j]; sc1[j] = ((const f32x4*)(mod_scale + (size_t)b * 6144))[lane + 64 * j] + 1.0f; }
        f32x4 hp[4], h[4], n1[4], n2[4];
        const bool first = (m0 & 4095) == 0;
        load_row(x, first ? m0 : m0 - 1, lane, hp); load_row(x, m0, lane, h); load_row(x, m0 + 1, lane, n1);
        finish_row(hp, sh, sc1);
        if (first) {
#pragma unroll
            for (int j = 0; j < 4; ++j) hp[j] = (f32x4){0.f, 0.f, 0.f, 0.f}; }
        for (int i = 0; i < 32; ++i) {
            const size_t m = m0 + i;
            load_row(x, (i + 2 < 32) ? m + 2 : m, lane, n2);
            finish_row(h, sh, sc1);
            u32x2* o2 = (u32x2*)(H2 + (m + b + 1) * D) + lane;
            u32x2* or_ = (u32x2*)(X3 + m * D) + lane;
#pragma unroll
            for (int j = 0; j < 4; ++j) {
                const f32x4 d = hp[j] - h[j];
                const f32x4 xr = h[j] + d * mr[j], xk = h[j] + d * mk[j], xv = h[j] + d * mv[j];
                u32x2 w; w.x = cvt_pk_bf16(h[j].x, h[j].y); w.y = cvt_pk_bf16(h[j].z, h[j].w); o2[64 * j] = w;
                if (first && i == 0) o2[64 * j - D / 4] = (u32x2){0u, 0u};
                w.x = cvt_pk_bf16(xr.x, xr.y); w.y = cvt_pk_bf16(xr.z, xr.w); or_[64 * j] = w;
                w.x = cvt_pk_bf16(xk.x, xk.y); w.y = cvt_pk_bf16(xk.z, xk.w); or_[64 * j + (size_t)M * D / 4] = w;
                w.x = cvt_pk_bf16(xv.x, xv.y); w.y = cvt_pk_bf16(xv.z, xv.w); or_[64 * j + 2 * (size_t)M * D / 4] = w;
                hp[j] = h[j]; h[j] = n1[j]; n1[j] = n2[j];
            }
        }
    }
}

__device__ __forceinline__ void phase_sgu(const Args& a, LAS unsigned char* lds) {
    const int tid = opaque_tid(), lane = tid & 63, wave = tid >> 6, fr = lane & 15, fq = lane >> 4;
    const bf16_t* UV = (const bf16_t*)(a.ws + WS_UV); bf16_t* Z = (bf16_t*)(a.ws + WS_Z);
    const bf16_t* WSB = (const bf16_t*)(a.ws + WS_WS);
    const float* lng = a.in[7]; const float* lnb = a.in[8]; const float* bs = a.in[10];
    constexpr int RS = 272;
    LAS unsigned char* Wl = lds;
    LAS unsigned char* Vl = lds + 128 * RS;
    LAS f32x2* st = (LAS f32x2*)(lds + 2 * 128 * RS);
    const int wt = wave >> 2, wd = wave & 3;
    for (int tile_ = blockIdx.x; tile_ < M / 128; tile_ += gridDim.x) {
        const int tile = M / 128 - 1 - tile_;
        const size_t m0 = (size_t)tile * 128;
        for (int r = wave * 16; r < wave * 16 + 16; ++r) {
            const u32x4* p = (const u32x4*)(UV + (m0 + r) * 2048 + 1024) + lane;
            const u32x4 q0 = p[0], q1 = p[64];
            float f[16];
            f[0] = bf_lo(q0.x); f[1] = bf_hi(q0.x); f[2] = bf_lo(q0.y); f[3] = bf_hi(q0.y); f[4] = bf_lo(q0.z); f[5] = bf_hi(q0.z); f[6] = bf_lo(q0.w); f[7] = bf_hi(q0.w);
            f[8] = bf_lo(q1.x); f[9] = bf_hi(q1.x); f[10] = bf_lo(q1.y); f[11] = bf_hi(q1.y); f[12] = bf_lo(q1.z); f[13] = bf_hi(q1.z); f[14] = bf_lo(q1.w); f[15] = bf_hi(q1.w);
            float s = 0.f;
#pragma unroll
            for (int e = 0; e < 16; ++e) s += f[e];
            const float mean = wave_sum(s) * (1.f / 1024.f);
            float q = 0.f;
#pragma unroll
            for (int e = 0; e < 16; ++e) { const float d = f[e] - mean; q += d * d; }
            const float var = wave_sum(q) * (1.f / 1024.f);
            if (lane == 0) st[r] = (f32x2){mean, 1.0f / sqrtf(var + 1e-5f)};
        }
        __syncthreads();
        for (int g = 0; g < 8; ++g) {
            {
                const u32x4* src = (const u32x4*)(WSB + (size_t)g * 128 * 128);
#pragma unroll
                for (int i = 0; i < 4; ++i) { const int idx = tid + i * NTHREADS; const int t = idx >> 4, c = idx & 15;
                    *(LAS u32x4*)(Wl + t * RS + c * 16) = src[idx]; }
            }
            {
                const int sp = tid & 63, dq = tid >> 6, s0 = 2 * sp, d0 = dq * 16;
                const f32x2 st0 = st[s0], st1 = st[s0 + 1];
                const bf16_t* p0 = UV + (m0 + s0) * 2048 + 1024 + g * 128 + d0;
                const u32x4 a0 = *(const u32x4*)p0, a1 = *(const u32x4*)(p0 + 8), b0 = *(const u32x4*)(p0 + 2048), b1 = *(const u32x4*)(p0 + 2048 + 8);
                const unsigned ua[8] = {a0.x, a0.y, a0.z, a0.w, a1.x, a1.y, a1.z, a1.w}, ub[8] = {b0.x, b0.y, b0.z, b0.w, b1.x, b1.y, b1.z, b1.w};
                const float* gp = lng + g * 128 + d0; const float* bp = lnb + g * 128 + d0;
#pragma unroll
                for (int e = 0; e < 8; ++e) {
                    const float g0 = gp[2 * e], g1 = gp[2 * e + 1], c0 = bp[2 * e], c1 = bp[2 * e + 1];
                    const float x00 = (bf_lo(ua[e]) - st0.x) * st0.y * g0 + c0, x01 = (bf_hi(ua[e]) - st0.x) * st0.y * g1 + c1;
                    const float x10 = (bf_lo(ub[e]) - st1.x) * st1.y * g0 + c0, x11 = (bf_hi(ub[e]) - st1.x) * st1.y * g1 + c1;
                    *(LAS unsigned*)(Vl + (d0 + 2 * e) * RS + s0 * 2) = cvt_pk_bf16(x00, x10);
                    *(LAS unsigned*)(Vl + (d0 + 2 * e + 1) * RS + s0 * 2) = cvt_pk_bf16(x01, x11);
                }
            }
            __syncthreads();
            f32x4 acc[4][2];
#pragma unroll
            for (int mi = 0; mi < 4; ++mi)
#pragma unroll
                for (int ni = 0; ni < 2; ++ni) acc[mi][ni] = (f32x4){0.f, 0.f, 0.f, 0.f};
#pragma unroll
            for (int ks = 0; ks < 4; ++ks) {
                if (ks * 32 <= 64 * wt + 63) {
                    bf16x8 bfr[2];
#pragma unroll
                    for (int ni = 0; ni < 2; ++ni) bfr[ni] = *(const LAS bf16x8*)(Vl + (32 * wd + 16 * ni + fr) * RS + (ks * 32 + fq * 8) * 2);
#pragma unroll
                    for (int mi = 0; mi < 4; ++mi) {
                        if (ks * 32 <= 64 * wt + 16 * mi + 15) {
                            const bf16x8 afr = *(const LAS bf16x8*)(Wl + (64 * wt + 16 * mi + fr) * RS + (ks * 32 + fq * 8) * 2);
#pragma unroll
                            for (int ni = 0; ni < 2; ++ni) acc[mi][ni] = __builtin_amdgcn_mfma_f32_16x16x32_bf16(bfr[ni], afr, acc[mi][ni], 0, 0, 0);
                        }
                    }
                }
            }
#pragma unroll
            for (int mi = 0; mi < 4; ++mi) {
                const int t = 64 * wt + 16 * mi + fr; const float bias = bs[g * 128 + t];
#pragma unroll
                for (int ni = 0; ni < 2; ++ni) {
                    const int col = g * 128 + 32 * wd + 16 * ni + 4 * fq;
                    const u32x2 uu = *(const u32x2*)(UV + (m0 + t) * 2048 + col);
                    const f32x4 sv = acc[mi][ni];
                    u32x2 o; o.x = cvt_pk_bf16(bf_lo(uu.x) * (sv[0] + bias), bf_hi(uu.x) * (sv[1] + bias)); o.y = cvt_pk_bf16(bf_lo(uu.y) * (sv[2] + bias), bf_hi(uu.y) * (sv[3] + bias));
                    *(u32x2*)(Z + (m0 + t) * 1024 + col) = o;
                }
            }
            __syncthreads();
        }
    }
}

__device__ __forceinline__ float fma_(float a, float b, float c) { float d; asm("v_fma_f32 %0, %1, %2, %3" : "=v"(d) : "v"(a), "v"(b), "v"(c)); return d; }
__device__ __forceinline__ float mul_(float a, float b) { float d; asm("v_mul_f32 %0, %1, %2" : "=v"(d) : "v"(a), "v"(b)); return d; }
__device__ __forceinline__ float dot4_(const f32x4& s, const f32x4& o) { return fma_(s.w, o.w, fma_(s.z, o.z, fma_(s.y, o.y, mul_(s.x, o.x)))); }
__device__ __forceinline__ void upd4_(f32x4& s, const f32x4& w, const f32x4& b, const f32x4& k, float sa, float v) {
    s.x = fma_(v, k.x, fma_(sa, b.x, mul_(s.x, w.x))); s.y = fma_(v, k.y, fma_(sa, b.y, mul_(s.y, w.y)));
    s.z = fma_(v, k.z, fma_(sa, b.z, mul_(s.z, w.z))); s.w = fma_(v, k.w, fma_(sa, b.w, mul_(s.w, w.w)));
}
__device__ __forceinline__ f32x2 pkmul_(f32x2 a, f32x2 b) { f32x2 d; asm("v_pk_mul_f32 %0, %1, %2" : "=v"(d) : "v"(a), "v"(b)); return d; }
__device__ __forceinline__ f32x2 pkfma_(f32x2 a, f32x2 b, f32x2 c) { f32x2 d; asm("v_pk_fma_f32 %0, %1, %2, %3" : "=v"(d) : "v"(a), "v"(b), "v"(c)); return d; }
__device__ __forceinline__ f32x2 pkfma_lo_(f32x2 a, f32x2 b, f32x2 c) { f32x2 d; asm("v_pk_fma_f32 %0, %1, %2, %3 op_sel_hi:[0,1,1]" : "=v"(d) : "v"(a), "v"(b), "v"(c)); return d; }
__device__ __forceinline__ f32x2 pkfma_hi_(f32x2 a, f32x2 b, f32x2 c) { f32x2 d; asm("v_pk_fma_f32 %0, %1, %2, %3 op_sel:[1,0,0]" : "=v"(d) : "v"(a), "v"(b), "v"(c)); return d; }
__device__ __forceinline__ float add_(float a, float b) { float d; asm("v_add_f32 %0, %1, %2" : "=v"(d) : "v"(a), "v"(b)); return d; }
#define LO2(v) __builtin_shufflevector(v, v, 0, 1)
#define HI2(v) __builtin_shufflevector(v, v, 2, 3)
__device__ __forceinline__ void phase_scan(const Args& a, LAS unsigned char* lds) {
    const int tid = opaque_tid(), lane = tid & 63, wave = tid >> 6;
    constexpr int TC = 32;
    LAS float* op = (LAS float*)lds;
    LAS float* vb = (LAS float*)(lds + (TC + 1) * 1280);
    LAS float* yb = (LAS float*)(lds + (TC + 1) * 1280 + (TC + 1) * 256);
    const bf16_t* Rg = (const bf16_t*)(a.ws + WS_R); const bf16_t* Kg = (const bf16_t*)(a.ws + WS_K); const bf16_t* Vg = (const bf16_t*)(a.ws + WS_V);
    const bf16_t* Lg = (const bf16_t*)(a.ws + WS_L); const bf16_t* WL2 = (const bf16_t*)(a.ws + WS_WL2);
    constexpr int XS = 68;
    LAS float* xb = (LAS float*)(lds + (TC + 1) * 1280 + (TC + 1) * 256 + TC * 1024);
    const int fr = lane & 15, fq = lane >> 4, stile = wave >> 2, ntile = wave & 3;
    bf16_t* YG = (bf16_t*)(a.ws + WS_YG);
    const int ts = tid >> 4, jg = tid & 15;
    const int ig = lane >> 4;
    const int r0 = wave * 8 + ig * 2;
    for (int hd = blockIdx.x; hd < NB * 16; hd += gridDim.x) {
        const int b = hd >> 4, h = hd & 15;
        const int ch = h * 64 + jg * 4;
        const f32x4 kk4 = *(const f32x4*)(a.in[22] + ch), ka4 = *(const f32x4*)(a.in[23] + ch), rk4 = *(const f32x4*)(a.in[24] + ch);
        const f32x4 lg4 = *(const f32x4*)(a.in[25] + ch), lb4 = *(const f32x4*)(a.in[26] + ch);
        const size_t base = ((size_t)b * T) * D + ch;
        f32x2 S0a = {0.f, 0.f}, S0b = {0.f, 0.f}, S1a = {0.f, 0.f}, S1b = {0.f, 0.f};
        size_t off = base + (size_t)ts * D;
        u32x2 pr = *(const u32x2*)(Rg + off), pk = *(const u32x2*)(Kg + off), pv = *(const u32x2*)(Vg + off);
        const int chn = h * 64 + ntile * 16 + fr;
        bf16x8 bw[2], ba[2], bg[5];
#pragma unroll
        for (int ks = 0; ks < 2; ++ks) { bw[ks] = *(const bf16x8*)(WL2 + (size_t)chn * 512 + ks * 32 + fq * 8); ba[ks] = *(const bf16x8*)(WL2 + (size_t)(1024 + chn) * 512 + 128 + ks * 32 + fq * 8); }
#pragma unroll
        for (int ks = 0; ks < 5; ++ks) bg[ks] = *(const bf16x8*)(WL2 + (size_t)(2048 + chn) * 512 + 256 + ks * 32 + fq * 8);
        const float w0c = a.in[14][chn], a0c = a.in[17][chn];
        bf16x8 aw[2], aa[2], ag[5];
#define LORA_LOAD(cc) do { const bf16_t* lrow = Lg + ((size_t)b * T + (size_t)(cc) * TC + stile * 16 + fr) * 512 + fq * 8; \
            _Pragma("unroll") for (int ks = 0; ks < 2; ++ks) { aw[ks] = *(const bf16x8*)(lrow + ks * 32); aa[ks] = *(const bf16x8*)(lrow + 128 + ks * 32); } \
            _Pragma("unroll") for (int ks = 0; ks < 5; ++ks) ag[ks] = *(const bf16x8*)(lrow + 256 + ks * 32); } while (0)
#define LORA_RUN() do { f32x4 cw = {0.f, 0.f, 0.f, 0.f}, ca = {0.f, 0.f, 0.f, 0.f}, cg_ = {0.f, 0.f, 0.f, 0.f}; \
            _Pragma("unroll") for (int ks = 0; ks < 2; ++ks) { cw = __builtin_amdgcn_mfma_f32_16x16x32_bf16(aw[ks], bw[ks], cw, 0, 0, 0); ca = __builtin_amdgcn_mfma_f32_16x16x32_bf16(aa[ks], ba[ks], ca, 0, 0, 0); } \
            _Pragma("unroll") for (int ks = 0; ks < 5; ++ks) cg_ = __builtin_amdgcn_mfma_f32_16x16x32_bf16(ag[ks], bg[ks], cg_, 0, 0, 0); \
            _Pragma("unroll") for (int e = 0; e < 4; ++e) { const int xi = (stile * 16 + 4 * fq + e) * XS + ntile * 16 + fr; \
                xb[xi] = __builtin_amdgcn_exp2f(-0.87503988f * __builtin_amdgcn_rcpf(1.0f + __expf(-(w0c + cw[e])))); \
                xb[TC * XS + xi] = __builtin_amdgcn_rcpf(1.0f + __expf(-(a0c + ca[e]))); \
                xb[2 * TC * XS + xi] = cg_[e]; } } while (0)
        LORA_LOAD(0); LORA_RUN();
        __syncthreads();
        u32x2 ypend = {0u, 0u};
        for (int c = 0; c < T / TC; ++c) {
            const f32x4 r4 = {bf_lo(pr.x), bf_hi(pr.x), bf_lo(pr.y), bf_hi(pr.y)};
            const f32x4 k4 = {bf_lo(pk.x), bf_hi(pk.x), bf_lo(pk.y), bf_hi(pk.y)};
            const f32x4 v4 = {bf_lo(pv.x), bf_hi(pv.x), bf_lo(pv.y), bf_hi(pv.y)};
            const f32x4 w4 = *(const LAS f32x4*)(xb + ts * XS + jg * 4), a4 = *(const LAS f32x4*)(xb + TC * XS + ts * XS + jg * 4), g4 = *(const LAS f32x4*)(xb + 2 * TC * XS + ts * XS + jg * 4);
            const f32x4 kkx = k4 * kk4;
            const float ss = reduce16((kkx.x * kkx.x + kkx.y * kkx.y) + (kkx.z * kkx.z + kkx.w * kkx.w));
            const float inv = __builtin_amdgcn_rsqf(fmaxf(ss, 1e-24f));
            const f32x4 kk = kkx * inv;
            const f32x4 kf = k4 * ((a4 - 1.0f) * ka4 + 1.0f);
            const f32x4 am = -kk, bm = kk * a4;
            const f32x4 rkr = r4 * kf * rk4;
            const float ct = reduce16((rkr.x + rkr.y) + (rkr.z + rkr.w));
            {
                LAS f32x4* o = (LAS f32x4*)(op + (ts * 16 + jg) * 20);
                o[0] = w4; o[1] = am; o[2] = bm; o[3] = kf; o[4] = r4;
                *(LAS f32x4*)(vb + ts * 64 + jg * 4) = v4;
            }
            __syncthreads();
            if (c > 0) *(u32x2*)(YG + base + (size_t)((c - 1) * TC + ts) * D) = ypend;
            if (c + 1 < T / TC) { off = base + (size_t)((c + 1) * TC + ts) * D;
                pr = *(const u32x2*)(Rg + off); pk = *(const u32x2*)(Kg + off); pv = *(const u32x2*)(Vg + off);
                LORA_LOAD(c + 1); }
            {
                const LAS float* obase = op + (lane & 15) * 20;
                const LAS float* vbase = vb + r0;
                f32x4 ow = *(const LAS f32x4*)(obase), oa = *(const LAS f32x4*)(obase + 4), ob = *(const LAS f32x4*)(obase + 8), ok = *(const LAS f32x4*)(obase + 12), orr = *(const LAS f32x4*)(obase + 16);
                f32x2 vv = *(const LAS f32x2*)(vbase);
#pragma unroll 4
                for (int s = 0; s < TC; ++s) {
                    const LAS float* o = obase + (s + 1) * 320;
                    const f32x4 now = *(const LAS f32x4*)(o), noa = *(const LAS f32x4*)(o + 4), nob = *(const LAS f32x4*)(o + 8), nok = *(const LAS f32x4*)(o + 12), norr = *(const LAS f32x4*)(o + 16);
                    const f32x2 nvv = *(const LAS f32x2*)(vbase + (s + 1) * 64);
                    const f32x2 p0 = pkfma_(S0b, HI2(oa), pkmul_(S0a, LO2(oa))), p1 = pkfma_(S1b, HI2(oa), pkmul_(S1a, LO2(oa)));
                    float sa0 = add_(p0.x, p0.y), sa1 = add_(p1.x, p1.y);
                    sa0 = reduce16(sa0); asm volatile("" : "+v"(sa0)); sa1 = reduce16(sa1);
                    const f32x2 sap = {sa0, sa1};
                    S0a = pkfma_lo_(vv, LO2(ok), pkfma_lo_(sap, LO2(ob), pkmul_(S0a, LO2(ow))));
                    S0b = pkfma_lo_(vv, HI2(ok), pkfma_lo_(sap, HI2(ob), pkmul_(S0b, HI2(ow))));
                    S1a = pkfma_hi_(vv, LO2(ok), pkfma_hi_(sap, LO2(ob), pkmul_(S1a, LO2(ow))));
                    S1b = pkfma_hi_(vv, HI2(ok), pkfma_hi_(sap, HI2(ob), pkmul_(S1b, HI2(ow))));
                    const f32x2 q0 = pkfma_(S0b, HI2(orr), pkmul_(S0a, LO2(orr))), q1 = pkfma_(S1b, HI2(orr), pkmul_(S1a, LO2(orr)));
                    float y0 = add_(q0.x, q0.y), y1 = add_(q1.x, q1.y);
                    y0 += dppf<0xB1>(y0); y1 += dppf<0xB1>(y1); y0 += dppf<0x4E>(y0); y1 += dppf<0x4E>(y1);
                    *(LAS f32x2*)(yb + ((s * 32 + (r0 >> 1)) * 4 + ((lane >> 2) & 3)) * 2) = (f32x2){y0, y1};
                    ow = now; oa = noa; ob = nob; ok = nok; orr = norr; vv = nvv;
                }
            }
            __syncthreads();
            {
                const LAS f32x4* yq = (const LAS f32x4*)(yb + (ts * 32 + 2 * jg) * 8);
                const f32x4 A0 = yq[0], A1 = yq[1], B0 = yq[2], B1 = yq[3];
                const f32x4 y4 = {(A0.x + A0.z) + (A1.x + A1.z), (A0.y + A0.w) + (A1.y + A1.w), (B0.x + B0.z) + (B1.x + B1.z), (B0.y + B0.w) + (B1.y + B1.w)};
                const float mean = reduce16((y4.x + y4.y) + (y4.z + y4.w)) * (1.f / 64.f);
                const f32x4 d = y4 - mean;
                const float var = reduce16((d.x * d.x + d.y * d.y) + (d.z * d.z + d.w * d.w)) * (1.f / 64.f);
                const float rstd = __builtin_amdgcn_rsqf(var + 64e-5f);
                const f32x4 o = ((d * rstd) * lg4 + lb4 + v4 * ct) * g4;
                u32x2 w; w.x = cvt_pk_bf16(o.x, o.y); w.y = cvt_pk_bf16(o.z, o.w);
                ypend = w;
            }
            if (c + 1 < T / TC) LORA_RUN();
            __syncthreads();
        }
        *(u32x2*)(YG + base + (size_t)((T / TC - 1) * TC + ts) * D) = ypend;
#undef LORA_LOAD
#undef LORA_RUN
    }
}


#define SEAM() do { ++ph; if (lo < ph && ph < hi) { if (ph == 1) gsync(grid); else xcd_barrier(xbar); } } while (0)
#define RUN (lo <= ph && ph < hi)
template <int l> __device__ __forceinline__ void layer(const Args& a, LAS unsigned char* lds, cg::grid_group& grid, const XcdBarrier& xbar, int& ph, const int lo, const int hi) {
    unsigned char* ws = a.ws;
    const float* MOD = (const float*)(ws + WS_MOD);
    bf16_t* H = (bf16_t*)(ws + WS_H);
    const int G = gridDim.x, c = blockIdx.x;
    const float* mod = MOD + (size_t)l * 16 * 6144;
    const float* xin = (l == 0) ? a.in[0] : a.out;
    if (RUN) {
        if (l == 1) phase_norm_shift(xin, mod + 0 * 1024, mod + 1 * 1024, a.in[12], (bf16_t*)(ws + WS_X3), (bf16_t*)(ws + WS_H2));
        else if ((threadIdx.x >> 6) < 4) { phase_norm_mod(xin, mod + 0 * 1024, mod + 1 * 1024, H, 0); phase_weights(a, lds); }
        else { phase_weights(a, lds); phase_norm_mod(xin, mod + 0 * 1024, mod + 1 * 1024, H, 0); }
    }
    SEAM();
    if (l == 0) {
        if (RUN) { pg8::Gemm g{H, (const bf16_t*)(ws + WS_WIN0), M, 2048, 1024, 0, 0}; pg8::StaticOrder S; S.init(M, 2048, G, c);
          pg8::EpiAct<1> E{(bf16_t*)(ws + WS_UV), 2048}; pg8::gemm_phase(lds, g, S, E); }
        SEAM();
        if (RUN) phase_sgu(a, lds);
        SEAM();
        if (RUN) { pg8::Gemm g{(const bf16_t*)(ws + WS_Z), (const bf16_t*)(ws + WS_WOUT0), M, 1024, 1024, 0, 0}; pg8::StaticOrder S; S.init(M, 1024, G, c);
          pg8::EpiRes E{a.in[0], a.out, mod + 2 * 1024, 6144}; pg8::gemm_phase(lds, g, S, E); }
    } else {
        if (RUN) {
          { pg8::Gemm g{(const bf16_t*)(ws + WS_H2), (const bf16_t*)(ws + WS_WL1), M, 512, 2048, 0, 1}; pg8::StaticOrder S; S.init(M, 512, G, c, 1);
            pg8::EpiRkvL E{(bf16_t*)(ws + WS_R), (size_t)(WS_K - WS_R) / 2, (bf16_t*)(ws + WS_L), 12}; pg8::gemm_phase(lds, g, S, E); }
          { pg8::Gemm g{(const bf16_t*)(ws + WS_X3), (const bf16_t*)(ws + WS_WRKV), M, 3072, 1024, (long)M * D, 0}; pg8::StaticOrder S; S.init(M, 3072, G, c, 1);
            pg8::EpiRkvL E{(bf16_t*)(ws + WS_R), (size_t)(WS_K - WS_R) / 2, (bf16_t*)(ws + WS_L), 0}; pg8::gemm_phase(lds, g, S, E); }
        }
        SEAM();
        if (RUN) phase_scan(a, lds);
        SEAM();
        if (RUN) { pg8::Gemm g{(const bf16_t*)(ws + WS_YG), (const bf16_t*)(ws + WS_WOUT1), M, 1024, 1024, 0, 0}; pg8::StaticOrder S; S.init(M, 1024, G, c);
          pg8::EpiRes E{a.out, a.out, mod + 2 * 1024, 6144}; pg8::gemm_phase(lds, g, S, E); }
    }
    SEAM();
    if (RUN) phase_norm_mod(a.out, mod + 3 * 1024, mod + 4 * 1024, H, 0);
    SEAM();
    if (RUN) { pg8::Gemm g{H, (const bf16_t*)(ws + WS_W1 + (size_t)l * 4096 * 1024 * 2), M, 4096, 1024, 0, 0}; pg8::StaticOrder S; S.init(M, 4096, G, c);
      pg8::EpiAct<2> E{(bf16_t*)(ws + WS_HID), 4096}; pg8::gemm_phase(lds, g, S, E); }
    SEAM();
    if (RUN) { pg8::Gemm g{(const bf16_t*)(ws + WS_HID), (const bf16_t*)(ws + WS_W2 + (size_t)l * 1024 * 4096 * 2), M, 1024, 4096, 0, 0}; pg8::StaticOrder S; S.init(M, 1024, G, c, 1);
      pg8::EpiRes E{a.out, a.out, mod + 5 * 1024, 6144}; pg8::gemm_phase(lds, g, S, E); }
    SEAM();
}
constexpr int NPHASES = 16;

__global__ void __launch_bounds__(NTHREADS, 2) fwd_megakernel(Args a) {
    extern __shared__ __attribute__((aligned(16))) unsigned char lds_raw[];
    LAS unsigned char* lds = (LAS unsigned char*)lds_raw;
    cg::grid_group grid = cg::this_grid();
    const int lo = a.lo, hi = a.hi;
    int ph = 0;
    volatile LAS unsigned* bst = (volatile LAS unsigned*)(lds + 131072 + 512);
    if (threadIdx.x < 2) bst[threadIdx.x] = 0u;
    __syncthreads();
    XcdBarrier xbar; xbar.bar = (unsigned*)a.ws; xbar.x = 0; xbar.st = nullptr;
    if (hi - lo > 1) xbar = xcd_barrier_post((unsigned*)a.ws, bst);
    if (RUN) phase_prep(a, lds);
    SEAM();
    layer<0>(a, lds, grid, xbar, ph, lo, hi);
    layer<1>(a, lds, grid, xbar, ph, lo, hi);
    if (RUN) phase_final_norm(a.out, a.in[28]);
}
#ifndef N_LAUNCHES
#define N_LAUNCHES 1
#endif

extern "C" void kernel_launch(void* const* d_in, const int* in_sizes, int n_in, void* d_out, int out_size, void* d_ws, size_t ws_size, hipStream_t stream) {
    static int grid = 0;
    if (grid == 0) {
        if (n_in != 29 || out_size != M * D || ws_size < WS_END) { fprintf(stderr, "kernel_launch: unexpected problem: n_in %d out %d ws %zu (need %zu)\n", n_in, out_size, ws_size, (size_t)WS_END); grid = -1; return; }
        int dev = 0, cus = 0, per_cu = 0;
        hipGetDevice(&dev);
        hipDeviceGetAttribute(&cus, hipDeviceAttributeMultiprocessorCount, dev);
        if (hipFuncSetAttribute((const void*)fwd_megakernel, hipFuncAttributeMaxDynamicSharedMemorySize, LDS_BYTES) != hipSuccess) { fprintf(stderr, "kernel_launch: hipFuncSetAttribute failed\n"); grid = -1; return; }
        if (hipOccupancyMaxActiveBlocksPerMultiprocessor(&per_cu, (const void*)fwd_megakernel, NTHREADS, LDS_BYTES) != hipSuccess || per_cu < 1) { fprintf(stderr, "kernel_launch: occupancy query says %d blocks/CU\n", per_cu); per_cu = 1; }
        (void)hipGetLastError();
        grid = cus;
    }
    if (grid < 0) return;
    Args a{};
    for (int i = 0; i < 29; ++i) a.in[i] = (const float*)d_in[i];
    a.out = (float*)d_out; a.ws = (unsigned char*)d_ws;
    if (N_LAUNCHES == 1) {
        if (hipMemsetAsync(d_ws, 0, 16384, stream) != hipSuccess) { fprintf(stderr, "kernel_launch: memset of the barrier words failed\n"); return; }
        a.lo = 0; a.hi = NPHASES;
        void* args[] = {&a};
        hipError_t e = hipLaunchCooperativeKernel((const void*)fwd_megakernel, dim3(grid), dim3(NTHREADS), args, LDS_BYTES, stream);
        if (e != hipSuccess) fprintf(stderr, "kernel_launch: cooperative launch failed: %s (grid %d)\n", hipGetErrorString(e), grid);
    } else {
        for (int p = 0; p < NPHASES; ++p) { a.lo = p; a.hi = p + 1;
            hipLaunchKernelGGL(fwd_megakernel, dim3(grid), dim3(NTHREADS), LDS_BYTES, stream, a); }
    }
}
```

```cpp
#include <hip/hip_runtime.h>
#include <hip/hip_cooperative_groups.h>
#include <cstdio>
#include <cstdint>
namespace cg = cooperative_groups;

#define LAS __attribute__((address_space(3)))
typedef unsigned short bf16_t;
typedef short bf16x8 __attribute__((ext_vector_type(8)));
typedef float f32x4 __attribute__((ext_vector_type(4)));
typedef float f32x2 __attribute__((ext_vector_type(2)));
typedef unsigned u32x4 __attribute__((ext_vector_type(4)));
typedef unsigned u32x2 __attribute__((ext_vector_type(2)));

constexpr int D = 1024, NB = 16, T = 4096, M = NB * T, FF = 4096, NMOD = 6;
constexpr int NTHREADS = 512, NWAVES = 8;

__device__ __forceinline__ int opaque_tid() { int t = threadIdx.x; asm volatile("" : "+v"(t)); return t; }
__device__ __forceinline__ unsigned cvt_pk_bf16(float lo, float hi) { unsigned r; asm volatile("v_cvt_pk_bf16_f32 %0, %1, %2" : "=v"(r) : "v"(lo), "v"(hi)); return r; }
__device__ __forceinline__ float bf_lo(unsigned u) { return __builtin_bit_cast(float, u << 16); }
__device__ __forceinline__ float bf_hi(unsigned u) { return __builtin_bit_cast(float, u & 0xffff0000u); }
__device__ __forceinline__ float sigmoidf_(float x) { return __builtin_amdgcn_rcpf(1.0f + __expf(-x)); }

namespace pg8 {
constexpr int BM = 256, BK = 64, HALF = 128, HTB = HALF * BK * 2, STAGE_BYTES = 8 * HTB, NXCD = 8, WGM = 8;
__host__ __device__ __forceinline__ int lds_byte(int r, int c) { const int st = (r >> 4) * 2 + (c >> 5), rr = r & 15, cc = c & 31, ob = rr * 64 + cc * 2; return st * 1024 + (ob ^ (((ob >> 9) & 1) << 5)); }
__host__ __device__ __forceinline__ void stage_rc(int b, int& R, int& C) { const int st = b / 1024, sb = b % 1024, swz = sb ^ (((sb >> 9) & 1) << 5); R = (st >> 1) * 16 + swz / 64; C = (st & 1) * 32 + (swz % 64) / 2; }
__host__ __device__ __forceinline__ int perm32(int rho) { const int n = rho >> 4, i = rho & 15; return 8 * (i >> 2) + 4 * n + (i & 3); }

struct Unit { int pm, pn; };
struct Gemm { const bf16_t* A; const bf16_t* Bt; int M, N, K; long asplit; int shift; };

struct StaticOrder {
    int nM, nN, nwg, G, c, rev;
    __device__ void init(int M_, int N_, int G_, int c_, int rev_ = 0) { nM = M_ / BM; nN = N_ / BM; nwg = nM * nN; G = G_; c = c_; rev = rev_; }
    __device__ bool next(int i, Unit& u) const {
        const long L = (long)i * G + c; if (L >= nwg) return false;
        int wgid = (int)L; { const int q = nwg / NXCD, r = nwg % NXCD, xcd = wgid % NXCD, off = wgid / NXCD; wgid = (xcd < r ? xcd * (q + 1) : r * (q + 1) + (xcd - r) * q) + off; }
        const int nig = WGM * nN, gid = wgid / nig, fm = gid * WGM, gsz = (nM - fm) < WGM ? (nM - fm) : WGM;
        u.pm = fm + ((wgid % nig) % gsz); u.pn = (wgid % nig) / gsz; if (rev) u.pm = nM - 1 - u.pm; return true;
    }
};

__device__ __forceinline__ f32x2 gelu_pk(f32x2 v) {
    const f32x2 av = __builtin_elementwise_abs(v), d = av * 0.2316418882f + 1.0f;
    f32x2 t; t.x = __builtin_amdgcn_rcpf(d.x); t.y = __builtin_amdgcn_rcpf(d.y);
    f32x2 q = t * 0.5307027145f + (-0.7265760135f); q = q * t + 0.7107068705f; q = q * t + (-0.142248368f); q = q * t + 0.127414796f; q = q * t;
    const f32x2 s = (v * v) * (-0.72134752044f);
    f32x2 e; e.x = __builtin_amdgcn_exp2f(s.x); e.y = __builtin_amdgcn_exp2f(s.y);
    const f32x2 m = v * (q * e), r = v - m;
    f32x2 o; o.x = v.x < 0.f ? m.x : r.x; o.y = v.y < 0.f ? m.y : r.y; return o;
}

template <int ACT  > struct EpiAct {
    static constexpr bool PERM = true;
    bf16_t* O; int ldc;
    __device__ __forceinline__ void operator()(const f32x4 (&acc)[2][2][4][2], const Unit& u, int wr, int wc, int fr, int fq) const {
        const int row0 = u.pm * BM + wr * 64 + fr; const int col0 = u.pn * BM + wc * 32 + 8 * fq;
#pragma unroll
        for (int ai = 0; ai < 2; ++ai)
#pragma unroll
            for (int m = 0; m < 4; ++m) { bf16_t* rowp = O + (size_t)(row0 + ai * HALF + m * 16) * ldc + col0;
#pragma unroll
                for (int bj = 0; bj < 2; ++bj) { f32x4 v0 = acc[ai][bj][m][0], v1 = acc[ai][bj][m][1];
                    if (ACT == 1) { f32x2 a = gelu_pk((f32x2){v0[0], v0[1]}), b = gelu_pk((f32x2){v0[2], v0[3]}), c = gelu_pk((f32x2){v1[0], v1[1]}), d = gelu_pk((f32x2){v1[2], v1[3]});
                        v0 = (f32x4){a.x, a.y, b.x, b.y}; v1 = (f32x4){c.x, c.y, d.x, d.y}; }
                    if (ACT == 2) {
#pragma unroll
                        for (int e = 0; e < 4; ++e) { float p = fmaxf(v0[e], 0.f), q = fmaxf(v1[e], 0.f); v0[e] = p * p; v1[e] = q * q; } }
                    u32x4 w; w.x = cvt_pk_bf16(v0[0], v0[1]); w.y = cvt_pk_bf16(v0[2], v0[3]); w.z = cvt_pk_bf16(v1[0], v1[1]); w.w = cvt_pk_bf16(v1[2], v1[3]);
                    *(u32x4*)(rowp + bj * HALF) = w; } }
    }
};
struct EpiRkvL {
    static constexpr bool PERM = true;
    bf16_t* R; size_t split_stride; bf16_t* L; int pn_off;
    __device__ __forceinline__ void operator()(const f32x4 (&acc)[2][2][4][2], const Unit& u0, int wr, int wc, int fr, int fq) const {
        Unit u = u0; u.pn += pn_off;
        const int row0 = u.pm * BM + wr * 64 + fr;
        bf16_t* base; int ldc, colt, mode;
        if (u.pn < 12) { base = R + (size_t)(u.pn >> 2) * split_stride; colt = (u.pn & 3) * BM; ldc = 1024; mode = 0; }
        else { base = L; colt = (u.pn - 12) * BM; ldc = 512; mode = (u.pn == 12) ? 1 : 2; }
        const int col0 = colt + wc * 32 + 8 * fq;
#pragma unroll
        for (int ai = 0; ai < 2; ++ai)
#pragma unroll
            for (int m = 0; m < 4; ++m) { bf16_t* rowp = base + (size_t)(row0 + ai * HALF + m * 16) * ldc + col0;
#pragma unroll
                for (int bj = 0; bj < 2; ++bj) { f32x4 v0 = acc[ai][bj][m][0], v1 = acc[ai][bj][m][1];
                    if (mode == 1 && bj == 0) {
#pragma unroll
                        for (int e = 0; e < 4; ++e) { v0[e] = tanhf(v0[e]); v1[e] = tanhf(v1[e]); } }
                    if (mode == 2) {
#pragma unroll
                        for (int e = 0; e < 4; ++e) { v0[e] = sigmoidf_(v0[e]); v1[e] = sigmoidf_(v1[e]); } }
                    u32x4 w; w.x = cvt_pk_bf16(v0[0], v0[1]); w.y = cvt_pk_bf16(v0[2], v0[3]); w.z = cvt_pk_bf16(v1[0], v1[1]); w.w = cvt_pk_bf16(v1[2], v1[3]);
                    *(u32x4*)(rowp + bj * HALF) = w; } }
    }
};
struct EpiL2 {
    static constexpr bool PERM = true;
    bf16_t* O0; bf16_t* O1; bf16_t* O2; const float* w0; const float* a0;
    __device__ __forceinline__ void operator()(const f32x4 (&acc)[2][2][4][2], const Unit& u, int wr, int wc, int fr, int fq) const {
        const int mode = u.pn >> 2;
        const int row0 = u.pm * BM + wr * 64 + fr; const int col0 = (u.pn & 3) * BM + wc * 32 + 8 * fq;
        bf16_t *o0 = O0, *o1 = O1, *o2 = O2; const float *bw = w0, *ba = a0;
        asm volatile("" : "+s"(o0), "+s"(o1), "+s"(o2), "+s"(bw), "+s"(ba));
        bf16_t* base = (mode == 0) ? o0 : ((mode == 1) ? o1 : o2);
        const float* bias = (mode == 0) ? bw : ba;
#pragma unroll
        for (int bj = 0; bj < 2; ++bj) {
            f32x4 b0 = {0.f, 0.f, 0.f, 0.f}, b1 = {0.f, 0.f, 0.f, 0.f};
            if (mode != 2) { b0 = *(const f32x4*)(bias + col0 + bj * HALF); b1 = *(const f32x4*)(bias + col0 + bj * HALF + 4); }
#pragma unroll
            for (int ai = 0; ai < 2; ++ai)
#pragma unroll
                for (int m = 0; m < 4; ++m) { bf16_t* rowp = base + (size_t)(row0 + ai * HALF + m * 16) * 1024 + col0;
                    f32x4 v0 = acc[ai][bj][m][0] + b0, v1 = acc[ai][bj][m][1] + b1;
                    if (mode != 2) {
                        const float sc = (mode == 0) ? -0.87503988f : 1.0f;
#pragma unroll
                        for (int e = 0; e < 4; ++e) { v0[e] = sc * __builtin_amdgcn_rcpf(1.0f + __expf(-v0[e])); v1[e] = sc * __builtin_amdgcn_rcpf(1.0f + __expf(-v1[e])); } }
                    u32x4 w; w.x = cvt_pk_bf16(v0[0], v0[1]); w.y = cvt_pk_bf16(v0[2], v0[3]); w.z = cvt_pk_bf16(v1[0], v1[1]); w.w = cvt_pk_bf16(v1[2], v1[3]);
                    *(u32x4*)(rowp + bj * HALF) = w;
                    if (m & 1) asm volatile("" ::: "memory"); }
        }
    }
};
struct EpiRes {
    static constexpr bool PERM = false;
    const float* base; float* out; const float* gate;
    int gstride;
    __device__ __forceinline__ void operator()(const f32x4 (&acc)[2][2][4][2], const Unit& u, int wr, int wc, int fr, int fq) const {
        const int col0 = u.pn * BM + wc * 32 + 4 * fq;
        const float* gp = gate + (size_t)(u.pm >> 4) * gstride + col0;
        f32x4 gv[2][2];
#pragma unroll
        for (int bj = 0; bj < 2; ++bj)
#pragma unroll
            for (int n = 0; n < 2; ++n) gv[bj][n] = *(const f32x4*)(gp + bj * HALF + n * 16);
#pragma unroll
        for (int ai = 0; ai < 2; ++ai)
#pragma unroll
            for (int m = 0; m < 4; ++m) { const size_t off = (size_t)(u.pm * BM + ai * HALF + wr * 64 + m * 16 + fr) * 1024 + col0;
#pragma unroll
                for (int bj = 0; bj < 2; ++bj)
#pragma unroll
                    for (int n = 0; n < 2; ++n) { const f32x4 bs = *(const f32x4*)(base + off + bj * HALF + n * 16);
                        *(f32x4*)(out + off + bj * HALF + n * 16) = bs + gv[bj][n] * acc[ai][bj][m][n]; } }
    }
};

template <class Epi>
__device__ __forceinline__ void gemm_phase(LAS unsigned char* lds, const Gemm g, const StaticOrder& S, const Epi& E) {
    const int tid = opaque_tid(), wid = __builtin_amdgcn_readfirstlane(tid >> 6), lane = tid & 63, wr = wid >> 2, wc = wid & 3, fr = lane & 15, fq = lane >> 4;
    int K_ = g.K; asm volatile("" : "+s"(K_));
    const int K = K_, nt = K / BK, lda = g.shift ? (K_ >> 1) : K_;
    const int ntA = g.shift ? (nt >> 1) : (1 << 30);
    const long adj = g.shift ? ((long)lda * 2 + (long)ntA * (BK * 2)) : 0;
    unsigned voffA[2], voffB[2];
#pragma unroll
    for (int i = 0; i < 2; ++i) { int R, C; stage_rc(tid * 16 + i * 8192, R, C); const int Rb = Epi::PERM ? ((R & ~31) + perm32(R & 31)) : R;
        voffA[i] = (unsigned)(R * lda + C) * 2u; voffB[i] = (unsigned)(Rb * K + C) * 2u; }
    const long kstep = (long)(BK * 2);
    const long hstepA = (long)HALF * lda * 2, hstepB = (long)HALF * K * 2, tstepB = 2 * hstepB;
    const unsigned ldsw = (unsigned)wid * 1024u;
    const int aoff = lds_byte(wr * 64 + fr, fq * 8), boff = lds_byte(wc * 32 + fr, fq * 8);
#define PG8_ABASE(u) ((const char*)g.A + ((long)((u).pn >> 2) * g.asplit + ((long)(u).pm * BM + (g.shift ? ((u).pm >> 4) + 1 : 0)) * (long)lda) * 2)
#define PG8_APTR(base, kt) ((base) + ((long)(kt) * kstep - (((kt) >= ntA) ? adj : 0)))
#define PG8_SA(b, h) (((b) * 2 + (h)) * HTB)
#define PG8_SB(b, h) ((4 + (b) * 2 + (h)) * HTB)
#define PG8_STAGE(bufoff, gbase, voff) do { _Pragma("unroll") for (int _i = 0; _i < 2; ++_i) \
        __builtin_amdgcn_global_load_lds((const unsigned*)((const char*)(gbase) + (voff)[_i]), (LAS unsigned*)(lds + (bufoff) + ldsw + _i * 8192), 16, 0, 0); } while (0)
#define PG8_LDA(dst, b, h) do { _Pragma("unroll") for (int m = 0; m < 4; ++m) _Pragma("unroll") for (int k = 0; k < 2; ++k) dst[m][k] = *(const LAS bf16x8*)(lds + PG8_SA(b, h) + aoff + m * 2048 + k * 1024); } while (0)
#define PG8_LDB(dst, b, h) do { _Pragma("unroll") for (int n = 0; n < 2; ++n) _Pragma("unroll") for (int k = 0; k < 2; ++k) dst[n][k] = *(const LAS bf16x8*)(lds + PG8_SB(b, h) + boff + n * 2048 + k * 1024); } while (0)
#define PG8_MMA(ai, bj, At, Bt) do { __builtin_amdgcn_s_setprio(1); _Pragma("unroll") for (int m = 0; m < 4; ++m) _Pragma("unroll") for (int n = 0; n < 2; ++n) _Pragma("unroll") for (int k = 0; k < 2; ++k) \
        acc[ai][bj][m][n] = __builtin_amdgcn_mfma_f32_16x16x32_bf16(Bt[n][k], At[m][k], acc[ai][bj][m][n], 0, 0, 0); __builtin_amdgcn_s_setprio(0); } while (0)
#define PG8_WAIT_V(n) asm volatile("s_waitcnt vmcnt(" #n ")" ::: "memory")
#define PG8_WAIT_L(n) asm volatile("s_waitcnt lgkmcnt(" #n ")" ::: "memory")
#define PG8_BAR __builtin_amdgcn_s_barrier()
#define PG8_SCHED __builtin_amdgcn_sched_barrier(0)
    Unit cur, nxt; int ui = 0;
    if (!S.next(0, cur)) return;
    f32x4 acc[2][2][4][2];
#pragma unroll
    for (int a = 0; a < 2; ++a)
#pragma unroll
        for (int b = 0; b < 2; ++b)
#pragma unroll
            for (int m = 0; m < 4; ++m)
#pragma unroll
                for (int n = 0; n < 2; ++n) acc[a][b][m][n] = (f32x4){0.f, 0.f, 0.f, 0.f};
    bf16x8 At[4][2], B0[2][2], B1[2][2];
    const char* cA = PG8_ABASE(cur); const char* cB = (const char*)g.Bt + (long)cur.pn * tstepB;
    PG8_STAGE(PG8_SB(0, 0), cB, voffB); PG8_STAGE(PG8_SB(0, 1), cB + hstepB, voffB); PG8_STAGE(PG8_SA(0, 0), cA, voffA); PG8_STAGE(PG8_SA(0, 1), cA + hstepA, voffA);
    if (wr == 1) PG8_BAR;
    PG8_WAIT_V(2); PG8_BAR;
    PG8_STAGE(PG8_SB(1, 0), cB + kstep, voffB); PG8_STAGE(PG8_SA(1, 0), cA + kstep, voffA); PG8_STAGE(PG8_SB(1, 1), cB + hstepB + kstep, voffB);
    PG8_WAIT_V(6); PG8_BAR;
    for (;;) {
        const bool has_next = S.next(ui + 1, nxt);
        const char* nA = has_next ? PG8_ABASE(nxt) : cA; const char* nB = has_next ? (const char*)g.Bt + (long)nxt.pn * tstepB : cB;
        for (int t = 0; t < nt; t += 2) {
            const bool last = (t == nt - 2);
            const char* a1 = PG8_APTR(cA, t + 1);
            const char* a2 = last ? nA : PG8_APTR(cA, t + 2); const char* b2 = last ? nB : cB + (long)(t + 2) * kstep;
            const char* a3 = a2 + kstep; const char* b3 = b2 + kstep;
            PG8_LDB(B0, 0, 0); PG8_LDB(B1, 0, 1); PG8_SCHED; PG8_LDA(At, 0, 0); PG8_STAGE(PG8_SA(1, 1), a1 + hstepA, voffA);
            PG8_WAIT_V(8); PG8_WAIT_L(0); PG8_BAR; PG8_MMA(0, 0, At, B0); PG8_MMA(0, 1, At, B1); PG8_BAR; PG8_SCHED;
            PG8_LDA(At, 0, 1); PG8_STAGE(PG8_SB(0, 0), b2, voffB); PG8_STAGE(PG8_SB(0, 1), b2 + hstepB, voffB); PG8_STAGE(PG8_SA(0, 0), a2, voffA);
            PG8_WAIT_V(8); PG8_WAIT_L(0); PG8_BAR; PG8_MMA(1, 0, At, B0); PG8_MMA(1, 1, At, B1); PG8_BAR; PG8_SCHED;
            PG8_LDB(B0, 1, 0); PG8_LDB(B1, 1, 1); PG8_SCHED; PG8_LDA(At, 1, 0); PG8_STAGE(PG8_SA(0, 1), a2 + hstepA, voffA);
            PG8_WAIT_V(8); PG8_WAIT_L(0); PG8_BAR; PG8_MMA(0, 0, At, B0); PG8_MMA(0, 1, At, B1); PG8_BAR; PG8_SCHED;
            PG8_LDA(At, 1, 1); PG8_STAGE(PG8_SB(1, 0), b3, voffB); PG8_STAGE(PG8_SB(1, 1), b3 + hstepB, voffB); PG8_STAGE(PG8_SA(1, 0), a3, voffA);
            PG8_WAIT_V(8); PG8_WAIT_L(0); PG8_BAR; PG8_MMA(1, 0, At, B0); PG8_MMA(1, 1, At, B1); PG8_BAR; PG8_SCHED;
        }
        if (wr == 0) PG8_BAR;
        E(acc, cur, wr, wc, fr, fq);
        if (!has_next) break;
#pragma unroll
        for (int a = 0; a < 2; ++a)
#pragma unroll
            for (int b = 0; b < 2; ++b)
#pragma unroll
                for (int m = 0; m < 4; ++m)
#pragma unroll
                    for (int n = 0; n < 2; ++n) acc[a][b][m][n] = (f32x4){0.f, 0.f, 0.f, 0.f};
        cur = nxt; cA = nA; cB = nB; ++ui;
        if (wr == 1) PG8_BAR;
    }
    PG8_WAIT_V(0);
    PG8_BAR;
#undef PG8_ABASE
#undef PG8_APTR
#undef PG8_SA
#undef PG8_SB
#undef PG8_STAGE
#undef PG8_LDA
#undef PG8_LDB
#undef PG8_MMA
#undef PG8_WAIT_V
#undef PG8_WAIT_L
#undef PG8_BAR
#undef PG8_SCHED
}
}

constexpr size_t MiB = 1u << 20;
constexpr size_t WS_MOD = 1 * MiB;
constexpr size_t WS_WIN0 = 2 * MiB;
constexpr size_t WS_WOUT0 = 6 * MiB;
constexpr size_t WS_W1 = 8 * MiB;
constexpr size_t WS_W2 = 24 * MiB;
constexpr size_t WS_WRKV = 40 * MiB;
constexpr size_t WS_WL1 = 46 * MiB;
constexpr size_t WS_WL2 = 48 * MiB;
constexpr size_t WS_WOUT1 = 51 * MiB;
constexpr size_t WS_WS = 53 * MiB;
constexpr size_t WS_H = 60 * MiB;
constexpr size_t WS_UV = 188 * MiB;
constexpr size_t WS_Z = 444 * MiB;
constexpr size_t WS_HID = 188 * MiB;
constexpr size_t WS_X3 = 54 * MiB;
constexpr size_t WS_H2 = 438 * MiB;
constexpr size_t WS_L = 952 * MiB;
constexpr size_t WS_R = 567 * MiB, WS_K = 695 * MiB, WS_V = 823 * MiB;
constexpr size_t WS_WE = 60 * MiB, WS_A = 188 * MiB, WS_G = 316 * MiB;
constexpr size_t WS_YG = 54 * MiB;
constexpr size_t WS_END = 1020 * MiB;
constexpr int LDS_BYTES = 147456;

struct Args {
    const float* in[29];
    float* out; unsigned char* ws;
    int lo, hi;
};

__device__ __forceinline__ float wave_sum(float v) {
#pragma unroll
    for (int o = 1; o < 64; o <<= 1) v += __shfl_xor(v, o);
    return v;
}
template <int CTRL> __device__ __forceinline__ float dppf(float v) { return __builtin_bit_cast(float, __builtin_amdgcn_update_dpp(0, __builtin_bit_cast(int, v), CTRL, 0xF, 0xF, true)); }
__device__ __forceinline__ float reduce16(float v) {
    v += dppf<0xB1>(v); v += dppf<0x4E>(v); v += dppf<0x141>(v); v += dppf<0x140>(v); return v;
}

#define XB_TMO      128
#define XB_XCNT(j)  (256  + 64 * (j))
#define XB_XSUB(j)  (1280 + 64 * (j))
#define XB_XGEN(j)  (2304 + 64 * (j))
#define XB_TOP      3328
#define XB_TOPGEN   3392
#define XCD_BAR_WORDS 3456
#define XB_SPIN_CAP (1u << 18)

__device__ __forceinline__ unsigned xb_ld(unsigned* p)              { return __hip_atomic_load(p, __ATOMIC_RELAXED, __HIP_MEMORY_SCOPE_AGENT); }
__device__ __forceinline__ unsigned xb_add(unsigned* p, unsigned v) { return __hip_atomic_fetch_add(p, v, __ATOMIC_RELAXED, __HIP_MEMORY_SCOPE_AGENT); }
__device__ __forceinline__ unsigned xb_xcc_id() { return (unsigned)__builtin_amdgcn_s_getreg((3 << 11) | 20) & 0xFu; }
#define XB_SPIN(cond, bar) do { unsigned _sp = 0; while (cond) { __builtin_amdgcn_s_sleep(1); \
    if ((++_sp & 255u) == 0u) { if (xb_ld(&(bar)[XB_TMO])) break; if (_sp > XB_SPIN_CAP) { atomicAdd(&(bar)[XB_TMO], 1u); break; } } } } while (0)

struct XcdBarrier {
    unsigned* bar; unsigned x;
    volatile LAS unsigned* st;
};

__device__ __forceinline__ XcdBarrier xcd_barrier_post(unsigned* bar, volatile LAS unsigned* st) {
    XcdBarrier b; b.bar = bar; b.x = xb_xcc_id(); b.st = st;
    if (threadIdx.x == 0) (void)xb_add(&bar[XB_XCNT(b.x)], 1u);
    return b;
}
__device__ __forceinline__ void xcd_barrier_complete(unsigned* bar, unsigned x, unsigned& nloc, unsigned& nx) {
    const unsigned G = gridDim.x * gridDim.y * gridDim.z;
    unsigned sum, cnt, mine, sp = 0u;
    for (;;) {
        sum = 0u; cnt = 0u; mine = 0u;
#pragma unroll
        for (unsigned j = 0; j < 16; ++j) { const unsigned c = xb_ld(&bar[XB_XCNT(j)]); sum += c; cnt += (c > 0u) ? 1u : 0u; mine = (j == x) ? c : mine; }
        if (sum == G) break;
        __builtin_amdgcn_s_sleep(1);
        if ((++sp & 255u) == 0u) { if (xb_ld(&bar[XB_TMO])) break; if (sp > XB_SPIN_CAP) { atomicAdd(&bar[XB_TMO], 1u); break; } }
    }
    nloc = mine > 0u ? mine : 1u; nx = cnt > 0u ? cnt : 1u;
}

__device__ __forceinline__ void xcd_barrier(const XcdBarrier& b) {
    asm volatile("s_waitcnt vmcnt(0)" ::: "memory");
    __syncthreads();
    if (threadIdx.x == 0) {
        unsigned* bar = b.bar;
        __builtin_amdgcn_s_waitcnt(0);
        unsigned nloc = b.st[0], nx = b.st[1];
        if (nloc == 0u) { xcd_barrier_complete(bar, b.x, nloc, nx); b.st[0] = nloc; b.st[1] = nx; }
        const unsigned old = xb_add(&bar[XB_XSUB(b.x)], 1u);
        const unsigned gen = old / nloc;
        if (old + 1u == (gen + 1u) * nloc) {
            __builtin_amdgcn_fence(__ATOMIC_RELEASE, "agent");
            asm volatile("s_waitcnt vmcnt(0)" ::: "memory");
            const unsigned og = xb_add(&bar[XB_TOP], 1u);
            const unsigned tg = og / nx;
            if (og + 1u == (tg + 1u) * nx) xb_add(&bar[XB_TOPGEN], 1u);
            else XB_SPIN(xb_ld(&bar[XB_TOPGEN]) == tg, bar);
            __builtin_amdgcn_fence(__ATOMIC_ACQUIRE, "agent");
            xb_add(&bar[XB_XGEN(b.x)], 1u);
            asm volatile("s_waitcnt vmcnt(0)" ::: "memory");
        } else {
            XB_SPIN(xb_ld(&bar[XB_XGEN(b.x)]) == gen, bar);
            __builtin_amdgcn_fence(__ATOMIC_ACQUIRE, "agent");
            asm volatile("s_waitcnt vmcnt(0)" ::: "memory");
        }
    }
    __syncthreads();
}


__device__ __forceinline__ void gsync(cg::grid_group& grid) {
    asm volatile("s_waitcnt vmcnt(0) lgkmcnt(0)" ::: "memory");
    grid.sync();
    if (threadIdx.x < 64) { __builtin_amdgcn_fence(__ATOMIC_ACQUIRE, "agent"); asm volatile("s_waitcnt vmcnt(0)" ::: "memory"); }
    __syncthreads();
}
__device__ __forceinline__ void transpose_item(const float* W, int lds_, int Ksrc, int Nsrc, bf16_t* WT, int ldd, int row_off, int col_off,
                                               const float* mu, int mode, LAS float* scr, int kb, int nb, int lane) {
    const int k0 = 64 * kb, n0 = 32 * nb;
#pragma unroll 8
    for (int i = 0; i < 32; ++i) { const int kk = 2 * i + (lane >> 5), nn = lane & 31, k = k0 + kk, n = n0 + nn;
        float v = (k < Ksrc && n < Nsrc) ? W[(size_t)k * lds_ + n] : 0.f;
        if (mode) { const float m = mu[k & 1023]; v *= (mode == 1) ? (1.f - m) : m; }
        scr[kk * 33 + nn] = v; }
    asm volatile("s_waitcnt lgkmcnt(0)" ::: "memory");
    const int c = lane & 7;
#pragma unroll
    for (int j = 0; j < 4; ++j) { const int n = (lane >> 3) + 8 * j; const LAS float* s = scr + (8 * c) * 33 + n;
        u32x4 o; o.x = cvt_pk_bf16(s[0 * 33], s[1 * 33]); o.y = cvt_pk_bf16(s[2 * 33], s[3 * 33]); o.z = cvt_pk_bf16(s[4 * 33], s[5 * 33]); o.w = cvt_pk_bf16(s[6 * 33], s[7 * 33]);
        *(u32x4*)(WT + (size_t)(row_off + n0 + n) * ldd + col_off + k0 + 8 * c) = o; }
    asm volatile("s_waitcnt lgkmcnt(0)" ::: "memory");
}

__device__ __forceinline__ void phase_prep(const Args& a, LAS unsigned char* lds) {
    const int tid = opaque_tid(), lane = tid & 63, wave = tid >> 6;
    unsigned char* ws = a.ws;
    {
        LAS float* sc = (LAS float*)lds;
        LAS float* red = (LAS float*)(lds + 65536);
        bool have = false;
        for (int it = blockIdx.x; it < 2 * 96; it += gridDim.x) {
            if (!have) { const float* c = a.in[1];
                for (int e = tid; e < 16 * 1024; e += NTHREADS) { const int b = e >> 10, k = e & 1023; const float x = c[e]; sc[k * 16 + b] = x / (1.f + __expf(-x)); }
                have = true; }
            __syncthreads();
            const int l = it / 96, n0 = (it % 96) * 64;
            const float* w = a.in[2] + (size_t)l * 1024 * 6144 + n0 + lane;
            float acc[16];
#pragma unroll
            for (int b = 0; b < 16; ++b) acc[b] = 0.f;
            const int kbeg = wave * 128;
#pragma unroll 8
            for (int k = kbeg; k < kbeg + 128; ++k) { const float wv = w[(size_t)k * 6144];
                const LAS f32x4* s4 = (const LAS f32x4*)(sc + k * 16);
#pragma unroll
                for (int q = 0; q < 4; ++q) { const f32x4 s = s4[q]; acc[4 * q] += s[0] * wv; acc[4 * q + 1] += s[1] * wv; acc[4 * q + 2] += s[2] * wv; acc[4 * q + 3] += s[3] * wv; } }
#pragma unroll
            for (int b = 0; b < 16; ++b) red[(wave * 16 + b) * 64 + lane] = acc[b];
            __syncthreads();
            float* mod = (float*)(ws + WS_MOD);
            for (int e = tid; e < 1024; e += NTHREADS) { const int b = e >> 6, n = e & 63; float s = 0.f;
#pragma unroll
                for (int wv = 0; wv < 8; ++wv) s += red[(wv * 16 + b) * 64 + n];
                mod[((size_t)l * 16 + b) * 6144 + n0 + n] = s + a.in[3][l * 6144 + n0 + n]; }
            __syncthreads();
        }
        __syncthreads();
    }
}
__device__ __forceinline__ void phase_weights(const Args& a, LAS unsigned char* lds) {
    const int tid = opaque_tid(), lane = tid & 63, wave = tid >> 6;
    unsigned char* ws = a.ws;
    {
        LAS float* scr = (LAS float*)(lds + wave * 16384);
        const int gw = blockIdx.x * NWAVES + wave, NGW = gridDim.x * NWAVES;
        const float* mu = a.in[12];
        constexpr int TOTAL = 16 * 64 + 16 * 32 + 2 * 16 * 128 + 2 * 64 * 32 + 3 * 16 * 32 + 2 * (16 * 4 + 16 * 4 + 16 * 8) + 24 * 32 + 16 * 32;
        for (int it = gw; it < TOTAL; it += NGW) {
            int r = it;
#define JOB(W, LDSRC, KS, NS, DST, LDD, RO, CO, MU, MODE, KB, NBK) if (r >= 0) { if (r < (KB) * (NBK)) { transpose_item((W), (LDSRC), (KS), (NS), (bf16_t*)(ws + (DST)), (LDD), (RO), (CO), (MU), (MODE), scr, r / (NBK), r % (NBK), lane); r = -1; } else r -= (KB) * (NBK); }
            JOB(a.in[6], 2048, 1024, 2048, WS_WIN0, 1024, 0, 0, mu, 0, 16, 64)
            JOB(a.in[11], 1024, 1024, 1024, WS_WOUT0, 1024, 0, 0, mu, 0, 16, 32)
            JOB(a.in[4], 4096, 1024, 4096, WS_W1, 1024, 0, 0, mu, 0, 16, 128)
            JOB(a.in[4] + (size_t)1024 * 4096, 4096, 1024, 4096, WS_W1 + (size_t)4096 * 1024 * 2, 1024, 0, 0, mu, 0, 16, 128)
            JOB(a.in[5], 1024, 4096, 1024, WS_W2, 4096, 0, 0, mu, 0, 64, 32)
            JOB(a.in[5] + (size_t)4096 * 1024, 1024, 4096, 1024, WS_W2 + (size_t)1024 * 4096 * 2, 4096, 0, 0, mu, 0, 64, 32)
            JOB(a.in[13] + 0, 3072, 1024, 1024, WS_WRKV, 1024, 0, 0, mu, 0, 16, 32)
            JOB(a.in[13] + 1024, 3072, 1024, 1024, WS_WRKV, 1024, 1024, 0, mu, 0, 16, 32)
            JOB(a.in[13] + 2048, 3072, 1024, 1024, WS_WRKV, 1024, 2048, 0, mu, 0, 16, 32)
            JOB(a.in[15], 64, 1024, 64, WS_WL1, 2048, 0, 0, mu + 1 * 1024, 1, 16, 4)
            JOB(a.in[15], 64, 1024, 64, WS_WL1, 2048, 0, 1024, mu + 1 * 1024, 2, 16, 4)
            JOB(a.in[18], 64, 1024, 64, WS_WL1, 2048, 128, 0, mu + 4 * 1024, 1, 16, 4)
            JOB(a.in[18], 64, 1024, 64, WS_WL1, 2048, 128, 1024, mu + 4 * 1024, 2, 16, 4)
            JOB(a.in[20], 160, 1024, 160, WS_WL1, 2048, 256, 0, mu + 5 * 1024, 1, 16, 8)
            JOB(a.in[20], 160, 1024, 160, WS_WL1, 2048, 256, 1024, mu + 5 * 1024, 2, 16, 8)
            JOB(a.in[16], 1024, 64, 1024, WS_WL2, 512, 0, 0, mu, 0, 2, 32)
            JOB(a.in[16], 1024, 0, 1024, WS_WL2, 512, 0, 128, mu, 0, 6, 32)
            JOB(a.in[19], 1024, 0, 1024, WS_WL2, 512, 1024, 0, mu, 0, 2, 32)
            JOB(a.in[19], 1024, 64, 1024, WS_WL2, 512, 1024, 128, mu, 0, 2, 32)
            JOB(a.in[19], 1024, 0, 1024, WS_WL2, 512, 1024, 256, mu, 0, 4, 32)
            JOB(a.in[21], 1024, 0, 1024, WS_WL2, 512, 2048, 0, mu, 0, 4, 32)
            JOB(a.in[21], 1024, 160, 1024, WS_WL2, 512, 2048, 256, mu, 0, 4, 32)
            JOB(a.in[27], 1024, 1024, 1024, WS_WOUT1, 1024, 0, 0, mu, 0, 16, 32)
#undef JOB
        }
        bf16_t* wsb = (bf16_t*)(ws + WS_WS);
        for (int e = blockIdx.x * NTHREADS + tid; e < 8 * 128 * 128 / 2; e += gridDim.x * NTHREADS) {
            const int i = e * 2, s = i & 127, t = (i >> 7) & 127;
            const float v0 = (s <= t) ? a.in[9][i] : 0.f, v1 = (s + 1 <= t) ? a.in[9][i + 1] : 0.f;
            ((unsigned*)wsb)[e] = cvt_pk_bf16(v0, v1);
        }
    }
}

__device__ __forceinline__ void phase_norm_mod(const float* x, const float* mod_shift, const float* mod_scale, bf16_t* H, int) {
    const int tid = opaque_tid(), lane = tid & 63, wave = tid >> 6;
    const int gw = blockIdx.x * NWAVES + wave, NGW = gridDim.x * NWAVES;
    constexpr int NR = 4;
    for (int m0 = gw; m0 < M; m0 += NR * NGW) {
        f32x4 v[NR][4];
#pragma unroll
        for (int r = 0; r < NR; ++r) { const int m = M - 1 - (m0 + r * NGW < M ? m0 + r * NGW : m0); const f32x4* xr = (const f32x4*)(x + (size_t)m * D) + lane;
#pragma unroll
            for (int j = 0; j < 4; ++j) v[r][j] = xr[64 * j]; }
#pragma unroll
        for (int r = 0; r < NR; ++r) { const int m = M - 1 - (m0 + r * NGW); if (m >= 0) {
            const int b = m >> 12; float s = 0.f;
#pragma unroll
            for (int j = 0; j < 4; ++j) s += (v[r][j].x * v[r][j].x + v[r][j].y * v[r][j].y) + (v[r][j].z * v[r][j].z + v[r][j].w * v[r][j].w);
            const float rstd = 1.0f / sqrtf(wave_sum(s) * (1.f / D) + 1e-6f);
            const f32x4* sh = (const f32x4*)(mod_shift + (size_t)b * 6144) + lane;
            const f32x4* sc = (const f32x4*)(mod_scale + (size_t)b * 6144) + lane;
            u32x2* o = (u32x2*)(H + (size_t)m * D) + lane;
#pragma unroll
            for (int j = 0; j < 4; ++j) { const f32x4 a = sh[64 * j], c = sc[64 * j]; const f32x4 h = v[r][j] * rstd * (c + 1.0f) + a;
                u32x2 w; w.x = cvt_pk_bf16(h.x, h.y); w.y = cvt_pk_bf16(h.z, h.w); o[64 * j] = w; } } }
    }
}
__device__ __forceinline__ void phase_final_norm(float* x, const float* g) {
    const int tid = opaque_tid(), lane = tid & 63, wave = tid >> 6;
    const int gw = blockIdx.x * NWAVES + wave, NGW = gridDim.x * NWAVES;
    constexpr int NR = 4;
    f32x4 gg[4];
#pragma unroll
    for (int j = 0; j < 4; ++j) gg[j] = ((const f32x4*)g)[lane + 64 * j];
    for (int m0 = gw; m0 < M; m0 += NR * NGW) {
        f32x4 v[NR][4];
#pragma unroll
        for (int r = 0; r < NR; ++r) { const int m = (m0 + r * NGW < M ? m0 + r * NGW : m0); const f32x4* xr = (const f32x4*)(x + (size_t)m * D) + lane;
#pragma unroll
            for (int j = 0; j < 4; ++j) v[r][j] = xr[64 * j]; }
#pragma unroll
        for (int r = 0; r < NR; ++r) { const int m = m0 + r * NGW; if (m < M) {
            float s = 0.f;
#pragma unroll
            for (int j = 0; j < 4; ++j) s += (v[r][j].x * v[r][j].x + v[r][j].y * v[r][j].y) + (v[r][j].z * v[r][j].z + v[r][j].w * v[r][j].w);
            const float rstd = 1.0f / sqrtf(wave_sum(s) * (1.f / D) + 1e-6f);
            f32x4* xr = (f32x4*)(x + (size_t)m * D) + lane;
#pragma unroll
            for (int j = 0; j < 4; ++j) xr[64 * j] = v[r][j] * rstd * gg[j]; } }
    }
}
__device__ __forceinline__ void load_row(const float* x, size_t m, int lane, f32x4 (&v)[4]) {
    const f32x4* xr = (const f32x4*)(x + m * D) + lane;
#pragma unroll
    for (int j = 0; j < 4; ++j) v[j] = xr[64 * j];
}
__device__ __forceinline__ void finish_row(f32x4 (&h)[4], const f32x4 (&sh)[4], const f32x4 (&sc1)[4]) {
    float s = 0.f;
#pragma unroll
    for (int j = 0; j < 4; ++j) s += (h[j].x * h[j].x + h[j].y * h[j].y) + (h[j].z * h[j].z + h[j].w * h[j].w);
    const float rstd = 1.0f / sqrtf(wave_sum(s) * (1.f / D) + 1e-6f);
#pragma unroll
    for (int j = 0; j < 4; ++j) h[j] = h[j] * rstd * sc1[j] + sh[j];
}
__device__ __forceinline__ void phase_norm_shift(const float* x, const float* mod_shift, const float* mod_scale, const float* mu, bf16_t* X3, bf16_t* H2) {
    const int tid = opaque_tid(), lane = tid & 63, wave = tid >> 6;
    const int gw = blockIdx.x * NWAVES + wave, NGW = gridDim.x * NWAVES;
    f32x4 mr[4], mk[4], mv[4];
#pragma unroll
    for (int j = 0; j < 4; ++j) { mr[j] = ((const f32x4*)(mu + 0 * 1024))[lane + 64 * j]; mk[j] = ((const f32x4*)(mu + 2 * 1024))[lane + 64 * j]; mv[j] = ((const f32x4*)(mu + 3 * 1024))[lane + 64 * j]; }
    for (int blk = gw; blk < M / 32; blk += NGW) {
        const size_t m0 = (size_t)blk * 32; const int b = (int)(m0 >> 12);
        f32x4 sh[4], sc1[4];
#pragma unroll
        for (int j = 0; j < 4; ++j) { sh[j] = ((const f32x4*)(mod_shift + (size_t)b * 6144))[lane + 64 * j]; sc1[j] = ((const f32x4*)(mod_scale + (size_t)b * 6144))[lane + 64 * j] + 1.0f; }
        f32x4 hp[4], h[4], n1[4], n2[4];
        const bool first = (m0 & 4095) == 0;
        load_row(x, first ? m0 : m0 - 1, lane, hp); load_row(x, m0, lane, h); load_row(x, m0 + 1, lane, n1);
        finish_row(hp, sh, sc1);
        if (first) {
#pragma unroll
            for (int j = 0; j < 4; ++j) hp[j] = (f32x4){0.f, 0.f, 0.f, 0.f}; }
        for (int i = 0; i < 32; ++i) {
            const size_t m = m0 + i;
            load_row(x, (i + 2 < 32) ? m + 2 : m, lane, n2);
            finish_row(h, sh, sc1);
            u32x2* o2 = (u32x2*)(H2 + (m + b + 1) * D) + lane;
            u32x2* or_ = (u32x2*)(X3 + m * D) + lane;
#pragma unroll
            for (int j = 0; j < 4; ++j) {
                const f32x4 d = hp[j] - h[j];
                const f32x4 xr = h[j] + d * mr[j], xk = h[j] + d * mk[j], xv = h[j] + d * mv[j];
                u32x2 w; w.x = cvt_pk_bf16(h[j].x, h[j].y); w.y = cvt_pk_bf16(h[j].z, h[j].w); o2[64 * j] = w;
                if (first && i == 0) o2[64 * j - D / 4] = (u32x2){0u, 0u};
                w.x = cvt_pk_bf16(xr.x, xr.y); w.y = cvt_pk_bf16(xr.z, xr.w); or_[64 * j] = w;
                w.x = cvt_pk_bf16(xk.x, xk.y); w.y = cvt_pk_bf16(xk.z, xk.w); or_[64 * j + (size_t)M * D / 4] = w;
                w.x = cvt_pk_bf16(xv.x, xv.y); w.y = cvt_pk_bf16(xv.z, xv.w); or_[64 * j + 2 * (size_t)M * D / 4] = w;
                hp[j] = h[j]; h[j] = n1[j]; n1[j] = n2[j];
            }
        }
    }
}

__device__ __forceinline__ void phase_sgu(const Args& a, LAS unsigned char* lds) {
    const int tid = opaque_tid(), lane = tid & 63, wave = tid >> 6, fr = lane & 15, fq = lane >> 4;
    const bf16_t* UV = (const bf16_t*)(a.ws + WS_UV); bf16_t* Z = (bf16_t*)(a.ws + WS_Z);
    const bf16_t* WSB = (const bf16_t*)(a.ws + WS_WS);
    const float* lng = a.in[7]; const float* lnb = a.in[8]; const float* bs = a.in[10];
    constexpr int RS = 272;
    LAS unsigned char* Wl = lds;
    LAS unsigned char* Vl = lds + 128 * RS;
    LAS f32x2* st = (LAS f32x2*)(lds + 2 * 128 * RS);
    const int wt = wave >> 2, wd = wave & 3;
    for (int tile_ = blockIdx.x; tile_ < M / 128; tile_ += gridDim.x) {
        const int tile = M / 128 - 1 - tile_;
        const size_t m0 = (size_t)tile * 128;
        for (int r = wave * 16; r < wave * 16 + 16; ++r) {
            const u32x4* p = (const u32x4*)(UV + (m0 + r) * 2048 + 1024) + lane;
            const u32x4 q0 = p[0], q1 = p[64];
            float f[16];
            f[0] = bf_lo(q0.x); f[1] = bf_hi(q0.x); f[2] = bf_lo(q0.y); f[3] = bf_hi(q0.y); f[4] = bf_lo(q0.z); f[5] = bf_hi(q0.z); f[6] = bf_lo(q0.w); f[7] = bf_hi(q0.w);
            f[8] = bf_lo(q1.x); f[9] = bf_hi(q1.x); f[10] = bf_lo(q1.y); f[11] = bf_hi(q1.y); f[12] = bf_lo(q1.z); f[13] = bf_hi(q1.z); f[14] = bf_lo(q1.w); f[15] = bf_hi(q1.w);
            float s = 0.f;
#pragma unroll
            for (int e = 0; e < 16; ++e) s += f[e];
            const float mean = wave_sum(s) * (1.f / 1024.f);
            float q = 0.f;
#pragma unroll
            for (int e = 0; e < 16; ++e) { const float d = f[e] - mean; q += d * d; }
            const float var = wave_sum(q) * (1.f / 1024.f);
            if (lane == 0) st[r] = (f32x2){mean, 1.0f / sqrtf(var + 1e-5f)};
        }
        __syncthreads();
        for (int g = 0; g < 8; ++g) {
            {
                const u32x4* src = (const u32x4*)(WSB + (size_t)g * 128 * 128);
#pragma unroll
                for (int i = 0; i < 4; ++i) { const int idx = tid + i * NTHREADS; const int t = idx >> 4, c = idx & 15;
                    *(LAS u32x4*)(Wl + t * RS + c * 16) = src[idx]; }
            }
            {
                const int sp = tid & 63, dq = tid >> 6, s0 = 2 * sp, d0 = dq * 16;
                const f32x2 st0 = st[s0], st1 = st[s0 + 1];
                const bf16_t* p0 = UV + (m0 + s0) * 2048 + 1024 + g * 128 + d0;
                const u32x4 a0 = *(const u32x4*)p0, a1 = *(const u32x4*)(p0 + 8), b0 = *(const u32x4*)(p0 + 2048), b1 = *(const u32x4*)(p0 + 2048 + 8);
                const unsigned ua[8] = {a0.x, a0.y, a0.z, a0.w, a1.x, a1.y, a1.z, a1.w}, ub[8] = {b0.x, b0.y, b0.z, b0.w, b1.x, b1.y, b1.z, b1.w};
                const float* gp = lng + g * 128 + d0; const float* bp = lnb + g * 128 + d0;
#pragma unroll
                for (int e = 0; e < 8; ++e) {
                    const float g0 = gp[2 * e], g1 = gp[2 * e + 1], c0 = bp[2 * e], c1 = bp[2 * e + 1];
                    const float x00 = (bf_lo(ua[e]) - st0.x) * st0.y * g0 + c0, x01 = (bf_hi(ua[e]) - st0.x) * st0.y * g1 + c1;
                    const float x10 = (bf_lo(ub[e]) - st1.x) * st1.y * g0 + c0, x11 = (bf_hi(ub[e]) - st1.x) * st1.y * g1 + c1;
                    *(LAS unsigned*)(Vl + (d0 + 2 * e) * RS + s0 * 2) = cvt_pk_bf16(x00, x10);
                    *(LAS unsigned*)(Vl + (d0 + 2 * e + 1) * RS + s0 * 2) = cvt_pk_bf16(x01, x11);
                }
            }
            __syncthreads();
            f32x4 acc[4][2];
#pragma unroll
            for (int mi = 0; mi < 4; ++mi)
#pragma unroll
                for (int ni = 0; ni < 2; ++ni) acc[mi][ni] = (f32x4){0.f, 0.f, 0.f, 0.f};
#pragma unroll
            for (int ks = 0; ks < 4; ++ks) {
                if (ks * 32 <= 64 * wt + 63) {
                    bf16x8 bfr[2];
#pragma unroll
                    for (int ni = 0; ni < 2; ++ni) bfr[ni] = *(const LAS bf16x8*)(Vl + (32 * wd + 16 * ni + fr) * RS + (ks * 32 + fq * 8) * 2);
#pragma unroll
                    for (int mi = 0; mi < 4; ++mi) {
                        if (ks * 32 <= 64 * wt + 16 * mi + 15) {
                            const bf16x8 afr = *(const LAS bf16x8*)(Wl + (64 * wt + 16 * mi + fr) * RS + (ks * 32 + fq * 8) * 2);
#pragma unroll
                            for (int ni = 0; ni < 2; ++ni) acc[mi][ni] = __builtin_amdgcn_mfma_f32_16x16x32_bf16(bfr[ni], afr, acc[mi][ni], 0, 0, 0);
                        }
                    }
                }
            }
#pragma unroll
            for (int mi = 0; mi < 4; ++mi) {
                const int t = 64 * wt + 16 * mi + fr; const float bias = bs[g * 128 + t];
#pragma unroll
                for (int ni = 0; ni < 2; ++ni) {
                    const int col = g * 128 + 32 * wd + 16 * ni + 4 * fq;
                    const u32x2 uu = *(const u32x2*)(UV + (m0 + t) * 2048 + col);
                    const f32x4 sv = acc[mi][ni];
                    u32x2 o; o.x = cvt_pk_bf16(bf_lo(uu.x) * (sv[0] + bias), bf_hi(uu.x) * (sv[1] + bias)); o.y = cvt_pk_bf16(bf_lo(uu.y) * (sv[2] + bias), bf_hi(uu.y) * (sv[3] + bias));
                    *(u32x2*)(Z + (m0 + t) * 1024 + col) = o;
                }
            }
            __syncthreads();
        }
    }
}

__device__ __forceinline__ float fma_(float a, float b, float c) { float d; asm("v_fma_f32 %0, %1, %2, %3" : "=v"(d) : "v"(a), "v"(b), "v"(c)); return d; }
__device__ __forceinline__ float mul_(float a, float b) { float d; asm("v_mul_f32 %0, %1, %2" : "=v"(d) : "v"(a), "v"(b)); return d; }
__device__ __forceinline__ float dot4_(const f32x4& s, const f32x4& o) { return fma_(s.w, o.w, fma_(s.z, o.z, fma_(s.y, o.y, mul_(s.x, o.x)))); }
__device__ __forceinline__ void upd4_(f32x4& s, const f32x4& w, const f32x4& b, const f32x4& k, float sa, float v) {
    s.x = fma_(v, k.x, fma_(sa, b.x, mul_(s.x, w.x))); s.y = fma_(v, k.y, fma_(sa, b.y, mul_(s.y, w.y)));
    s.z = fma_(v, k.z, fma_(sa, b.z, mul_(s.z, w.z))); s.w = fma_(v, k.w, fma_(sa, b.w, mul_(s.w, w.w)));
}
__device__ __forceinline__ f32x2 pkmul_(f32x2 a, f32x2 b) { f32x2 d; asm("v_pk_mul_f32 %0, %1, %2" : "=v"(d) : "v"(a), "v"(b)); return d; }
__device__ __forceinline__ f32x2 pkfma_(f32x2 a, f32x2 b, f32x2 c) { f32x2 d; asm("v_pk_fma_f32 %0, %1, %2, %3" : "=v"(d) : "v"(a), "v"(b), "v"(c)); return d; }
__device__ __forceinline__ f32x2 pkfma_lo_(f32x2 a, f32x2 b, f32x2 c) { f32x2 d; asm("v_pk_fma_f32 %0, %1, %2, %3 op_sel_hi:[0,1,1]" : "=v"(d) : "v"(a), "v"(b), "v"(c)); return d; }
__device__ __forceinline__ f32x2 pkfma_hi_(f32x2 a, f32x2 b, f32x2 c) { f32x2 d; asm("v_pk_fma_f32 %0, %1, %2, %3 op_sel:[1,0,0]" : "=v"(d) : "v"(a), "v"(b), "v"(c)); return d; }
__device__ __forceinline__ float add_(float a, float b) { float d; asm("v_add_f32 %0, %1, %2" : "=v"(d) : "v"(a), "v"(b)); return d; }
template <int SEL> __device__ __forceinline__ f32x2 pkmul_b(f32x2 s, f32x2 o) { f32x2 d;
    if (SEL == 0) asm("v_pk_mul_f32 %0, %1, %2 op_sel_hi:[1,0]" : "=v"(d) : "v"(s), "v"(o)); else asm("v_pk_mul_f32 %0, %1, %2 op_sel:[0,1]" : "=v"(d) : "v"(s), "v"(o)); return d; }
template <int SEL> __device__ __forceinline__ f32x2 pkfma_b(f32x2 s, f32x2 o, f32x2 c) { f32x2 d;
    if (SEL == 0) asm("v_pk_fma_f32 %0, %1, %2, %3 op_sel_hi:[1,0,1]" : "=v"(d) : "v"(s), "v"(o), "v"(c)); else asm("v_pk_fma_f32 %0, %1, %2, %3 op_sel:[0,1,0]" : "=v"(d) : "v"(s), "v"(o), "v"(c)); return d; }
#define LO2(v) __builtin_shufflevector(v, v, 0, 1)
#define HI2(v) __builtin_shufflevector(v, v, 2, 3)
__device__ __forceinline__ void phase_scan(const Args& a, LAS unsigned char* lds) {
    const int tid = opaque_tid(), lane = tid & 63, wave = tid >> 6;
    constexpr int TC = 32;
    LAS float* op = (LAS float*)lds;
    LAS float* vb = (LAS float*)(lds + (TC + 1) * 1280);
    LAS float* yb = (LAS float*)(lds + (TC + 1) * 1280 + (TC + 1) * 256);
    const bf16_t* Rg = (const bf16_t*)(a.ws + WS_R); const bf16_t* Kg = (const bf16_t*)(a.ws + WS_K); const bf16_t* Vg = (const bf16_t*)(a.ws + WS_V);
    const bf16_t* Lg = (const bf16_t*)(a.ws + WS_L); const bf16_t* WL2 = (const bf16_t*)(a.ws + WS_WL2);
    constexpr int XS = 68;
    LAS float* xb = (LAS float*)(lds + (TC + 1) * 1280 + (TC + 1) * 256 + TC * 1024);
    const int fr = lane & 15, fq = lane >> 4, stile = wave >> 2, ntile = wave & 3;
    bf16_t* YG = (bf16_t*)(a.ws + WS_YG);
    const int ts = tid >> 4, jg = tid & 15;
    const int ig = lane >> 4;
    const int r0 = wave * 8 + ig * 2;
    for (int hd = blockIdx.x; hd < NB * 16; hd += gridDim.x) {
        const int b = hd >> 4, h = hd & 15;
        const int ch = h * 64 + jg * 4;
        const f32x4 kk4 = *(const f32x4*)(a.in[22] + ch), ka4 = *(const f32x4*)(a.in[23] + ch), rk4 = *(const f32x4*)(a.in[24] + ch);
        const f32x4 lg4 = *(const f32x4*)(a.in[25] + ch), lb4 = *(const f32x4*)(a.in[26] + ch);
        const size_t base = ((size_t)b * T) * D + ch;
        f32x2 C0 = {0.f, 0.f}, C1 = {0.f, 0.f}, C2 = {0.f, 0.f}, C3 = {0.f, 0.f};
        size_t off = base + (size_t)ts * D;
        u32x2 pr = *(const u32x2*)(Rg + off), pk = *(const u32x2*)(Kg + off), pv = *(const u32x2*)(Vg + off);
        const int chn = h * 64 + ntile * 16 + fr;
        bf16x8 bw[2], ba[2], bg[5];
#pragma unroll
        for (int ks = 0; ks < 2; ++ks) { bw[ks] = *(const bf16x8*)(WL2 + (size_t)chn * 512 + ks * 32 + fq * 8); ba[ks] = *(const bf16x8*)(WL2 + (size_t)(1024 + chn) * 512 + 128 + ks * 32 + fq * 8); }
#pragma unroll
        for (int ks = 0; ks < 5; ++ks) bg[ks] = *(const bf16x8*)(WL2 + (size_t)(2048 + chn) * 512 + 256 + ks * 32 + fq * 8);
        const float w0c = a.in[14][chn], a0c = a.in[17][chn];
        bf16x8 aw[2], aa[2], ag[5];
#define LORA_LOAD(cc) do { const bf16_t* lrow = Lg + ((size_t)b * T + (size_t)(cc) * TC + stile * 16 + fr) * 512 + fq * 8; \
            _Pragma("unroll") for (int ks = 0; ks < 2; ++ks) { aw[ks] = *(const bf16x8*)(lrow + ks * 32); aa[ks] = *(const bf16x8*)(lrow + 128 + ks * 32); } \
            _Pragma("unroll") for (int ks = 0; ks < 5; ++ks) ag[ks] = *(const bf16x8*)(lrow + 256 + ks * 32); } while (0)
#define LORA_RUN() do { f32x4 cw = {0.f, 0.f, 0.f, 0.f}, ca = {0.f, 0.f, 0.f, 0.f}, cg_ = {0.f, 0.f, 0.f, 0.f}; \
            _Pragma("unroll") for (int ks = 0; ks < 2; ++ks) { cw = __builtin_amdgcn_mfma_f32_16x16x32_bf16(aw[ks], bw[ks], cw, 0, 0, 0); ca = __builtin_amdgcn_mfma_f32_16x16x32_bf16(aa[ks], ba[ks], ca, 0, 0, 0); } \
            _Pragma("unroll") for (int ks = 0; ks < 5; ++ks) cg_ = __builtin_amdgcn_mfma_f32_16x16x32_bf16(ag[ks], bg[ks], cg_, 0, 0, 0); \
            _Pragma("unroll") for (int e = 0; e < 4; ++e) { const int xi = (stile * 16 + 4 * fq + e) * XS + ntile * 16 + fr; \
                xb[xi] = __builtin_amdgcn_exp2f(-0.87503988f * __builtin_amdgcn_rcpf(1.0f + __expf(-(w0c + cw[e])))); \
                xb[TC * XS + xi] = __builtin_amdgcn_rcpf(1.0f + __expf(-(a0c + ca[e]))); \
                xb[2 * TC * XS + xi] = cg_[e]; } } while (0)
        LORA_LOAD(0); LORA_RUN();
        __syncthreads();
        u32x2 ypend = {0u, 0u};
        for (int c = 0; c < T / TC; ++c) {
            const f32x4 r4 = {bf_lo(pr.x), bf_hi(pr.x), bf_lo(pr.y), bf_hi(pr.y)};
            const f32x4 k4 = {bf_lo(pk.x), bf_hi(pk.x), bf_lo(pk.y), bf_hi(pk.y)};
            const f32x4 v4 = {bf_lo(pv.x), bf_hi(pv.x), bf_lo(pv.y), bf_hi(pv.y)};
            const f32x4 w4 = *(const LAS f32x4*)(xb + ts * XS + jg * 4), a4 = *(const LAS f32x4*)(xb + TC * XS + ts * XS + jg * 4), g4 = *(const LAS f32x4*)(xb + 2 * TC * XS + ts * XS + jg * 4);
            const f32x4 kkx = k4 * kk4;
            const float ss = reduce16((kkx.x * kkx.x + kkx.y * kkx.y) + (kkx.z * kkx.z + kkx.w * kkx.w));
            const float inv = __builtin_amdgcn_rsqf(fmaxf(ss, 1e-24f));
            const f32x4 kk = kkx * inv;
            const f32x4 kf = k4 * ((a4 - 1.0f) * ka4 + 1.0f);
            const f32x4 am = -kk, bm = kk * a4;
            const f32x4 rkr = r4 * kf * rk4;
            const float ct = reduce16((rkr.x + rkr.y) + (rkr.z + rkr.w));
            {
                LAS f32x4* o = (LAS f32x4*)(op + (ts * 16 + jg) * 20);
                o[0] = w4; o[1] = am; o[2] = bm; o[3] = kf; o[4] = r4;
                *(LAS f32x4*)(vb + ts * 64 + jg * 4) = v4;
            }
            __syncthreads();
            if (c > 0) *(u32x2*)(YG + base + (size_t)((c - 1) * TC + ts) * D) = ypend;
            if (c + 1 < T / TC) { off = base + (size_t)((c + 1) * TC + ts) * D;
                pr = *(const u32x2*)(Rg + off); pk = *(const u32x2*)(Kg + off); pv = *(const u32x2*)(Vg + off);
                LORA_LOAD(c + 1); }
            {
                const LAS float* obase = op + (lane & 15) * 20;
                const LAS float* vbase = vb + r0;
                f32x4 ow = *(const LAS f32x4*)(obase), oa = *(const LAS f32x4*)(obase + 4), ob = *(const LAS f32x4*)(obase + 8), ok = *(const LAS f32x4*)(obase + 12), orr = *(const LAS f32x4*)(obase + 16);
                f32x2 vv = *(const LAS f32x2*)(vbase);
#pragma unroll 4
                for (int s = 0; s < TC; ++s) {
                    const LAS float* o = obase + (s + 1) * 320;
                    const f32x4 now = *(const LAS f32x4*)(o), noa = *(const LAS f32x4*)(o + 4), nob = *(const LAS f32x4*)(o + 8), nok = *(const LAS f32x4*)(o + 12), norr = *(const LAS f32x4*)(o + 16);
                    const f32x2 nvv = *(const LAS f32x2*)(vbase + (s + 1) * 64);
                    const f32x2 p = pkfma_b<1>(C3, HI2(oa), pkfma_b<0>(C2, HI2(oa), pkfma_b<1>(C1, LO2(oa), pkmul_b<0>(C0, LO2(oa)))));
                    float sa0 = p.x, sa1 = p.y;
                    sa0 = reduce16(sa0); asm volatile("" : "+v"(sa0)); sa1 = reduce16(sa1);
                    const f32x2 sap = {sa0, sa1};
                    C0 = pkfma_b<0>(vv, LO2(ok), pkfma_b<0>(sap, LO2(ob), pkmul_b<0>(C0, LO2(ow))));
                    C1 = pkfma_b<1>(vv, LO2(ok), pkfma_b<1>(sap, LO2(ob), pkmul_b<1>(C1, LO2(ow))));
                    C2 = pkfma_b<0>(vv, HI2(ok), pkfma_b<0>(sap, HI2(ob), pkmul_b<0>(C2, HI2(ow))));
                    C3 = pkfma_b<1>(vv, HI2(ok), pkfma_b<1>(sap, HI2(ob), pkmul_b<1>(C3, HI2(ow))));
                    const f32x2 q = pkfma_b<1>(C3, HI2(orr), pkfma_b<0>(C2, HI2(orr), pkfma_b<1>(C1, LO2(orr), pkmul_b<0>(C0, LO2(orr)))));
                    float y0 = q.x, y1 = q.y;
                    y0 += dppf<0xB1>(y0); y1 += dppf<0xB1>(y1); y0 += dppf<0x4E>(y0); y1 += dppf<0x4E>(y1);
                    *(LAS f32x2*)(yb + ((s * 32 + (r0 >> 1)) * 4 + ((lane >> 2) & 3)) * 2) = (f32x2){y0, y1};
                    ow = now; oa = noa; ob = nob; ok = nok; orr = norr; vv = nvv;
                }
            }
            __syncthreads();
            {
                const LAS f32x4* yq = (const LAS f32x4*)(yb + (ts * 32 + 2 * jg) * 8);
                const f32x4 A0 = yq[0], A1 = yq[1], B0 = yq[2], B1 = yq[3];
                const f32x4 y4 = {(A0.x + A0.z) + (A1.x + A1.z), (A0.y + A0.w) + (A1.y + A1.w), (B0.x + B0.z) + (B1.x + B1.z), (B0.y + B0.w) + (B1.y + B1.w)};
                const float mean = reduce16((y4.x + y4.y) + (y4.z + y4.w)) * (1.f / 64.f);
                const f32x4 d = y4 - mean;
                const float var = reduce16((d.x * d.x + d.y * d.y) + (d.z * d.z + d.w * d.w)) * (1.f / 64.f);
                const float rstd = __builtin_amdgcn_rsqf(var + 64e-5f);
                const f32x4 o = ((d * rstd) * lg4 + lb4 + v4 * ct) * g4;
                u32x2 w; w.x = cvt_pk_bf16(o.x, o.y); w.y = cvt_pk_bf16(o.z, o.w);
                ypend = w;
            }
            if (c + 1 < T / TC) LORA_RUN();
            __syncthreads();
        }
        *(u32x2*)(YG + base + (size_t)((T / TC - 1) * TC + ts) * D) = ypend;
#undef LORA_LOAD
#undef LORA_RUN
    }
}


#define SEAM() do { ++ph; if (lo < ph && ph < hi) { if (ph == 1) gsync(grid); else xcd_barrier(xbar); } } while (0)
#define RUN (lo <= ph && ph < hi)
template <int l> __device__ __forceinline__ void layer(const Args& a, LAS unsigned char* lds, cg::grid_group& grid, const XcdBarrier& xbar, int& ph, const int lo, const int hi) {
    unsigned char* ws = a.ws;
    const float* MOD = (const float*)(ws + WS_MOD);
    bf16_t* H = (bf16_t*)(ws + WS_H);
    const int G = gridDim.x, c = blockIdx.x;
    const float* mod = MOD + (size_t)l * 16 * 6144;
    const float* xin = (l == 0) ? a.in[0] : a.out;
    if (RUN) {
        if (l == 1) phase_norm_shift(xin, mod + 0 * 1024, mod + 1 * 1024, a.in[12], (bf16_t*)(ws + WS_X3), (bf16_t*)(ws + WS_H2));
        else if ((threadIdx.x >> 6) < 4) { phase_norm_mod(xin, mod + 0 * 1024, mod + 1 * 1024, H, 0); phase_weights(a, lds); }
        else { phase_weights(a, lds); phase_norm_mod(xin, mod + 0 * 1024, mod + 1 * 1024, H, 0); }
    }
    SEAM();
    if (l == 0) {
        if (RUN) { pg8::Gemm g{H, (const bf16_t*)(ws + WS_WIN0), M, 2048, 1024, 0, 0}; pg8::StaticOrder S; S.init(M, 2048, G, c);
          pg8::EpiAct<1> E{(bf16_t*)(ws + WS_UV), 2048}; pg8::gemm_phase(lds, g, S, E); }
        SEAM();
        if (RUN) phase_sgu(a, lds);
        SEAM();
        if (RUN) { pg8::Gemm g{(const bf16_t*)(ws + WS_Z), (const bf16_t*)(ws + WS_WOUT0), M, 1024, 1024, 0, 0}; pg8::StaticOrder S; S.init(M, 1024, G, c);
          pg8::EpiRes E{a.in[0], a.out, mod + 2 * 1024, 6144}; pg8::gemm_phase(lds, g, S, E); }
    } else {
        if (RUN) {
          { pg8::Gemm g{(const bf16_t*)(ws + WS_H2), (const bf16_t*)(ws + WS_WL1), M, 512, 2048, 0, 1}; pg8::StaticOrder S; S.init(M, 512, G, c, 1);
            pg8::EpiRkvL E{(bf16_t*)(ws + WS_R), (size_t)(WS_K - WS_R) / 2, (bf16_t*)(ws + WS_L), 12}; pg8::gemm_phase(lds, g, S, E); }
          { pg8::Gemm g{(const bf16_t*)(ws + WS_X3), (const bf16_t*)(ws + WS_WRKV), M, 3072, 1024, (long)M * D, 0}; pg8::StaticOrder S; S.init(M, 3072, G, c, 1);
            pg8::EpiRkvL E{(bf16_t*)(ws + WS_R), (size_t)(WS_K - WS_R) / 2, (bf16_t*)(ws + WS_L), 0}; pg8::gemm_phase(lds, g, S, E); }
        }
        SEAM();
        if (RUN) phase_scan(a, lds);
        SEAM();
        if (RUN) { pg8::Gemm g{(const bf16_t*)(ws + WS_YG), (const bf16_t*)(ws + WS_WOUT1), M, 1024, 1024, 0, 0}; pg8::StaticOrder S; S.init(M, 1024, G, c);
          pg8::EpiRes E{a.out, a.out, mod + 2 * 1024, 6144}; pg8::gemm_phase(lds, g, S, E); }
    }
    SEAM();
    if (RUN) phase_norm_mod(a.out, mod + 3 * 1024, mod + 4 * 1024, H, 0);
    SEAM();
    if (RUN) { pg8::Gemm g{H, (const bf16_t*)(ws + WS_W1 + (size_t)l * 4096 * 1024 * 2), M, 4096, 1024, 0, 0}; pg8::StaticOrder S; S.init(M, 4096, G, c);
      pg8::EpiAct<2> E{(bf16_t*)(ws + WS_HID), 4096}; pg8::gemm_phase(lds, g, S, E); }
    SEAM();
    if (RUN) { pg8::Gemm g{(const bf16_t*)(ws + WS_HID), (const bf16_t*)(ws + WS_W2 + (size_t)l * 1024 * 4096 * 2), M, 1024, 4096, 0, 0}; pg8::StaticOrder S; S.init(M, 1024, G, c, 1);
      pg8::EpiRes E{a.out, a.out, mod + 5 * 1024, 6144}; pg8::gemm_phase(lds, g, S, E); }
    SEAM();
}
constexpr int NPHASES = 16;

__global__ void __launch_bounds__(NTHREADS, 2) fwd_megakernel(Args a) {
    extern __shared__ __attribute__((aligned(16))) unsigned char lds_raw[];
    LAS unsigned char* lds = (LAS unsigned char*)lds_raw;
    cg::grid_group grid = cg::this_grid();
    const int lo = a.lo, hi = a.hi;
    int ph = 0;
    volatile LAS unsigned* bst = (volatile LAS unsigned*)(lds + 131072 + 512);
    if (threadIdx.x < 2) bst[threadIdx.x] = 0u;
    __syncthreads();
    XcdBarrier xbar; xbar.bar = (unsigned*)a.ws; xbar.x = 0; xbar.st = nullptr;
    if (hi - lo > 1) xbar = xcd_barrier_post((unsigned*)a.ws, bst);
    if (RUN) phase_prep(a, lds);
    SEAM();
    layer<0>(a, lds, grid, xbar, ph, lo, hi);
    layer<1>(a, lds, grid, xbar, ph, lo, hi);
    if (RUN) phase_final_norm(a.out, a.in[28]);
}
#ifndef N_LAUNCHES
#define N_LAUNCHES 1
#endif

extern "C" void kernel_launch(void* const* d_in, const int* in_sizes, int n_in, void* d_out, int out_size, void* d_ws, size_t ws_size, hipStream_t stream) {
    static int grid = 0;
    if (grid == 0) {
        if (n_in != 29 || out_size != M * D || ws_size < WS_END) { fprintf(stderr, "kernel_launch: unexpected problem: n_in %d out %d ws %zu (need %zu)\n", n_in, out_size, ws_size, (size_t)WS_END); grid = -1; return; }
        int dev = 0, cus = 0, per_cu = 0;
        hipGetDevice(&dev);
        hipDeviceGetAttribute(&cus, hipDeviceAttributeMultiprocessorCount, dev);
        if (hipFuncSetAttribute((const void*)fwd_megakernel, hipFuncAttributeMaxDynamicSharedMemorySize, LDS_BYTES) != hipSuccess) { fprintf(stderr, "kernel_launch: hipFuncSetAttribute failed\n"); grid = -1; return; }
        if (hipOccupancyMaxActiveBlocksPerMultiprocessor(&per_cu, (const void*)fwd_megakernel, NTHREADS, LDS_BYTES) != hipSuccess || per_cu < 1) { fprintf(stderr, "kernel_launch: occupancy query says %d blocks/CU\n", per_cu); per_cu = 1; }
        (void)hipGetLastError();
        grid = cus;
    }
    if (grid < 0) return;
    Args a{};
    for (int i = 0; i < 29; ++i) a.in[i] = (const float*)d_in[i];
    a.out = (float*)d_out; a.ws = (unsigned char*)d_ws;
    if (N_LAUNCHES == 1) {
        if (hipMemsetAsync(d_ws, 0, 16384, stream) != hipSuccess) { fprintf(stderr, "kernel_launch: memset of the barrier words failed\n"); return; }
        a.lo = 0; a.hi = NPHASES;
        void* args[] = {&a};
        hipError_t e = hipLaunchCooperativeKernel((const void*)fwd_megakernel, dim3(grid), dim3(NTHREADS), args, LDS_BYTES, stream);
        if (e != hipSuccess) fprintf(stderr, "kernel_launch: cooperative launch failed: %s (grid %d)\n", hipGetErrorString(e), grid);
    } else {
        for (int p = 0; p < NPHASES; ++p) { a.lo = p; a.hi = p + 1;
            hipLaunchKernelGGL(fwd_megakernel, dim3(grid), dim3(NTHREADS), LDS_BYTES, stream, a); }
    }
}
```

```cpp
#include <hip/hip_runtime.h>
#include <hip/hip_cooperative_groups.h>
#include <cstdio>
#include <cstdint>
namespace cg = cooperative_groups;

#define LAS __attribute__((address_space(3)))
typedef unsigned short bf16_t;
typedef short bf16x8 __attribute__((ext_vector_type(8)));
typedef float f32x4 __attribute__((ext_vector_type(4)));
typedef float f32x2 __attribute__((ext_vector_type(2)));
typedef unsigned u32x4 __attribute__((ext_vector_type(4)));
typedef unsigned u32x2 __attribute__((ext_vector_type(2)));

constexpr int D = 1024, NB = 16, T = 4096, M = NB * T, FF = 4096, NMOD = 6;
constexpr int NTHREADS = 512, NWAVES = 8;

__device__ __forceinline__ int opaque_tid() { int t = threadIdx.x; asm volatile("" : "+v"(t)); return t; }
__device__ __forceinline__ unsigned cvt_pk_bf16(float lo, float hi) { unsigned r; asm volatile("v_cvt_pk_bf16_f32 %0, %1, %2" : "=v"(r) : "v"(lo), "v"(hi)); return r; }
__device__ __forceinline__ float bf_lo(unsigned u) { return __builtin_bit_cast(float, u << 16); }
__device__ __forceinline__ float bf_hi(unsigned u) { return __builtin_bit_cast(float, u & 0xffff0000u); }
__device__ __forceinline__ float sigmoidf_(float x) { return __builtin_amdgcn_rcpf(1.0f + __expf(-x)); }

namespace pg8 {
constexpr int BM = 256, BK = 64, HALF = 128, HTB = HALF * BK * 2, STAGE_BYTES = 8 * HTB, NXCD = 8, WGM = 8;
__host__ __device__ __forceinline__ int lds_byte(int r, int c) { const int st = (r >> 4) * 2 + (c >> 5), rr = r & 15, cc = c & 31, ob = rr * 64 + cc * 2; return st * 1024 + (ob ^ (((ob >> 9) & 1) << 5)); }
__host__ __device__ __forceinline__ void stage_rc(int b, int& R, int& C) { const int st = b / 1024, sb = b % 1024, swz = sb ^ (((sb >> 9) & 1) << 5); R = (st >> 1) * 16 + swz / 64; C = (st & 1) * 32 + (swz % 64) / 2; }
__host__ __device__ __forceinline__ int perm32(int rho) { const int n = rho >> 4, i = rho & 15; return 8 * (i >> 2) + 4 * n + (i & 3); }

struct Unit { int pm, pn; };
struct Gemm { const bf16_t* A; const bf16_t* Bt; int M, N, K; long asplit; int shift; };

struct StaticOrder {
    int nM, nN, nwg, G, c, rev;
    __device__ void init(int M_, int N_, int G_, int c_, int rev_ = 0) { nM = M_ / BM; nN = N_ / BM; nwg = nM * nN; G = G_; c = c_; rev = rev_; }
    __device__ bool next(int i, Unit& u) const {
        const long L = (long)i * G + c; if (L >= nwg) return false;
        int wgid = (int)L; { const int q = nwg / NXCD, r = nwg % NXCD, xcd = wgid % NXCD, off = wgid / NXCD; wgid = (xcd < r ? xcd * (q + 1) : r * (q + 1) + (xcd - r) * q) + off; }
        const int nig = WGM * nN, gid = wgid / nig, fm = gid * WGM, gsz = (nM - fm) < WGM ? (nM - fm) : WGM;
        u.pm = fm + ((wgid % nig) % gsz); u.pn = (wgid % nig) / gsz; if (rev) u.pm = nM - 1 - u.pm; return true;
    }
};

__device__ __forceinline__ f32x2 gelu_pk(f32x2 v) {
    const f32x2 av = __builtin_elementwise_abs(v), d = av * 0.2316418882f + 1.0f;
    f32x2 t; t.x = __builtin_amdgcn_rcpf(d.x); t.y = __builtin_amdgcn_rcpf(d.y);
    f32x2 q = t * 0.5307027145f + (-0.7265760135f); q = q * t + 0.7107068705f; q = q * t + (-0.142248368f); q = q * t + 0.127414796f; q = q * t;
    const f32x2 s = (v * v) * (-0.72134752044f);
    f32x2 e; e.x = __builtin_amdgcn_exp2f(s.x); e.y = __builtin_amdgcn_exp2f(s.y);
    const f32x2 m = v * (q * e), r = v - m;
    f32x2 o; o.x = v.x < 0.f ? m.x : r.x; o.y = v.y < 0.f ? m.y : r.y; return o;
}

template <int ACT  > struct EpiAct {
    static constexpr bool PERM = true;
    bf16_t* O; int ldc;
    __device__ __forceinline__ void operator()(const f32x4 (&acc)[2][2][4][2], const Unit& u, int wr, int wc, int fr, int fq) const {
        const int row0 = u.pm * BM + wr * 64 + fr; const int col0 = u.pn * BM + wc * 32 + 8 * fq;
#pragma unroll
        for (int ai = 0; ai < 2; ++ai)
#pragma unroll
            for (int m = 0; m < 4; ++m) { bf16_t* rowp = O + (size_t)(row0 + ai * HALF + m * 16) * ldc + col0;
#pragma unroll
                for (int bj = 0; bj < 2; ++bj) { f32x4 v0 = acc[ai][bj][m][0], v1 = acc[ai][bj][m][1];
                    if (ACT == 1) { f32x2 a = gelu_pk((f32x2){v0[0], v0[1]}), b = gelu_pk((f32x2){v0[2], v0[3]}), c = gelu_pk((f32x2){v1[0], v1[1]}), d = gelu_pk((f32x2){v1[2], v1[3]});
                        v0 = (f32x4){a.x, a.y, b.x, b.y}; v1 = (f32x4){c.x, c.y, d.x, d.y}; }
                    if (ACT == 2) {
#pragma unroll
                        for (int e = 0; e < 4; ++e) { float p = fmaxf(v0[e], 0.f), q = fmaxf(v1[e], 0.f); v0[e] = p * p; v1[e] = q * q; } }
                    u32x4 w; w.x = cvt_pk_bf16(v0[0], v0[1]); w.y = cvt_pk_bf16(v0[2], v0[3]); w.z = cvt_pk_bf16(v1[0], v1[1]); w.w = cvt_pk_bf16(v1[2], v1[3]);
                    *(u32x4*)(rowp + bj * HALF) = w; } }
    }
};
struct EpiRkvL {
    static constexpr bool PERM = true;
    bf16_t* R; size_t split_stride; bf16_t* L; int pn_off;
    __device__ __forceinline__ void operator()(const f32x4 (&acc)[2][2][4][2], const Unit& u0, int wr, int wc, int fr, int fq) const {
        Unit u = u0; u.pn += pn_off;
        const int row0 = u.pm * BM + wr * 64 + fr;
        bf16_t* base; int ldc, colt, mode;
        if (u.pn < 12) { base = R + (size_t)(u.pn >> 2) * split_stride; colt = (u.pn & 3) * BM; ldc = 1024; mode = 0; }
        else { base = L; colt = (u.pn - 12) * BM; ldc = 512; mode = (u.pn == 12) ? 1 : 2; }
        const int col0 = colt + wc * 32 + 8 * fq;
#pragma unroll
        for (int ai = 0; ai < 2; ++ai)
#pragma unroll
            for (int m = 0; m < 4; ++m) { bf16_t* rowp = base + (size_t)(row0 + ai * HALF + m * 16) * ldc + col0;
#pragma unroll
                for (int bj = 0; bj < 2; ++bj) { f32x4 v0 = acc[ai][bj][m][0], v1 = acc[ai][bj][m][1];
                    if (mode == 1 && bj == 0) {
#pragma unroll
                        for (int e = 0; e < 4; ++e) { v0[e] = tanhf(v0[e]); v1[e] = tanhf(v1[e]); } }
                    if (mode == 2) {
#pragma unroll
                        for (int e = 0; e < 4; ++e) { v0[e] = sigmoidf_(v0[e]); v1[e] = sigmoidf_(v1[e]); } }
                    u32x4 w; w.x = cvt_pk_bf16(v0[0], v0[1]); w.y = cvt_pk_bf16(v0[2], v0[3]); w.z = cvt_pk_bf16(v1[0], v1[1]); w.w = cvt_pk_bf16(v1[2], v1[3]);
                    *(u32x4*)(rowp + bj * HALF) = w; } }
    }
};
struct EpiL2 {
    static constexpr bool PERM = true;
    bf16_t* O0; bf16_t* O1; bf16_t* O2; const float* w0; const float* a0;
    __device__ __forceinline__ void operator()(const f32x4 (&acc)[2][2][4][2], const Unit& u, int wr, int wc, int fr, int fq) const {
        const int mode = u.pn >> 2;
        const int row0 = u.pm * BM + wr * 64 + fr; const int col0 = (u.pn & 3) * BM + wc * 32 + 8 * fq;
        bf16_t *o0 = O0, *o1 = O1, *o2 = O2; const float *bw = w0, *ba = a0;
        asm volatile("" : "+s"(o0), "+s"(o1), "+s"(o2), "+s"(bw), "+s"(ba));
        bf16_t* base = (mode == 0) ? o0 : ((mode == 1) ? o1 : o2);
        const float* bias = (mode == 0) ? bw : ba;
#pragma unroll
        for (int bj = 0; bj < 2; ++bj) {
            f32x4 b0 = {0.f, 0.f, 0.f, 0.f}, b1 = {0.f, 0.f, 0.f, 0.f};
            if (mode != 2) { b0 = *(const f32x4*)(bias + col0 + bj * HALF); b1 = *(const f32x4*)(bias + col0 + bj * HALF + 4); }
#pragma unroll
            for (int ai = 0; ai < 2; ++ai)
#pragma unroll
                for (int m = 0; m < 4; ++m) { bf16_t* rowp = base + (size_t)(row0 + ai * HALF + m * 16) * 1024 + col0;
                    f32x4 v0 = acc[ai][bj][m][0] + b0, v1 = acc[ai][bj][m][1] + b1;
                    if (mode != 2) {
                        const float sc = (mode == 0) ? -0.87503988f : 1.0f;
#pragma unroll
                        for (int e = 0; e < 4; ++e) { v0[e] = sc * __builtin_amdgcn_rcpf(1.0f + __expf(-v0[e])); v1[e] = sc * __builtin_amdgcn_rcpf(1.0f + __expf(-v1[e])); } }
                    u32x4 w; w.x = cvt_pk_bf16(v0[0], v0[1]); w.y = cvt_pk_bf16(v0[2], v0[3]); w.z = cvt_pk_bf16(v1[0], v1[1]); w.w = cvt_pk_bf16(v1[2], v1[3]);
                    *(u32x4*)(rowp + bj * HALF) = w;
                    if (m & 1) asm volatile("" ::: "memory"); }
        }
    }
};
struct EpiRes {
    static constexpr bool PERM = false;
    const float* base; float* out; const float* gate;
    int gstride;
    __device__ __forceinline__ void operator()(const f32x4 (&acc)[2][2][4][2], const Unit& u, int wr, int wc, int fr, int fq) const {
        const int col0 = u.pn * BM + wc * 32 + 4 * fq;
        const float* gp = gate + (size_t)(u.pm >> 4) * gstride + col0;
        f32x4 gv[2][2];
#pragma unroll
        for (int bj = 0; bj < 2; ++bj)
#pragma unroll
            for (int n = 0; n < 2; ++n) gv[bj][n] = *(const f32x4*)(gp + bj * HALF + n * 16);
#pragma unroll
        for (int ai = 0; ai < 2; ++ai)
#pragma unroll
            for (int m = 0; m < 4; ++m) { const size_t off = (size_t)(u.pm * BM + ai * HALF + wr * 64 + m * 16 + fr) * 1024 + col0;
#pragma unroll
                for (int bj = 0; bj < 2; ++bj)
#pragma unroll
                    for (int n = 0; n < 2; ++n) { const f32x4 bs = *(const f32x4*)(base + off + bj * HALF + n * 16);
                        *(f32x4*)(out + off + bj * HALF + n * 16) = bs + gv[bj][n] * acc[ai][bj][m][n]; } }
    }
};

template <class Epi>
__device__ __forceinline__ void gemm_phase(LAS unsigned char* lds, const Gemm g, const StaticOrder& S, const Epi& E) {
    const int tid = opaque_tid(), wid = __builtin_amdgcn_readfirstlane(tid >> 6), lane = tid & 63, wr = wid >> 2, wc = wid & 3, fr = lane & 15, fq = lane >> 4;
    int K_ = g.K; asm volatile("" : "+s"(K_));
    const int K = K_, nt = K / BK, lda = g.shift ? (K_ >> 1) : K_;
    const int ntA = g.shift ? (nt >> 1) : (1 << 30);
    const long adj = g.shift ? ((long)lda * 2 + (long)ntA * (BK * 2)) : 0;
    unsigned voffA[2], voffB[2];
#pragma unroll
    for (int i = 0; i < 2; ++i) { int R, C; stage_rc(tid * 16 + i * 8192, R, C); const int Rb = Epi::PERM ? ((R & ~31) + perm32(R & 31)) : R;
        voffA[i] = (unsigned)(R * lda + C) * 2u; voffB[i] = (unsigned)(Rb * K + C) * 2u; }
    const long kstep = (long)(BK * 2);
    const long hstepA = (long)HALF * lda * 2, hstepB = (long)HALF * K * 2, tstepB = 2 * hstepB;
    const unsigned ldsw = (unsigned)wid * 1024u;
    const int aoff = lds_byte(wr * 64 + fr, fq * 8), boff = lds_byte(wc * 32 + fr, fq * 8);
#define PG8_ABASE(u) ((const char*)g.A + ((long)((u).pn >> 2) * g.asplit + ((long)(u).pm * BM + (g.shift ? ((u).pm >> 4) + 1 : 0)) * (long)lda) * 2)
#define PG8_APTR(base, kt) ((base) + ((long)(kt) * kstep - (((kt) >= ntA) ? adj : 0)))
#define PG8_SA(b, h) (((b) * 2 + (h)) * HTB)
#define PG8_SB(b, h) ((4 + (b) * 2 + (h)) * HTB)
#define PG8_STAGE(bufoff, gbase, voff) do { _Pragma("unroll") for (int _i = 0; _i < 2; ++_i) \
        __builtin_amdgcn_global_load_lds((const unsigned*)((const char*)(gbase) + (voff)[_i]), (LAS unsigned*)(lds + (bufoff) + ldsw + _i * 8192), 16, 0, 0); } while (0)
#define PG8_LDA(dst, b, h) do { _Pragma("unroll") for (int m = 0; m < 4; ++m) _Pragma("unroll") for (int k = 0; k < 2; ++k) dst[m][k] = *(const LAS bf16x8*)(lds + PG8_SA(b, h) + aoff + m * 2048 + k * 1024); } while (0)
#define PG8_LDB(dst, b, h) do { _Pragma("unroll") for (int n = 0; n < 2; ++n) _Pragma("unroll") for (int k = 0; k < 2; ++k) dst[n][k] = *(const LAS bf16x8*)(lds + PG8_SB(b, h) + boff + n * 2048 + k * 1024); } while (0)
#define PG8_MMA(ai, bj, At, Bt) do { __builtin_amdgcn_s_setprio(1); _Pragma("unroll") for (int m = 0; m < 4; ++m) _Pragma("unroll") for (int n = 0; n < 2; ++n) _Pragma("unroll") for (int k = 0; k < 2; ++k) \
        acc[ai][bj][m][n] = __builtin_amdgcn_mfma_f32_16x16x32_bf16(Bt[n][k], At[m][k], acc[ai][bj][m][n], 0, 0, 0); __builtin_amdgcn_s_setprio(0); } while (0)
#define PG8_WAIT_V(n) asm volatile("s_waitcnt vmcnt(" #n ")" ::: "memory")
#define PG8_WAIT_L(n) asm volatile("s_waitcnt lgkmcnt(" #n ")" ::: "memory")
#define PG8_BAR __builtin_amdgcn_s_barrier()
#define PG8_SCHED __builtin_amdgcn_sched_barrier(0)
    Unit cur, nxt; int ui = 0;
    if (!S.next(0, cur)) return;
    f32x4 acc[2][2][4][2];
#pragma unroll
    for (int a = 0; a < 2; ++a)
#pragma unroll
        for (int b = 0; b < 2; ++b)
#pragma unroll
            for (int m = 0; m < 4; ++m)
#pragma unroll
                for (int n = 0; n < 2; ++n) acc[a][b][m][n] = (f32x4){0.f, 0.f, 0.f, 0.f};
    bf16x8 At[4][2], B0[2][2], B1[2][2];
    const char* cA = PG8_ABASE(cur); const char* cB = (const char*)g.Bt + (long)cur.pn * tstepB;
    PG8_STAGE(PG8_SB(0, 0), cB, voffB); PG8_STAGE(PG8_SB(0, 1), cB + hstepB, voffB); PG8_STAGE(PG8_SA(0, 0), cA, voffA); PG8_STAGE(PG8_SA(0, 1), cA + hstepA, voffA);
    if (wr == 1) PG8_BAR;
    PG8_WAIT_V(2); PG8_BAR;
    PG8_STAGE(PG8_SB(1, 0), cB + kstep, voffB); PG8_STAGE(PG8_SA(1, 0), cA + kstep, voffA); PG8_STAGE(PG8_SB(1, 1), cB + hstepB + kstep, voffB);
    PG8_WAIT_V(6); PG8_BAR;
    for (;;) {
        const bool has_next = S.next(ui + 1, nxt);
        const char* nA = has_next ? PG8_ABASE(nxt) : cA; const char* nB = has_next ? (const char*)g.Bt + (long)nxt.pn * tstepB : cB;
        for (int t = 0; t < nt; t += 2) {
            const bool last = (t == nt - 2);
            const char* a1 = PG8_APTR(cA, t + 1);
            const char* a2 = last ? nA : PG8_APTR(cA, t + 2); const char* b2 = last ? nB : cB + (long)(t + 2) * kstep;
            const char* a3 = a2 + kstep; const char* b3 = b2 + kstep;
            PG8_LDB(B0, 0, 0); PG8_LDB(B1, 0, 1); PG8_SCHED; PG8_LDA(At, 0, 0); PG8_STAGE(PG8_SA(1, 1), a1 + hstepA, voffA);
            PG8_WAIT_V(8); PG8_WAIT_L(0); PG8_BAR; PG8_MMA(0, 0, At, B0); PG8_MMA(0, 1, At, B1); PG8_BAR; PG8_SCHED;
            PG8_LDA(At, 0, 1); PG8_STAGE(PG8_SB(0, 0), b2, voffB); PG8_STAGE(PG8_SB(0, 1), b2 + hstepB, voffB); PG8_STAGE(PG8_SA(0, 0), a2, voffA);
            PG8_WAIT_V(8); PG8_WAIT_L(0); PG8_BAR; PG8_MMA(1, 0, At, B0); PG8_MMA(1, 1, At, B1); PG8_BAR; PG8_SCHED;
            PG8_LDB(B0, 1, 0); PG8_LDB(B1, 1, 1); PG8_SCHED; PG8_LDA(At, 1, 0); PG8_STAGE(PG8_SA(0, 1), a2 + hstepA, voffA);
            PG8_WAIT_V(8); PG8_WAIT_L(0); PG8_BAR; PG8_MMA(0, 0, At, B0); PG8_MMA(0, 1, At, B1); PG8_BAR; PG8_SCHED;
            PG8_LDA(At, 1, 1); PG8_STAGE(PG8_SB(1, 0), b3, voffB); PG8_STAGE(PG8_SB(1, 1), b3 + hstepB, voffB); PG8_STAGE(PG8_SA(1, 0), a3, voffA);
            PG8_WAIT_V(8); PG8_WAIT_L(0); PG8_BAR; PG8_MMA(1, 0, At, B0); PG8_MMA(1, 1, At, B1); PG8_BAR; PG8_SCHED;
        }
        if (wr == 0) PG8_BAR;
        E(acc, cur, wr, wc, fr, fq);
        if (!has_next) break;
#pragma unroll
        for (int a = 0; a < 2; ++a)
#pragma unroll
            for (int b = 0; b < 2; ++b)
#pragma unroll
                for (int m = 0; m < 4; ++m)
#pragma unroll
                    for (int n = 0; n < 2; ++n) acc[a][b][m][n] = (f32x4){0.f, 0.f, 0.f, 0.f};
        cur = nxt; cA = nA; cB = nB; ++ui;
        if (wr == 1) PG8_BAR;
    }
    PG8_WAIT_V(0);
    PG8_BAR;
#undef PG8_ABASE
#undef PG8_APTR
#undef PG8_SA
#undef PG8_SB
#undef PG8_STAGE
#undef PG8_LDA
#undef PG8_LDB
#undef PG8_MMA
#undef PG8_WAIT_V
#undef PG8_WAIT_L
#undef PG8_BAR
#undef PG8_SCHED
}
}

constexpr size_t MiB = 1u << 20;
constexpr size_t WS_MOD = 1 * MiB;
constexpr size_t WS_WIN0 = 2 * MiB;
constexpr size_t WS_WOUT0 = 6 * MiB;
constexpr size_t WS_W1 = 8 * MiB;
constexpr size_t WS_W2 = 24 * MiB;
constexpr size_t WS_WRKV = 40 * MiB;
constexpr size_t WS_WL1 = 46 * MiB;
constexpr size_t WS_WL2 = 48 * MiB;
constexpr size_t WS_WOUT1 = 51 * MiB;
constexpr size_t WS_WS = 53 * MiB;
constexpr size_t WS_H = 60 * MiB;
constexpr size_t WS_UV = 188 * MiB;
constexpr size_t WS_Z = 444 * MiB;
constexpr size_t WS_HID = 188 * MiB;
constexpr size_t WS_X3 = 54 * MiB;
constexpr size_t WS_H2 = 438 * MiB;
constexpr size_t WS_L = 952 * MiB;
constexpr size_t WS_R = 567 * MiB, WS_K = 695 * MiB, WS_V = 823 * MiB;
constexpr size_t WS_WE = 60 * MiB, WS_A = 188 * MiB, WS_G = 316 * MiB;
constexpr size_t WS_YG = 54 * MiB;
constexpr size_t WS_END = 1020 * MiB;
constexpr int LDS_BYTES = 147456;

struct Args {
    const float* in[29];
    float* out; unsigned char* ws;
    int lo, hi;
};

__device__ __forceinline__ float wave_sum(float v) {
#pragma unroll
    for (int o = 1; o < 64; o <<= 1) v += __shfl_xor(v, o);
    return v;
}
template <int CTRL> __device__ __forceinline__ float dppf(float v) { return __builtin_bit_cast(float, __builtin_amdgcn_update_dpp(0, __builtin_bit_cast(int, v), CTRL, 0xF, 0xF, true)); }
__device__ __forceinline__ float reduce16(float v) {
    v += dppf<0xB1>(v); v += dppf<0x4E>(v); v += dppf<0x141>(v); v += dppf<0x140>(v); return v;
}

#define XB_TMO      128
#define XB_XCNT(j)  (256  + 64 * (j))
#define XB_XSUB(j)  (1280 + 64 * (j))
#define XB_XGEN(j)  (2304 + 64 * (j))
#define XB_TOP      3328
#define XB_TOPGEN   3392
#define XCD_BAR_WORDS 3456
#define XB_SPIN_CAP (1u << 18)

__device__ __forceinline__ unsigned xb_ld(unsigned* p)              { return __hip_atomic_load(p, __ATOMIC_RELAXED, __HIP_MEMORY_SCOPE_AGENT); }
__device__ __forceinline__ unsigned xb_add(unsigned* p, unsigned v) { return __hip_atomic_fetch_add(p, v, __ATOMIC_RELAXED, __HIP_MEMORY_SCOPE_AGENT); }
__device__ __forceinline__ unsigned xb_xcc_id() { return (unsigned)__builtin_amdgcn_s_getreg((3 << 11) | 20) & 0xFu; }
#define XB_SPIN(cond, bar) do { unsigned _sp = 0; while (cond) { __builtin_amdgcn_s_sleep(1); \
    if ((++_sp & 255u) == 0u) { if (xb_ld(&(bar)[XB_TMO])) break; if (_sp > XB_SPIN_CAP) { atomicAdd(&(bar)[XB_TMO], 1u); break; } } } } while (0)

struct XcdBarrier {
    unsigned* bar; unsigned x;
    volatile LAS unsigned* st;
};

__device__ __forceinline__ XcdBarrier xcd_barrier_post(unsigned* bar, volatile LAS unsigned* st) {
    XcdBarrier b; b.bar = bar; b.x = xb_xcc_id(); b.st = st;
    if (threadIdx.x == 0) (void)xb_add(&bar[XB_XCNT(b.x)], 1u);
    return b;
}
__device__ __forceinline__ void xcd_barrier_complete(unsigned* bar, unsigned x, unsigned& nloc, unsigned& nx) {
    const unsigned G = gridDim.x * gridDim.y * gridDim.z;
    unsigned sum, cnt, mine, sp = 0u;
    for (;;) {
        sum = 0u; cnt = 0u; mine = 0u;
#pragma unroll
        for (unsigned j = 0; j < 16; ++j) { const unsigned c = xb_ld(&bar[XB_XCNT(j)]); sum += c; cnt += (c > 0u) ? 1u : 0u; mine = (j == x) ? c : mine; }
        if (sum == G) break;
        __builtin_amdgcn_s_sleep(1);
        if ((++sp & 255u) == 0u) { if (xb_ld(&bar[XB_TMO])) break; if (sp > XB_SPIN_CAP) { atomicAdd(&bar[XB_TMO], 1u); break; } }
    }
    nloc = mine > 0u ? mine : 1u; nx = cnt > 0u ? cnt : 1u;
}

__device__ __forceinline__ void xcd_barrier(const XcdBarrier& b) {
    asm volatile("s_waitcnt vmcnt(0)" ::: "memory");
    __syncthreads();
    if (threadIdx.x == 0) {
        unsigned* bar = b.bar;
        __builtin_amdgcn_s_waitcnt(0);
        unsigned nloc = b.st[0], nx = b.st[1];
        if (nloc == 0u) { xcd_barrier_complete(bar, b.x, nloc, nx); b.st[0] = nloc; b.st[1] = nx; }
        const unsigned old = xb_add(&bar[XB_XSUB(b.x)], 1u);
        const unsigned gen = old / nloc;
        if (old + 1u == (gen + 1u) * nloc) {
            __builtin_amdgcn_fence(__ATOMIC_RELEASE, "agent");
            asm volatile("s_waitcnt vmcnt(0)" ::: "memory");
            const unsigned og = xb_add(&bar[XB_TOP], 1u);
            const unsigned tg = og / nx;
            if (og + 1u == (tg + 1u) * nx) xb_add(&bar[XB_TOPGEN], 1u);
            else XB_SPIN(xb_ld(&bar[XB_TOPGEN]) == tg, bar);
            __builtin_amdgcn_fence(__ATOMIC_ACQUIRE, "agent");
            xb_add(&bar[XB_XGEN(b.x)], 1u);
            asm volatile("s_waitcnt vmcnt(0)" ::: "memory");
        } else {
            XB_SPIN(xb_ld(&bar[XB_XGEN(b.x)]) == gen, bar);
            __builtin_amdgcn_fence(__ATOMIC_ACQUIRE, "agent");
            asm volatile("s_waitcnt vmcnt(0)" ::: "memory");
        }
    }
    __syncthreads();
}


__device__ __forceinline__ void gsync(cg::grid_group& grid) {
    asm volatile("s_waitcnt vmcnt(0) lgkmcnt(0)" ::: "memory");
    grid.sync();
    if (threadIdx.x < 64) { __builtin_amdgcn_fence(__ATOMIC_ACQUIRE, "agent"); asm volatile("s_waitcnt vmcnt(0)" ::: "memory"); }
    __syncthreads();
}
__device__ __forceinline__ void transpose_item(const float* W, int lds_, int Ksrc, int Nsrc, bf16_t* WT, int ldd, int row_off, int col_off,
                                               const float* mu, int mode, LAS float* scr, int kb, int nb, int lane) {
    const int k0 = 64 * kb, n0 = 32 * nb;
#pragma unroll 8
    for (int i = 0; i < 32; ++i) { const int kk = 2 * i + (lane >> 5), nn = lane & 31, k = k0 + kk, n = n0 + nn;
        float v = (k < Ksrc && n < Nsrc) ? W[(size_t)k * lds_ + n] : 0.f;
        if (mode) { const float m = mu[k & 1023]; v *= (mode == 1) ? (1.f - m) : m; }
        scr[kk * 33 + nn] = v; }
    asm volatile("s_waitcnt lgkmcnt(0)" ::: "memory");
    const int c = lane & 7;
#pragma unroll
    for (int j = 0; j < 4; ++j) { const int n = (lane >> 3) + 8 * j; const LAS float* s = scr + (8 * c) * 33 + n;
        u32x4 o; o.x = cvt_pk_bf16(s[0 * 33], s[1 * 33]); o.y = cvt_pk_bf16(s[2 * 33], s[3 * 33]); o.z = cvt_pk_bf16(s[4 * 33], s[5 * 33]); o.w = cvt_pk_bf16(s[6 * 33], s[7 * 33]);
        *(u32x4*)(WT + (size_t)(row_off + n0 + n) * ldd + col_off + k0 + 8 * c) = o; }
    asm volatile("s_waitcnt lgkmcnt(0)" ::: "memory");
}

__device__ __forceinline__ void phase_prep(const Args& a, LAS unsigned char* lds) {
    const int tid = opaque_tid(), lane = tid & 63, wave = tid >> 6;
    unsigned char* ws = a.ws;
    {
        LAS float* sc = (LAS float*)lds;
        LAS float* red = (LAS float*)(lds + 65536);
        bool have = false;
        for (int it = blockIdx.x; it < 2 * 96; it += gridDim.x) {
            if (!have) { const float* c = a.in[1];
                for (int e = tid; e < 16 * 1024; e += NTHREADS) { const int b = e >> 10, k = e & 1023; const float x = c[e]; sc[k * 16 + b] = x / (1.f + __expf(-x)); }
                have = true; }
            __syncthreads();
            const int l = it / 96, n0 = (it % 96) * 64;
            const float* w = a.in[2] + (size_t)l * 1024 * 6144 + n0 + lane;
            float acc[16];
#pragma unroll
            for (int b = 0; b < 16; ++b) acc[b] = 0.f;
            const int kbeg = wave * 128;
#pragma unroll 8
            for (int k = kbeg; k < kbeg + 128; ++k) { const float wv = w[(size_t)k * 6144];
                const LAS f32x4* s4 = (const LAS f32x4*)(sc + k * 16);
#pragma unroll
                for (int q = 0; q < 4; ++q) { const f32x4 s = s4[q]; acc[4 * q] += s[0] * wv; acc[4 * q + 1] += s[1] * wv; acc[4 * q + 2] += s[2] * wv; acc[4 * q + 3] += s[3] * wv; } }
#pragma unroll
            for (int b = 0; b < 16; ++b) red[(wave * 16 + b) * 64 + lane] = acc[b];
            __syncthreads();
            float* mod = (float*)(ws + WS_MOD);
            for (int e = tid; e < 1024; e += NTHREADS) { const int b = e >> 6, n = e & 63; float s = 0.f;
#pragma unroll
                for (int wv = 0; wv < 8; ++wv) s += red[(wv * 16 + b) * 64 + n];
                mod[((size_t)l * 16 + b) * 6144 + n0 + n] = s + a.in[3][l * 6144 + n0 + n]; }
            __syncthreads();
        }
        __syncthreads();
    }
}
__device__ __forceinline__ void phase_weights(const Args& a, LAS unsigned char* lds) {
    const int tid = opaque_tid(), lane = tid & 63, wave = tid >> 6;
    unsigned char* ws = a.ws;
    {
        LAS float* scr = (LAS float*)(lds + wave * 16384);
        const int gw = blockIdx.x * NWAVES + wave, NGW = gridDim.x * NWAVES;
        const float* mu = a.in[12];
        constexpr int TOTAL = 16 * 64 + 16 * 32 + 2 * 16 * 128 + 2 * 64 * 32 + 3 * 16 * 32 + 2 * (16 * 4 + 16 * 4 + 16 * 8) + 24 * 32 + 16 * 32;
        for (int it = gw; it < TOTAL; it += NGW) {
            int r = it;
#define JOB(W, LDSRC, KS, NS, DST, LDD, RO, CO, MU, MODE, KB, NBK) if (r >= 0) { if (r < (KB) * (NBK)) { transpose_item((W), (LDSRC), (KS), (NS), (bf16_t*)(ws + (DST)), (LDD), (RO), (CO), (MU), (MODE), scr, r / (NBK), r % (NBK), lane); r = -1; } else r -= (KB) * (NBK); }
            JOB(a.in[6], 2048, 1024, 2048, WS_WIN0, 1024, 0, 0, mu, 0, 16, 64)
            JOB(a.in[11], 1024, 1024, 1024, WS_WOUT0, 1024, 0, 0, mu, 0, 16, 32)
            JOB(a.in[4], 4096, 1024, 4096, WS_W1, 1024, 0, 0, mu, 0, 16, 128)
            JOB(a.in[4] + (size_t)1024 * 4096, 4096, 1024, 4096, WS_W1 + (size_t)4096 * 1024 * 2, 1024, 0, 0, mu, 0, 16, 128)
            JOB(a.in[5], 1024, 4096, 1024, WS_W2, 4096, 0, 0, mu, 0, 64, 32)
            JOB(a.in[5] + (size_t)4096 * 1024, 1024, 4096, 1024, WS_W2 + (size_t)1024 * 4096 * 2, 4096, 0, 0, mu, 0, 64, 32)
            JOB(a.in[13] + 0, 3072, 1024, 1024, WS_WRKV, 1024, 0, 0, mu, 0, 16, 32)
            JOB(a.in[13] + 1024, 3072, 1024, 1024, WS_WRKV, 1024, 1024, 0, mu, 0, 16, 32)
            JOB(a.in[13] + 2048, 3072, 1024, 1024, WS_WRKV, 1024, 2048, 0, mu, 0, 16, 32)
            JOB(a.in[15], 64, 1024, 64, WS_WL1, 2048, 0, 0, mu + 1 * 1024, 1, 16, 4)
            JOB(a.in[15], 64, 1024, 64, WS_WL1, 2048, 0, 1024, mu + 1 * 1024, 2, 16, 4)
            JOB(a.in[18], 64, 1024, 64, WS_WL1, 2048, 128, 0, mu + 4 * 1024, 1, 16, 4)
            JOB(a.in[18], 64, 1024, 64, WS_WL1, 2048, 128, 1024, mu + 4 * 1024, 2, 16, 4)
            JOB(a.in[20], 160, 1024, 160, WS_WL1, 2048, 256, 0, mu + 5 * 1024, 1, 16, 8)
            JOB(a.in[20], 160, 1024, 160, WS_WL1, 2048, 256, 1024, mu + 5 * 1024, 2, 16, 8)
            JOB(a.in[16], 1024, 64, 1024, WS_WL2, 512, 0, 0, mu, 0, 2, 32)
            JOB(a.in[16], 1024, 0, 1024, WS_WL2, 512, 0, 128, mu, 0, 6, 32)
            JOB(a.in[19], 1024, 0, 1024, WS_WL2, 512, 1024, 0, mu, 0, 2, 32)
            JOB(a.in[19], 1024, 64, 1024, WS_WL2, 512, 1024, 128, mu, 0, 2, 32)
            JOB(a.in[19], 1024, 0, 1024, WS_WL2, 512, 1024, 256, mu, 0, 4, 32)
            JOB(a.in[21], 1024, 0, 1024, WS_WL2, 512, 2048, 0, mu, 0, 4, 32)
            JOB(a.in[21], 1024, 160, 1024, WS_WL2, 512, 2048, 256, mu, 0, 4, 32)
            JOB(a.in[27], 1024, 1024, 1024, WS_WOUT1, 1024, 0, 0, mu, 0, 16, 32)
#undef JOB
        }
        bf16_t* wsb = (bf16_t*)(ws + WS_WS);
        for (int e = blockIdx.x * NTHREADS + tid; e < 8 * 128 * 128 / 2; e += gridDim.x * NTHREADS) {
            const int i = e * 2, s = i & 127, t = (i >> 7) & 127;
            const float v0 = (s <= t) ? a.in[9][i] : 0.f, v1 = (s + 1 <= t) ? a.in[9][i + 1] : 0.f;
            ((unsigned*)wsb)[e] = cvt_pk_bf16(v0, v1);
        }
    }
}

__device__ __forceinline__ void phase_norm_mod(const float* x, const float* mod_shift, const float* mod_scale, bf16_t* H, int) {
    const int tid = opaque_tid(), lane = tid & 63, wave = tid >> 6;
    const int gw = blockIdx.x * NWAVES + wave, NGW = gridDim.x * NWAVES;
    constexpr int NR = 4;
    for (int m0 = gw; m0 < M; m0 += NR * NGW) {
        f32x4 v[NR][4];
#pragma unroll
        for (int r = 0; r < NR; ++r) { const int m = M - 1 - (m0 + r * NGW < M ? m0 + r * NGW : m0); const f32x4* xr = (const f32x4*)(x + (size_t)m * D) + lane;
#pragma unroll
            for (int j = 0; j < 4; ++j) v[r][j] = xr[64 * j]; }
#pragma unroll
        for (int r = 0; r < NR; ++r) { const int m = M - 1 - (m0 + r * NGW); if (m >= 0) {
            const int b = m >> 12; float s = 0.f;
#pragma unroll
            for (int j = 0; j < 4; ++j) s += (v[r][j].x * v[r][j].x + v[r][j].y * v[r][j].y) + (v[r][j].z * v[r][j].z + v[r][j].w * v[r][j].w);
            const float rstd = 1.0f / sqrtf(wave_sum(s) * (1.f / D) + 1e-6f);
            const f32x4* sh = (const f32x4*)(mod_shift + (size_t)b * 6144) + lane;
            const f32x4* sc = (const f32x4*)(mod_scale + (size_t)b * 6144) + lane;
            u32x2* o = (u32x2*)(H + (size_t)m * D) + lane;
#pragma unroll
            for (int j = 0; j < 4; ++j) { const f32x4 a = sh[64 * j], c = sc[64 * j]; const f32x4 h = v[r][j] * rstd * (c + 1.0f) + a;
                u32x2 w; w.x = cvt_pk_bf16(h.x, h.y); w.y = cvt_pk_bf16(h.z, h.w); o[64 * j] = w; } } }
    }
}
__device__ __forceinline__ void phase_final_norm(float* x, const float* g) {
    const int tid = opaque_tid(), lane = tid & 63, wave = tid >> 6;
    const int gw = blockIdx.x * NWAVES + wave, NGW = gridDim.x * NWAVES;
    constexpr int NR = 4;
    f32x4 gg[4];
#pragma unroll
    for (int j = 0; j < 4; ++j) gg[j] = ((const f32x4*)g)[lane + 64 * j];
    for (int m0 = gw; m0 < M; m0 += NR * NGW) {
        f32x4 v[NR][4];
#pragma unroll
        for (int r = 0; r < NR; ++r) { const int m = (m0 + r * NGW < M ? m0 + r * NGW : m0); const f32x4* xr = (const f32x4*)(x + (size_t)m * D) + lane;
#pragma unroll
            for (int j = 0; j < 4; ++j) v[r][j] = xr[64 * j]; }
#pragma unroll
        for (int r = 0; r < NR; ++r) { const int m = m0 + r * NGW; if (m < M) {
            float s = 0.f;
#pragma unroll
            for (int j = 0; j < 4; ++j) s += (v[r][j].x * v[r][j].x + v[r][j].y * v[r][j].y) + (v[r][j].z * v[r][j].z + v[r][j].w * v[r][j].w);
            const float rstd = 1.0f / sqrtf(wave_sum(s) * (1.f / D) + 1e-6f);
            f32x4* xr = (f32x4*)(x + (size_t)m * D) + lane;
#pragma unroll
            for (int j = 0; j < 4; ++j) xr[64 * j] = v[r][j] * rstd * gg[j]; } }
    }
}
__device__ __forceinline__ void load_row(const float* x, size_t m, int lane, f32x4 (&v)[4]) {
    const f32x4* xr = (const f32x4*)(x + m * D) + lane;
#pragma unroll
    for (int j = 0; j < 4; ++j) v[j] = xr[64 * j];
}
__device__ __forceinline__ void finish_row(f32x4 (&h)[4], const f32x4 (&sh)[4], const f32x4 (&sc1)[4]) {
    float s = 0.f;
#pragma unroll
    for (int j = 0; j < 4; ++j) s += (h[j].x * h[j].x + h[j].y * h[j].y) + (h[j].z * h[j].z + h[j].w * h[j].w);
    const float rstd = 1.0f / sqrtf(wave_sum(s) * (1.f / D) + 1e-6f);
#pragma unroll
    for (int j = 0; j < 4; ++j) h[j] = h[j] * rstd * sc1[j] + sh[j];
}
__device__ __forceinline__ void phase_norm_shift(const float* x, const float* mod_shift, const float* mod_scale, const float* mu, bf16_t* X3, bf16_t* H2) {
    const int tid = opaque_tid(), lane = tid & 63, wave = tid >> 6;
    const int gw = blockIdx.x * NWAVES + wave, NGW = gridDim.x * NWAVES;
    f32x4 mr[4], mk[4], mv[4];
#pragma unroll
    for (int j = 0; j < 4; ++j) { mr[j] = ((const f32x4*)(mu + 0 * 1024))[lane + 64 * j]; mk[j] = ((const f32x4*)(mu + 2 * 1024))[lane + 64 * j]; mv[j] = ((const f32x4*)(mu + 3 * 1024))[lane + 64 * j]; }
    for (int blk = gw; blk < M / 32; blk += NGW) {
        const size_t m0 = (size_t)blk * 32; const int b = (int)(m0 >> 12);
        f32x4 sh[4], sc1[4];
#pragma unroll
        for (int j = 0; j < 4; ++j) { sh[j] = ((const f32x4*)(mod_shift + (size_t)b * 6144))[lane + 64 * j]; sc1[j] = ((const f32x4*)(mod_scale + (size_t)b * 6144))[lane + 64 * j] + 1.0f; }
        f32x4 hp[4], h[4], n1[4], n2[4];
        const bool first = (m0 & 4095) == 0;
        load_row(x, first ? m0 : m0 - 1, lane, hp); load_row(x, m0, lane, h); load_row(x, m0 + 1, lane, n1);
        finish_row(hp, sh, sc1);
        if (first) {
#pragma unroll
            for (int j = 0; j < 4; ++j) hp[j] = (f32x4){0.f, 0.f, 0.f, 0.f}; }
        for (int i = 0; i < 32; ++i) {
            const size_t m = m0 + i;
            load_row(x, (i + 2 < 32) ? m + 2 : m, lane, n2);
            finish_row(h, sh, sc1);
            u32x2* o2 = (u32x2*)(H2 + (m + b + 1) * D) + lane;
            u32x2* or_ = (u32x2*)(X3 + m * D) + lane;
#pragma unroll
            for (int j = 0; j < 4; ++j) {
                const f32x4 d = hp[j] - h[j];
                const f32x4 xr = h[j] + d * mr[j], xk = h[j] + d * mk[j], xv = h[j] + d * mv[j];
                u32x2 w; w.x = cvt_pk_bf16(h[j].x, h[j].y); w.y = cvt_pk_bf16(h[j].z, h[j].w); o2[64 * j] = w;
                if (first && i == 0) o2[64 * j - D / 4] = (u32x2){0u, 0u};
                w.x = cvt_pk_bf16(xr.x, xr.y); w.y = cvt_pk_bf16(xr.z, xr.w); or_[64 * j] = w;
                w.x = cvt_pk_bf16(xk.x, xk.y); w.y = cvt_pk_bf16(xk.z, xk.w); or_[64 * j + (size_t)M * D / 4] = w;
                w.x = cvt_pk_bf16(xv.x, xv.y); w.y = cvt_pk_bf16(xv.z, xv.w); or_[64 * j + 2 * (size_t)M * D / 4] = w;
                hp[j] = h[j]; h[j] = n1[j]; n1[j] = n2[j];
            }
        }
    }
}

__device__ __forceinline__ void phase_sgu(const Args& a, LAS unsigned char* lds) {
    const int tid = opaque_tid(), lane = tid & 63, wave = tid >> 6, fr = lane & 15, fq = lane >> 4;
    const bf16_t* UV = (const bf16_t*)(a.ws + WS_UV); bf16_t* Z = (bf16_t*)(a.ws + WS_Z);
    const bf16_t* WSB = (const bf16_t*)(a.ws + WS_WS);
    const float* lng = a.in[7]; const float* lnb = a.in[8]; const float* bs = a.in[10];
    constexpr int RS = 272;
    LAS unsigned char* Wl = lds;
    LAS unsigned char* Vl = lds + 128 * RS;
    LAS f32x2* st = (LAS f32x2*)(lds + 2 * 128 * RS);
    const int wt = wave >> 2, wd = wave & 3;
    for (int tile_ = blockIdx.x; tile_ < M / 128; tile_ += gridDim.x) {
        const int tile = M / 128 - 1 - tile_;
        const size_t m0 = (size_t)tile * 128;
        for (int r = wave * 16; r < wave * 16 + 16; ++r) {
            const u32x4* p = (const u32x4*)(UV + (m0 + r) * 2048 + 1024) + lane;
            const u32x4 q0 = p[0], q1 = p[64];
            float f[16];
            f[0] = bf_lo(q0.x); f[1] = bf_hi(q0.x); f[2] = bf_lo(q0.y); f[3] = bf_hi(q0.y); f[4] = bf_lo(q0.z); f[5] = bf_hi(q0.z); f[6] = bf_lo(q0.w); f[7] = bf_hi(q0.w);
            f[8] = bf_lo(q1.x); f[9] = bf_hi(q1.x); f[10] = bf_lo(q1.y); f[11] = bf_hi(q1.y); f[12] = bf_lo(q1.z); f[13] = bf_hi(q1.z); f[14] = bf_lo(q1.w); f[15] = bf_hi(q1.w);
            float s = 0.f;
#pragma unroll
            for (int e = 0; e < 16; ++e) s += f[e];
            const float mean = wave_sum(s) * (1.f / 1024.f);
            float q = 0.f;
#pragma unroll
            for (int e = 0; e < 16; ++e) { const float d = f[e] - mean; q += d * d; }
            const float var = wave_sum(q) * (1.f / 1024.f);
            if (lane == 0) st[r] = (f32x2){mean, 1.0f / sqrtf(var + 1e-5f)};
        }
        __syncthreads();
        for (int g = 0; g < 8; ++g) {
            {
                const u32x4* src = (const u32x4*)(WSB + (size_t)g * 128 * 128);
#pragma unroll
                for (int i = 0; i < 4; ++i) { const int idx = tid + i * NTHREADS; const int t = idx >> 4, c = idx & 15;
                    *(LAS u32x4*)(Wl + t * RS + c * 16) = src[idx]; }
            }
            {
                const int sp = tid & 63, dq = tid >> 6, s0 = 2 * sp, d0 = dq * 16;
                const f32x2 st0 = st[s0], st1 = st[s0 + 1];
                const bf16_t* p0 = UV + (m0 + s0) * 2048 + 1024 + g * 128 + d0;
                const u32x4 a0 = *(const u32x4*)p0, a1 = *(const u32x4*)(p0 + 8), b0 = *(const u32x4*)(p0 + 2048), b1 = *(const u32x4*)(p0 + 2048 + 8);
                const unsigned ua[8] = {a0.x, a0.y, a0.z, a0.w, a1.x, a1.y, a1.z, a1.w}, ub[8] = {b0.x, b0.y, b0.z, b0.w, b1.x, b1.y, b1.z, b1.w};
                const float* gp = lng + g * 128 + d0; const float* bp = lnb + g * 128 + d0;
#pragma unroll
                for (int e = 0; e < 8; ++e) {
                    const float g0 = gp[2 * e], g1 = gp[2 * e + 1], c0 = bp[2 * e], c1 = bp[2 * e + 1];
                    const float x00 = (bf_lo(ua[e]) - st0.x) * st0.y * g0 + c0, x01 = (bf_hi(ua[e]) - st0.x) * st0.y * g1 + c1;
                    const float x10 = (bf_lo(ub[e]) - st1.x) * st1.y * g0 + c0, x11 = (bf_hi(ub[e]) - st1.x) * st1.y * g1 + c1;
                    *(LAS unsigned*)(Vl + (d0 + 2 * e) * RS + s0 * 2) = cvt_pk_bf16(x00, x10);
                    *(LAS unsigned*)(Vl + (d0 + 2 * e + 1) * RS + s0 * 2) = cvt_pk_bf16(x01, x11);
                }
            }
            __syncthreads();
            f32x4 acc[4][2];
#pragma unroll
            for (int mi = 0; mi < 4; ++mi)
#pragma unroll
                for (int ni = 0; ni < 2; ++ni) acc[mi][ni] = (f32x4){0.f, 0.f, 0.f, 0.f};
#pragma unroll
            for (int ks = 0; ks < 4; ++ks) {
                if (ks * 32 <= 64 * wt + 63) {
                    bf16x8 bfr[2];
#pragma unroll
                    for (int ni = 0; ni < 2; ++ni) bfr[ni] = *(const LAS bf16x8*)(Vl + (32 * wd + 16 * ni + fr) * RS + (ks * 32 + fq * 8) * 2);
#pragma unroll
                    for (int mi = 0; mi < 4; ++mi) {
                        if (ks * 32 <= 64 * wt + 16 * mi + 15) {
                            const bf16x8 afr = *(const LAS bf16x8*)(Wl + (64 * wt + 16 * mi + fr) * RS + (ks * 32 + fq * 8) * 2);
#pragma unroll
                            for (int ni = 0; ni < 2; ++ni) acc[mi][ni] = __builtin_amdgcn_mfma_f32_16x16x32_bf16(bfr[ni], afr, acc[mi][ni], 0, 0, 0);
                        }
                    }
                }
            }
#pragma unroll
            for (int mi = 0; mi < 4; ++mi) {
                const int t = 64 * wt + 16 * mi + fr; const float bias = bs[g * 128 + t];
#pragma unroll
                for (int ni = 0; ni < 2; ++ni) {
                    const int col = g * 128 + 32 * wd + 16 * ni + 4 * fq;
                    const u32x2 uu = *(const u32x2*)(UV + (m0 + t) * 2048 + col);
                    const f32x4 sv = acc[mi][ni];
                    u32x2 o; o.x = cvt_pk_bf16(bf_lo(uu.x) * (sv[0] + bias), bf_hi(uu.x) * (sv[1] + bias)); o.y = cvt_pk_bf16(bf_lo(uu.y) * (sv[2] + bias), bf_hi(uu.y) * (sv[3] + bias));
                    *(u32x2*)(Z + (m0 + t) * 1024 + col) = o;
                }
            }
            __syncthreads();
        }
    }
}

__device__ __forceinline__ float fma_(float a, float b, float c) { float d; asm("v_fma_f32 %0, %1, %2, %3" : "=v"(d) : "v"(a), "v"(b), "v"(c)); return d; }
__device__ __forceinline__ float mul_(float a, float b) { float d; asm("v_mul_f32 %0, %1, %2" : "=v"(d) : "v"(a), "v"(b)); return d; }
__device__ __forceinline__ float dot4_(const f32x4& s, const f32x4& o) { return fma_(s.w, o.w, fma_(s.z, o.z, fma_(s.y, o.y, mul_(s.x, o.x)))); }
__device__ __forceinline__ void upd4_(f32x4& s, const f32x4& w, const f32x4& b, const f32x4& k, float sa, float v) {
    s.x = fma_(v, k.x, fma_(sa, b.x, mul_(s.x, w.x))); s.y = fma_(v, k.y, fma_(sa, b.y, mul_(s.y, w.y)));
    s.z = fma_(v, k.z, fma_(sa, b.z, mul_(s.z, w.z))); s.w = fma_(v, k.w, fma_(sa, b.w, mul_(s.w, w.w)));
}
__device__ __forceinline__ f32x2 pkmul_(f32x2 a, f32x2 b) { f32x2 d; asm("v_pk_mul_f32 %0, %1, %2" : "=v"(d) : "v"(a), "v"(b)); return d; }
__device__ __forceinline__ f32x2 pkfma_(f32x2 a, f32x2 b, f32x2 c) { f32x2 d; asm("v_pk_fma_f32 %0, %1, %2, %3" : "=v"(d) : "v"(a), "v"(b), "v"(c)); return d; }
__device__ __forceinline__ f32x2 pkfma_lo_(f32x2 a, f32x2 b, f32x2 c) { f32x2 d; asm("v_pk_fma_f32 %0, %1, %2, %3 op_sel_hi:[0,1,1]" : "=v"(d) : "v"(a), "v"(b), "v"(c)); return d; }
__device__ __forceinline__ f32x2 pkfma_hi_(f32x2 a, f32x2 b, f32x2 c) { f32x2 d; asm("v_pk_fma_f32 %0, %1, %2, %3 op_sel:[1,0,0]" : "=v"(d) : "v"(a), "v"(b), "v"(c)); return d; }
__device__ __forceinline__ float add_(float a, float b) { float d; asm("v_add_f32 %0, %1, %2" : "=v"(d) : "v"(a), "v"(b)); return d; }
template <int SEL> __device__ __forceinline__ f32x2 pkmul_b(f32x2 s, f32x2 o) { f32x2 d;
    if (SEL == 0) asm("v_pk_mul_f32 %0, %1, %2 op_sel_hi:[1,0]" : "=v"(d) : "v"(s), "v"(o)); else asm("v_pk_mul_f32 %0, %1, %2 op_sel:[0,1]" : "=v"(d) : "v"(s), "v"(o)); return d; }
template <int SEL> __device__ __forceinline__ f32x2 pkfma_b(f32x2 s, f32x2 o, f32x2 c) { f32x2 d;
    if (SEL == 0) asm("v_pk_fma_f32 %0, %1, %2, %3 op_sel_hi:[1,0,1]" : "=v"(d) : "v"(s), "v"(o), "v"(c)); else asm("v_pk_fma_f32 %0, %1, %2, %3 op_sel:[0,1,0]" : "=v"(d) : "v"(s), "v"(o), "v"(c)); return d; }
#define LO2(v) __builtin_shufflevector(v, v, 0, 1)
#define HI2(v) __builtin_shufflevector(v, v, 2, 3)
__device__ __forceinline__ void phase_scan(const Args& a, LAS unsigned char* lds) {
    const int tid = opaque_tid(), lane = tid & 63, wave = tid >> 6;
    constexpr int TC = 32;
    LAS float* op = (LAS float*)lds;
    LAS float* vb = (LAS float*)(lds + (TC + 1) * 1280);
    LAS float* yb = (LAS float*)(lds + (TC + 1) * 1280 + (TC + 1) * 256);
    const bf16_t* Rg = (const bf16_t*)(a.ws + WS_R); const bf16_t* Kg = (const bf16_t*)(a.ws + WS_K); const bf16_t* Vg = (const bf16_t*)(a.ws + WS_V);
    const bf16_t* Lg = (const bf16_t*)(a.ws + WS_L); const bf16_t* WL2 = (const bf16_t*)(a.ws + WS_WL2);
    constexpr int XS = 68;
    LAS float* xb = (LAS float*)(lds + (TC + 1) * 1280 + (TC + 1) * 256 + TC * 1024);
    const int fr = lane & 15, fq = lane >> 4, stile = wave >> 2, ntile = wave & 3;
    bf16_t* YG = (bf16_t*)(a.ws + WS_YG);
    const int ts = tid >> 4, jg = tid & 15;
    const int ig = lane >> 4;
    const int r0 = wave * 8 + ig * 2;
    for (int hd = blockIdx.x; hd < NB * 16; hd += gridDim.x) {
        const int b = hd >> 4, h = hd & 15;
        const int ch = h * 64 + jg * 4;
        const f32x4 kk4 = *(const f32x4*)(a.in[22] + ch), ka4 = *(const f32x4*)(a.in[23] + ch), rk4 = *(const f32x4*)(a.in[24] + ch);
        const f32x4 lg4 = *(const f32x4*)(a.in[25] + ch), lb4 = *(const f32x4*)(a.in[26] + ch);
        const size_t base = ((size_t)b * T) * D + ch;
        f32x2 C0 = {0.f, 0.f}, C1 = {0.f, 0.f}, C2 = {0.f, 0.f}, C3 = {0.f, 0.f};
        size_t off = base + (size_t)ts * D;
        u32x2 pr = *(const u32x2*)(Rg + off), pk = *(const u32x2*)(Kg + off), pv = *(const u32x2*)(Vg + off);
        const int chn = h * 64 + ntile * 16 + fr;
        bf16x8 bw[2], ba[2], bg[5];
#pragma unroll
        for (int ks = 0; ks < 2; ++ks) { bw[ks] = *(const bf16x8*)(WL2 + (size_t)chn * 512 + ks * 32 + fq * 8); ba[ks] = *(const bf16x8*)(WL2 + (size_t)(1024 + chn) * 512 + 128 + ks * 32 + fq * 8); }
#pragma unroll
        for (int ks = 0; ks < 5; ++ks) bg[ks] = *(const bf16x8*)(WL2 + (size_t)(2048 + chn) * 512 + 256 + ks * 32 + fq * 8);
        const float w0c = a.in[14][chn], a0c = a.in[17][chn];
        bf16x8 aw[2], aa[2], ag[5];
#define LORA_LOAD(cc) do { const bf16_t* lrow = Lg + ((size_t)b * T + (size_t)(cc) * TC + stile * 16 + fr) * 512 + fq * 8; \
            _Pragma("unroll") for (int ks = 0; ks < 2; ++ks) { aw[ks] = *(const bf16x8*)(lrow + ks * 32); aa[ks] = *(const bf16x8*)(lrow + 128 + ks * 32); } \
            _Pragma("unroll") for (int ks = 0; ks < 5; ++ks) ag[ks] = *(const bf16x8*)(lrow + 256 + ks * 32); } while (0)
#define LORA_RUN() do { f32x4 cw = {0.f, 0.f, 0.f, 0.f}, ca = {0.f, 0.f, 0.f, 0.f}, cg_ = {0.f, 0.f, 0.f, 0.f}; \
            _Pragma("unroll") for (int ks = 0; ks < 2; ++ks) { cw = __builtin_amdgcn_mfma_f32_16x16x32_bf16(aw[ks], bw[ks], cw, 0, 0, 0); ca = __builtin_amdgcn_mfma_f32_16x16x32_bf16(aa[ks], ba[ks], ca, 0, 0, 0); } \
            _Pragma("unroll") for (int ks = 0; ks < 5; ++ks) cg_ = __builtin_amdgcn_mfma_f32_16x16x32_bf16(ag[ks], bg[ks], cg_, 0, 0, 0); \
            _Pragma("unroll") for (int e = 0; e < 4; ++e) { const int xi = (stile * 16 + 4 * fq + e) * XS + ntile * 16 + fr; \
                xb[xi] = __builtin_amdgcn_exp2f(-0.87503988f * __builtin_amdgcn_rcpf(1.0f + __expf(-(w0c + cw[e])))); \
                xb[TC * XS + xi] = __builtin_amdgcn_rcpf(1.0f + __expf(-(a0c + ca[e]))); \
                xb[2 * TC * XS + xi] = cg_[e]; } } while (0)
        LORA_LOAD(0); LORA_RUN();
        __syncthreads();
        u32x2 ypend = {0u, 0u};
        for (int c = 0; c < T / TC; ++c) {
            const f32x4 r4 = {bf_lo(pr.x), bf_hi(pr.x), bf_lo(pr.y), bf_hi(pr.y)};
            const f32x4 k4 = {bf_lo(pk.x), bf_hi(pk.x), bf_lo(pk.y), bf_hi(pk.y)};
            const f32x4 v4 = {bf_lo(pv.x), bf_hi(pv.x), bf_lo(pv.y), bf_hi(pv.y)};
            const f32x4 w4 = *(const LAS f32x4*)(xb + ts * XS + jg * 4), a4 = *(const LAS f32x4*)(xb + TC * XS + ts * XS + jg * 4), g4 = *(const LAS f32x4*)(xb + 2 * TC * XS + ts * XS + jg * 4);
            const f32x4 kkx = k4 * kk4;
            const float ss = reduce16((kkx.x * kkx.x + kkx.y * kkx.y) + (kkx.z * kkx.z + kkx.w * kkx.w));
            const float inv = __builtin_amdgcn_rsqf(fmaxf(ss, 1e-24f));
            const f32x4 kk = kkx * inv;
            const f32x4 kf = k4 * ((a4 - 1.0f) * ka4 + 1.0f);
            const f32x4 am = -kk, bm = kk * a4;
            const f32x4 rkr = r4 * kf * rk4;
            const float ct = reduce16((rkr.x + rkr.y) + (rkr.z + rkr.w));
            {
                LAS f32x4* o = (LAS f32x4*)(op + (ts * 16 + jg) * 20);
                o[0] = w4; o[1] = am; o[2] = bm; o[3] = kf; o[4] = r4;
                *(LAS f32x4*)(vb + ts * 64 + jg * 4) = v4;
            }
            __syncthreads();
            if (c > 0) *(u32x2*)(YG + base + (size_t)((c - 1) * TC + ts) * D) = ypend;
            if (c + 1 < T / TC) { off = base + (size_t)((c + 1) * TC + ts) * D;
                pr = *(const u32x2*)(Rg + off); pk = *(const u32x2*)(Kg + off); pv = *(const u32x2*)(Vg + off);
                LORA_LOAD(c + 1); }
            {
                const LAS float* obase = op + (lane & 15) * 20;
                const LAS float* vbase = vb + r0;
                f32x4 ow = *(const LAS f32x4*)(obase), oa = *(const LAS f32x4*)(obase + 4), ob = *(const LAS f32x4*)(obase + 8), ok = *(const LAS f32x4*)(obase + 12), orr = *(const LAS f32x4*)(obase + 16);
                f32x2 vv = *(const LAS f32x2*)(vbase);
#pragma unroll 4
                for (int s = 0; s < TC; ++s) {
                    const LAS float* o = obase + (s + 1) * 320;
                    const f32x4 now = *(const LAS f32x4*)(o), noa = *(const LAS f32x4*)(o + 4), nob = *(const LAS f32x4*)(o + 8), nok = *(const LAS f32x4*)(o + 12), norr = *(const LAS f32x4*)(o + 16);
                    const f32x2 nvv = *(const LAS f32x2*)(vbase + (s + 1) * 64);
                    const f32x2 p = pkfma_b<1>(C3, HI2(oa), pkfma_b<0>(C2, HI2(oa), pkfma_b<1>(C1, LO2(oa), pkmul_b<0>(C0, LO2(oa)))));
                    float sa0 = p.x, sa1 = p.y;
                    sa0 = reduce16(sa0); asm volatile("" : "+v"(sa0)); sa1 = reduce16(sa1);
                    const f32x2 sap = {sa0, sa1};
                    C0 = pkfma_b<0>(vv, LO2(ok), pkfma_b<0>(sap, LO2(ob), pkmul_b<0>(C0, LO2(ow))));
                    C1 = pkfma_b<1>(vv, LO2(ok), pkfma_b<1>(sap, LO2(ob), pkmul_b<1>(C1, LO2(ow))));
                    C2 = pkfma_b<0>(vv, HI2(ok), pkfma_b<0>(sap, HI2(ob), pkmul_b<0>(C2, HI2(ow))));
                    C3 = pkfma_b<1>(vv, HI2(ok), pkfma_b<1>(sap, HI2(ob), pkmul_b<1>(C3, HI2(ow))));
                    const f32x2 q = pkfma_b<1>(C3, HI2(orr), pkfma_b<0>(C2, HI2(orr), pkfma_b<1>(C1, LO2(orr), pkmul_b<0>(C0, LO2(orr)))));
                    float y0 = q.x, y1 = q.y;
                    y0 += dppf<0xB1>(y0); y1 += dppf<0xB1>(y1); y0 += dppf<0x4E>(y0); y1 += dppf<0x4E>(y1);
                    *(LAS f32x2*)(yb + ((s * 32 + (r0 >> 1)) * 4 + ((lane >> 2) & 3)) * 2) = (f32x2){y0, y1};
                    ow = now; oa = noa; ob = nob; ok = nok; orr = norr; vv = nvv;
                }
            }
            __syncthreads();
            {
                const LAS f32x4* yq = (const LAS f32x4*)(yb + (ts * 32 + 2 * jg) * 8);
                const f32x4 A0 = yq[0], A1 = yq[1], B0 = yq[2], B1 = yq[3];
                const f32x4 y4 = {(A0.x + A0.z) + (A1.x + A1.z), (A0.y + A0.w) + (A1.y + A1.w), (B0.x + B0.z) + (B1.x + B1.z), (B0.y + B0.w) + (B1.y + B1.w)};
                const float mean = reduce16((y4.x + y4.y) + (y4.z + y4.w)) * (1.f / 64.f);
                const f32x4 d = y4 - mean;
                const float var = reduce16((d.x * d.x + d.y * d.y) + (d.z * d.z + d.w * d.w)) * (1.f / 64.f);
                const float rstd = __builtin_amdgcn_rsqf(var + 64e-5f);
                const f32x4 o = ((d * rstd) * lg4 + lb4 + v4 * ct) * g4;
                u32x2 w; w.x = cvt_pk_bf16(o.x, o.y); w.y = cvt_pk_bf16(o.z, o.w);
                ypend = w;
            }
            if (c + 1 < T / TC) LORA_RUN();
            __syncthreads();
        }
        *(u32x2*)(YG + base + (size_t)((T / TC - 1) * TC + ts) * D) = ypend;
#undef LORA_LOAD
#undef LORA_RUN
    }
}


#define SEAM() do { ++ph; if (lo < ph && ph < hi) { if (lo < 0) gsync(grid); else xcd_barrier(xbar); } } while (0)
#define RUN (lo <= ph && ph < hi)
template <int l> __device__ __forceinline__ void layer(const Args& a, LAS unsigned char* lds, cg::grid_group& grid, const XcdBarrier& xbar, int& ph, const int lo, const int hi) {
    unsigned char* ws = a.ws;
    const float* MOD = (const float*)(ws + WS_MOD);
    bf16_t* H = (bf16_t*)(ws + WS_H);
    const int G = gridDim.x, c = blockIdx.x;
    const float* mod = MOD + (size_t)l * 16 * 6144;
    const float* xin = (l == 0) ? a.in[0] : a.out;
    if (RUN) {
        if (l == 1) phase_norm_shift(xin, mod + 0 * 1024, mod + 1 * 1024, a.in[12], (bf16_t*)(ws + WS_X3), (bf16_t*)(ws + WS_H2));
        else if ((threadIdx.x >> 6) < 4) { phase_norm_mod(xin, mod + 0 * 1024, mod + 1 * 1024, H, 0); phase_weights(a, lds); }
        else { phase_weights(a, lds); phase_norm_mod(xin, mod + 0 * 1024, mod + 1 * 1024, H, 0); }
    }
    SEAM();
    if (l == 0) {
        if (RUN) { pg8::Gemm g{H, (const bf16_t*)(ws + WS_WIN0), M, 2048, 1024, 0, 0}; pg8::StaticOrder S; S.init(M, 2048, G, c);
          pg8::EpiAct<1> E{(bf16_t*)(ws + WS_UV), 2048}; pg8::gemm_phase(lds, g, S, E); }
        SEAM();
        if (RUN) phase_sgu(a, lds);
        SEAM();
        if (RUN) { pg8::Gemm g{(const bf16_t*)(ws + WS_Z), (const bf16_t*)(ws + WS_WOUT0), M, 1024, 1024, 0, 0}; pg8::StaticOrder S; S.init(M, 1024, G, c);
          pg8::EpiRes E{a.in[0], a.out, mod + 2 * 1024, 6144}; pg8::gemm_phase(lds, g, S, E); }
    } else {
        if (RUN) {
          { pg8::Gemm g{(const bf16_t*)(ws + WS_H2), (const bf16_t*)(ws + WS_WL1), M, 512, 2048, 0, 1}; pg8::StaticOrder S; S.init(M, 512, G, c, 1);
            pg8::EpiRkvL E{(bf16_t*)(ws + WS_R), (size_t)(WS_K - WS_R) / 2, (bf16_t*)(ws + WS_L), 12}; pg8::gemm_phase(lds, g, S, E); }
          { pg8::Gemm g{(const bf16_t*)(ws + WS_X3), (const bf16_t*)(ws + WS_WRKV), M, 3072, 1024, (long)M * D, 0}; pg8::StaticOrder S; S.init(M, 3072, G, c, 1);
            pg8::EpiRkvL E{(bf16_t*)(ws + WS_R), (size_t)(WS_K - WS_R) / 2, (bf16_t*)(ws + WS_L), 0}; pg8::gemm_phase(lds, g, S, E); }
        }
        SEAM();
        if (RUN) phase_scan(a, lds);
        SEAM();
        if (RUN) { pg8::Gemm g{(const bf16_t*)(ws + WS_YG), (const bf16_t*)(ws + WS_WOUT1), M, 1024, 1024, 0, 0}; pg8::StaticOrder S; S.init(M, 1024, G, c);
          pg8::EpiRes E{a.out, a.out, mod + 2 * 1024, 6144}; pg8::gemm_phase(lds, g, S, E); }
    }
    SEAM();
    if (RUN) phase_norm_mod(a.out, mod + 3 * 1024, mod + 4 * 1024, H, 0);
    SEAM();
    if (RUN) { pg8::Gemm g{H, (const bf16_t*)(ws + WS_W1 + (size_t)l * 4096 * 1024 * 2), M, 4096, 1024, 0, 0}; pg8::StaticOrder S; S.init(M, 4096, G, c);
      pg8::EpiAct<2> E{(bf16_t*)(ws + WS_HID), 4096}; pg8::gemm_phase(lds, g, S, E); }
    SEAM();
    if (RUN) { pg8::Gemm g{(const bf16_t*)(ws + WS_HID), (const bf16_t*)(ws + WS_W2 + (size_t)l * 1024 * 4096 * 2), M, 1024, 4096, 0, 0}; pg8::StaticOrder S; S.init(M, 1024, G, c, 1);
      pg8::EpiRes E{a.out, a.out, mod + 5 * 1024, 6144}; pg8::gemm_phase(lds, g, S, E); }
    SEAM();
}
constexpr int NPHASES = 16;

__global__ void __launch_bounds__(NTHREADS, 2) fwd_megakernel(Args a) {
    extern __shared__ __attribute__((aligned(16))) unsigned char lds_raw[];
    LAS unsigned char* lds = (LAS unsigned char*)lds_raw;
    cg::grid_group grid = cg::this_grid();
    const int lo = a.lo, hi = a.hi;
    int ph = 0;
    volatile LAS unsigned* bst = (volatile LAS unsigned*)(lds + 131072 + 512);
    if (threadIdx.x < 2) bst[threadIdx.x] = 0u;
    __syncthreads();
    XcdBarrier xbar; xbar.bar = (unsigned*)a.ws; xbar.x = 0; xbar.st = nullptr;
    if (hi - lo > 1) xbar = xcd_barrier_post((unsigned*)a.ws, bst);
    if (RUN) phase_prep(a, lds);
    SEAM();
    layer<0>(a, lds, grid, xbar, ph, lo, hi);
    layer<1>(a, lds, grid, xbar, ph, lo, hi);
    if (RUN) phase_final_norm(a.out, a.in[28]);
}
#ifndef N_LAUNCHES
#define N_LAUNCHES 1
#endif

extern "C" void kernel_launch(void* const* d_in, const int* in_sizes, int n_in, void* d_out, int out_size, void* d_ws, size_t ws_size, hipStream_t stream) {
    static int grid = 0;
    if (grid == 0) {
        if (n_in != 29 || out_size != M * D || ws_size < WS_END) { fprintf(stderr, "kernel_launch: unexpected problem: n_in %d out %d ws %zu (need %zu)\n", n_in, out_size, ws_size, (size_t)WS_END); grid = -1; return; }
        int dev = 0, cus = 0, per_cu = 0;
        hipGetDevice(&dev);
        hipDeviceGetAttribute(&cus, hipDeviceAttributeMultiprocessorCount, dev);
        if (hipFuncSetAttribute((const void*)fwd_megakernel, hipFuncAttributeMaxDynamicSharedMemorySize, LDS_BYTES) != hipSuccess) { fprintf(stderr, "kernel_launch: hipFuncSetAttribute failed\n"); grid = -1; return; }
        if (hipOccupancyMaxActiveBlocksPerMultiprocessor(&per_cu, (const void*)fwd_megakernel, NTHREADS, LDS_BYTES) != hipSuccess || per_cu < 1) { fprintf(stderr, "kernel_launch: occupancy query says %d blocks/CU\n", per_cu); per_cu = 1; }
        (void)hipGetLastError();
        grid = cus;
    }
    if (grid < 0) return;
    Args a{};
    for (int i = 0; i < 29; ++i) a.in[i] = (const float*)d_in[i];
    a.out = (float*)d_out; a.ws = (unsigned char*)d_ws;
    if (N_LAUNCHES == 1) {
        if (hipMemsetAsync(d_ws, 0, 16384, stream) != hipSuccess) { fprintf(stderr, "kernel_launch: memset of the barrier words failed\n"); return; }
        a.lo = 0; a.hi = NPHASES;
        void* args[] = {&a};
        hipError_t e = hipLaunchCooperativeKernel((const void*)fwd_megakernel, dim3(grid), dim3(NTHREADS), args, LDS_BYTES, stream);
        if (e != hipSuccess) fprintf(stderr, "kernel_launch: cooperative launch failed: %s (grid %d)\n", hipGetErrorString(e), grid);
    } else {
        for (int p = 0; p < NPHASES; ++p) { a.lo = p; a.hi = p + 1;
            hipLaunchKernelGGL(fwd_megakernel, dim3(grid), dim3(NTHREADS), LDS_BYTES, stream, a); }
    }
}
```
